# Optimizing an MI355X kernel written in HIP

```python
import math
import jax, jax.numpy as jnp
from jax import lax
import numpy as np

D_MODEL = 1024
BATCH = 2
SEQ = 8192
DEPTH = 1

MEM_LEN = 256
EPS = 1e-6
LRU_WIDTH = 512
LRU_BLOCKS = 8
LRU_BLOCK = LRU_WIDTH // LRU_BLOCKS
CONV_WIDTH = 4
LRU_C = 8.0
MLA_HEADS = 8
QK_NOPE = 64
QK_ROPE = 32
QK_HEAD = QK_NOPE + QK_ROPE
V_DIM = 64
Q_LORA = 256
KV_LORA = 128
MLA_WIDTH = MLA_HEADS * V_DIM
ROPE_THETA = 10000.0
Q_BLOCK = 128
MIX_WIDTH = LRU_WIDTH + MLA_WIDTH
OFF_Y = LRU_WIDTH
OFF_CQ = 2 * LRU_WIDTH
OFF_CKV = OFF_CQ + Q_LORA
OFF_KR = OFF_CKV + KV_LORA
IN_COLS = OFF_KR + QK_ROPE
MEM_HEADS = 4
MEM_HEAD_DIM = 128
MEM_WIDTH = MEM_HEADS * MEM_HEAD_DIM
D_FF = 2816
FFN_CONV = 3

kernel_name = "hybrid_rglru_mla_memxattn_convffn_encoder"


def rms_norm(x, g):
    xf = x.astype(jnp.float32)
    y = xf * lax.rsqrt(jnp.mean(xf * xf, axis=-1, keepdims=True) + EPS)
    return (y * g.astype(jnp.float32)).astype(x.dtype)


def depthwise_conv(x, w, b, left, right):
    S = x.shape[1]
    xp = jnp.pad(x, ((0, 0), (left, right), (0, 0)))
    out = xp[:, 0:S] * w[0] + b
    for k in range(1, w.shape[0]):
        out = out + xp[:, k:k + S] * w[k]
    return out


def rope_tables(positions):
    inv = ROPE_THETA ** (-jnp.arange(0, QK_ROPE, 2, dtype=jnp.float32) / QK_ROPE)
    ang = positions.astype(jnp.float32)[..., None] * inv
    return jnp.cos(ang), jnp.sin(ang)


def apply_rope(t, cos, sin):
    half = QK_ROPE // 2
    c = cos[:, :, None, :].astype(t.dtype)
    s = sin[:, :, None, :].astype(t.dtype)
    t1, t2 = t[..., :half], t[..., half:]
    return jnp.concatenate([t1 * c - t2 * s, t1 * s + t2 * c], axis=-1)


def block_diag(x, w):
    B_, S_, _ = x.shape
    xb = x.reshape(B_, S_, LRU_BLOCKS, LRU_BLOCK)
    return jnp.einsum('bsnc,ncd->bsnd', xb, w).reshape(B_, S_, LRU_WIDTH)


def rg_lru(x, w_a, b_a, w_i, b_i, lam, reverse):
    r = jax.nn.sigmoid((block_diag(x, w_a) + b_a).astype(jnp.float32))
    i = jax.nn.sigmoid((block_diag(x, w_i) + b_i).astype(jnp.float32))
    log_a = -LRU_C * r * jax.nn.softplus(-lam.astype(jnp.float32))
    a = jnp.exp(log_a)
    mult = jnp.sqrt(-jnp.expm1(2.0 * log_a))
    b = mult * (i * x.astype(jnp.float32))

    def combine(lhs, rhs):
        a_l, b_l = lhs
        a_r, b_r = rhs
        return a_l * a_r, a_r * b_l + b_r

    _, h = lax.associative_scan(combine, (a, b), reverse=reverse, axis=1)
    return h


def mla_attention(proj, cos, sin, q_a_norm, w_uq, kv_a_norm, w_ukv, q_norm, k_norm):
    B_, S_, _ = proj.shape
    c_q = rms_norm(proj[..., OFF_CQ:OFF_CKV], q_a_norm)
    c_kv = rms_norm(proj[..., OFF_CKV:OFF_KR], kv_a_norm)
    k_rope = proj[..., OFF_KR:IN_COLS]
    q = (c_q @ w_uq).reshape(B_, S_, MLA_HEADS, QK_HEAD)
    kv = (c_kv @ w_ukv).reshape(B_, S_, MLA_HEADS, QK_NOPE + V_DIM)
    k_nope, v = kv[..., :QK_NOPE], kv[..., QK_NOPE:]
    k_rope_h = jnp.broadcast_to(k_rope[:, :, None, :], (B_, S_, MLA_HEADS, QK_ROPE))
    k = jnp.concatenate([k_nope, k_rope_h], axis=-1)
    q = rms_norm(q, q_norm)
    k = rms_norm(k, k_norm)
    q = jnp.concatenate([q[..., :QK_NOPE], apply_rope(q[..., QK_NOPE:], cos, sin)], axis=-1)
    k = jnp.concatenate([k[..., :QK_NOPE], apply_rope(k[..., QK_NOPE:], cos, sin)], axis=-1)
    scale = QK_HEAD ** -0.5
    kh = k.transpose(0, 2, 1, 3)
    vh = v.transpose(0, 2, 1, 3)
    nb = S_ // Q_BLOCK
    qb = q.transpose(0, 2, 1, 3).reshape(B_, MLA_HEADS, nb, Q_BLOCK, QK_HEAD).transpose(2, 0, 1, 3, 4)

    def attend(q_blk):
        s = jnp.einsum('bhqd,bhkd->bhqk', q_blk, kh).astype(jnp.float32) * scale
        p = jax.nn.softmax(s, axis=-1)
        return jnp.einsum('bhqk,bhkd->bhqd', p.astype(vh.dtype), vh)

    o = lax.map(attend, qb)
    return o.transpose(1, 0, 3, 2, 4).reshape(B_, S_, MLA_WIDTH)


def memory_cross_attention(h, mem_n, w_q, w_kv, q_norm, k_norm, w_o):
    B_, S_, _ = h.shape
    M = mem_n.shape[1]
    q = (h @ w_q).reshape(B_, S_, MEM_HEADS, MEM_HEAD_DIM)
    kv = mem_n @ w_kv
    k = kv[..., :MEM_WIDTH].reshape(B_, M, MEM_HEADS, MEM_HEAD_DIM)
    v = kv[..., MEM_WIDTH:].reshape(B_, M, MEM_HEADS, MEM_HEAD_DIM)
    q = rms_norm(q, q_norm)
    k = rms_norm(k, k_norm)
    s = jnp.einsum('bqhd,bkhd->bhqk', q, k).astype(jnp.float32) * (MEM_HEAD_DIM ** -0.5)
    p = jax.nn.softmax(s, axis=-1)
    o = jnp.einsum('bhqk,bkhd->bqhd', p.astype(v.dtype), v).reshape(B_, S_, MEM_WIDTH)
    return o @ w_o


def hybrid_layer(x, mem, cos, sin, attn_norm, w_in, lru_conv_w, lru_conv_b, lru_w_a, lru_b_a,
                 lru_w_i, lru_b_i, lru_lambda, q_a_norm, w_uq, kv_a_norm, w_ukv, mla_q_norm,
                 mla_k_norm, lru_out_norm, mla_out_norm, w_out, mem_attn_norm, mem_norm, w_mem_q,
                 w_mem_kv, mem_q_norm, mem_k_norm, w_mem_o, ffn_norm, w_up, ffn_conv_w, ffn_conv_b,
                 w_down):
    h = rms_norm(x, attn_norm)
    proj = h @ w_in
    xr = proj[..., :OFF_Y]
    yg = proj[..., OFF_Y:OFF_CQ]
    xf = depthwise_conv(xr, lru_conv_w[0], lru_conv_b[0], CONV_WIDTH - 1, 0)
    xb = depthwise_conv(xr, lru_conv_w[1], lru_conv_b[1], 0, CONV_WIDTH - 1)
    hf = rg_lru(xf, lru_w_a[0], lru_b_a[0], lru_w_i[0], lru_b_i[0], lru_lambda[0], False)
    hb = rg_lru(xb, lru_w_a[1], lru_b_a[1], lru_w_i[1], lru_b_i[1], lru_lambda[1], True)
    lru_out = (hf + hb).astype(x.dtype) * jax.nn.gelu(yg)
    mla_out = mla_attention(proj, cos, sin, q_a_norm, w_uq, kv_a_norm, w_ukv, mla_q_norm, mla_k_norm)
    mixed = jnp.concatenate([rms_norm(lru_out, lru_out_norm), rms_norm(mla_out, mla_out_norm)], axis=-1)
    x = x + mixed @ w_out
    x = x + memory_cross_attention(rms_norm(x, mem_attn_norm), rms_norm(mem, mem_norm),
                                   w_mem_q, w_mem_kv, mem_q_norm, mem_k_norm, w_mem_o)
    gu = rms_norm(x, ffn_norm) @ w_up
    gu = depthwise_conv(gu, ffn_conv_w, ffn_conv_b, FFN_CONV // 2, FFN_CONV // 2)
    g, u = gu[..., :D_FF], gu[..., D_FF:]
    x = x + (jax.nn.silu(g) * u) @ w_down
    return x


def setup_inputs(seed: int = 0) -> dict:
    key = jax.random.key(seed)
    ks = iter(jax.random.split(key, 40))
    f32 = jnp.float32

    def w(shape, fan_in):
        return jax.random.normal(next(ks), (DEPTH,) + shape, f32) * (fan_in ** -0.5)

    def gain(shape):
        return 1.0 + 0.05 * jax.random.normal(next(ks), (DEPTH,) + shape, f32)

    def bias(shape):
        return 0.01 * jax.random.normal(next(ks), (DEPTH,) + shape, f32)

    x = jax.random.normal(next(ks), (BATCH, SEQ, D_MODEL), f32)
    mem = jax.random.normal(next(ks), (BATCH, MEM_LEN, D_MODEL), f32)
    positions = jnp.broadcast_to(jnp.arange(SEQ, dtype=jnp.int32)[None, :], (BATCH, SEQ))
    u = jax.random.uniform(next(ks), (DEPTH, 2, LRU_WIDTH), f32, 0.9, 0.999)
    s = u ** (1.0 / LRU_C)
    lru_lambda = jnp.log(s) - jnp.log1p(-s)
    return {
        "x": x,
        "mem": mem,
        "positions": positions,
        "attn_norm": gain((D_MODEL,)),
        "w_in": w((D_MODEL, IN_COLS), D_MODEL),
        "lru_conv_w": w((2, CONV_WIDTH, LRU_WIDTH), CONV_WIDTH),
        "lru_conv_b": bias((2, LRU_WIDTH)),
        "lru_w_a": w((2, LRU_BLOCKS, LRU_BLOCK, LRU_BLOCK), LRU_BLOCK),
        "lru_b_a": bias((2, LRU_WIDTH)),
        "lru_w_i": w((2, LRU_BLOCKS, LRU_BLOCK, LRU_BLOCK), LRU_BLOCK),
        "lru_b_i": bias((2, LRU_WIDTH)),
        "lru_lambda": lru_lambda,
        "q_a_norm": gain((Q_LORA,)),
        "w_uq": w((Q_LORA, MLA_HEADS * QK_HEAD), Q_LORA),
        "kv_a_norm": gain((KV_LORA,)),
        "w_ukv": w((KV_LORA, MLA_HEADS * (QK_NOPE + V_DIM)), KV_LORA),
        "mla_q_norm": gain((QK_HEAD,)),
        "mla_k_norm": gain((QK_HEAD,)),
        "lru_out_norm": gain((LRU_WIDTH,)),
        "mla_out_norm": gain((MLA_WIDTH,)),
        "w_out": w((MIX_WIDTH, D_MODEL), MIX_WIDTH),
        "mem_attn_norm": gain((D_MODEL,)),
        "mem_norm": gain((D_MODEL,)),
        "w_mem_q": w((D_MODEL, MEM_WIDTH), D_MODEL),
        "w_mem_kv": w((D_MODEL, 2 * MEM_WIDTH), D_MODEL),
        "mem_q_norm": gain((MEM_HEAD_DIM,)),
        "mem_k_norm": gain((MEM_HEAD_DIM,)),
        "w_mem_o": w((MEM_WIDTH, D_MODEL), MEM_WIDTH),
        "ffn_norm": gain((D_MODEL,)),
        "w_up": w((D_MODEL, 2 * D_FF), D_MODEL),
        "ffn_conv_w": w((FFN_CONV, 2 * D_FF), FFN_CONV),
        "ffn_conv_b": bias((2 * D_FF,)),
        "w_down": w((D_FF, D_MODEL), D_FF),
    }


def reference(x, mem, positions, attn_norm, w_in, lru_conv_w, lru_conv_b, lru_w_a, lru_b_a,
              lru_w_i, lru_b_i, lru_lambda, q_a_norm, w_uq, kv_a_norm, w_ukv, mla_q_norm,
              mla_k_norm, lru_out_norm, mla_out_norm, w_out, mem_attn_norm, mem_norm, w_mem_q,
              w_mem_kv, mem_q_norm, mem_k_norm, w_mem_o, ffn_norm, w_up, ffn_conv_w, ffn_conv_b,
              w_down):
    cos, sin = rope_tables(positions)
    for l in range(DEPTH):
        x = hybrid_layer(x, mem, cos, sin, attn_norm[l], w_in[l], lru_conv_w[l], lru_conv_b[l],
                         lru_w_a[l], lru_b_a[l], lru_w_i[l], lru_b_i[l], lru_lambda[l],
                         q_a_norm[l], w_uq[l], kv_a_norm[l], w_ukv[l], mla_q_norm[l],
                         mla_k_norm[l], lru_out_norm[l], mla_out_norm[l], w_out[l],
                         mem_attn_norm[l], mem_norm[l], w_mem_q[l], w_mem_kv[l], mem_q_norm[l],
                         mem_k_norm[l], w_mem_o[l], ffn_norm[l], w_up[l], ffn_conv_w[l],
                         ffn_conv_b[l], w_down[l])
    return x
```

```cpp
#include <hip/hip_runtime.h>
#include <hip/hip_cooperative_groups.h>
#include <cstdio>
#include <cstdint>
namespace cg = cooperative_groups;

#ifndef FAST_GEMM
#define FAST_GEMM 1
#endif
#ifndef FAST_ATTN
#define FAST_ATTN 1
#endif

namespace pg8 {
#define PG8_LAS __attribute__((address_space(3)))
typedef unsigned short bf16_t;
typedef short bf16x8 __attribute__((ext_vector_type(8)));
typedef float f32x4 __attribute__((ext_vector_type(4)));
typedef unsigned u32x4 __attribute__((ext_vector_type(4)));
constexpr int BM = 256, BK = 64, HALF = 128, HTB = HALF * BK * 2  , STAGE_BYTES = 8 * HTB, NXCD = 8, WGM = 8;

__host__ __device__ __forceinline__ int lds_byte(int r, int c) { const int st = (r >> 4) * 2 + (c >> 5), rr = r & 15, cc = c & 31, ob = rr * 64 + cc * 2; return st * 1024 + (ob ^ (((ob >> 9) & 1) << 5)); }
__host__ __device__ __forceinline__ void stage_rc(int b, int& R, int& C) { const int st = b / 1024, sb = b % 1024, swz = sb ^ (((sb >> 9) & 1) << 5); R = (st >> 1) * 16 + swz / 64; C = (st & 1) * 32 + (swz % 64) / 2; }
__host__ __device__ __forceinline__ int perm32(int rho) { const int n = rho >> 4, i = rho & 15; return 8 * (i >> 2) + 4 * n + (i & 3); }

typedef unsigned u32x2 __attribute__((ext_vector_type(2)));
struct Unit { int pm, pn, job; const char* A; const char* B; };
struct Gemm { int K, lda, ldb; };

template <class Epi, class Sched, bool ALIGN_EPI = false, bool SP2 = false>
__device__ __forceinline__ void gemm_phase(PG8_LAS unsigned char* lds, const Gemm g, const Sched& S, const Epi& E) {
    const int tid = threadIdx.x, wid = __builtin_amdgcn_readfirstlane(tid >> 6), lane = tid & 63, wr = wid >> 2, wc = wid & 3, fr = lane & 15, fq = lane >> 4;
    int Kopq = g.K; asm volatile("" : "+s"(Kopq));
    const int K = Kopq, nt = K / BK;
    unsigned voffA[2], voffB[2];
#pragma unroll
    for (int i = 0; i < 2; ++i) { int R, C; stage_rc(tid * 16 + i * 8192, R, C); const int Rb = Epi::PERM ? ((R & ~31) + perm32(R & 31)) : R;
        voffA[i] = (unsigned)(R * g.lda + C) * 2u; voffB[i] = (unsigned)(Rb * g.ldb + C) * 2u; }
    const size_t kstep = (size_t)(BK * 2);
    const size_t hstepA = (size_t)HALF * g.lda * 2, hstepB = (size_t)HALF * g.ldb * 2;
    const unsigned ldsw = (unsigned)wid * 1024u;
    const int aoff = lds_byte(wr * 64 + fr, fq * 8), boff = lds_byte(wc * 32 + fr, fq * 8);
#define PG8_SA(b, h) (((b) * 2 + (h)) * HTB)
#define PG8_SB(b, h) ((4 + (b) * 2 + (h)) * HTB)
#define PG8_STAGE(bufoff, gbase, voff) do { _Pragma("unroll") for (int _i = 0; _i < 2; ++_i) \
        __builtin_amdgcn_global_load_lds((const unsigned*)((const char*)(gbase) + (voff)[_i]), (PG8_LAS unsigned*)(lds + (bufoff) + ldsw + _i * 8192), 16, 0, 0); } while (0)
#define PG8_LDA(dst, b, h) do { _Pragma("unroll") for (int m = 0; m < 4; ++m) _Pragma("unroll") for (int k = 0; k < 2; ++k) dst[m][k] = *(const PG8_LAS bf16x8*)(lds + PG8_SA(b, h) + aoff + m * 2048 + k * 1024); } while (0)
#define PG8_LDB(dst, b, h) do { _Pragma("unroll") for (int n = 0; n < 2; ++n) _Pragma("unroll") for (int k = 0; k < 2; ++k) dst[n][k] = *(const PG8_LAS bf16x8*)(lds + PG8_SB(b, h) + boff + n * 2048 + k * 1024); } while (0)
#define PG8_MMA(ai, bj, At, Bt) do { __builtin_amdgcn_s_setprio(1); _Pragma("unroll") for (int m = 0; m < 4; ++m) _Pragma("unroll") for (int n = 0; n < 2; ++n) _Pragma("unroll") for (int k = 0; k < 2; ++k) \
        acc[ai][bj][m][n] = __builtin_amdgcn_mfma_f32_16x16x32_bf16(Bt[n][k], At[m][k], acc[ai][bj][m][n], 0, 0, 0); __builtin_amdgcn_s_setprio(0); } while (0)
#define PG8_WAIT_V(n) asm volatile("s_waitcnt vmcnt(" #n ")" ::: "memory")
#define PG8_WAIT_L(n) asm volatile("s_waitcnt lgkmcnt(" #n ")" ::: "memory")
#define PG8_BAR __builtin_amdgcn_s_barrier()
#define PG8_SCHED __builtin_amdgcn_sched_barrier(0)
    Unit cur, nxt; int ui = 0;
    if (!S.next(0, cur)) return;
    f32x4 acc[2][2][4][2];
#pragma unroll
    for (int a = 0; a < 2; ++a)
#pragma unroll
        for (int b = 0; b < 2; ++b)
#pragma unroll
            for (int m = 0; m < 4; ++m)
#pragma unroll
                for (int n = 0; n < 2; ++n) acc[a][b][m][n] = (f32x4){0.f, 0.f, 0.f, 0.f};
    bf16x8 At[4][2], B0[2][2], B1[2][2];
    const char* cA = cur.A; const char* cB = cur.B;
    S.a_ready(cur);
    if constexpr (SP2) {
        PG8_STAGE(PG8_SB(0, 0), cB, voffB); PG8_STAGE(PG8_SB(0, 1), cB + hstepB, voffB); PG8_STAGE(PG8_SA(0, 0), cA, voffA); PG8_STAGE(PG8_SA(0, 1), cA + hstepA, voffA);
        if (wr == 1) PG8_BAR;
        PG8_WAIT_V(2); PG8_BAR;
        PG8_STAGE(PG8_SB(1, 0), cB + kstep, voffB); PG8_STAGE(PG8_SA(1, 0), cA + kstep, voffA); PG8_STAGE(PG8_SB(1, 1), cB + hstepB + kstep, voffB);
        PG8_WAIT_V(6); PG8_BAR;
    } else {
        PG8_STAGE(PG8_SB(0, 0), cB, voffB); PG8_STAGE(PG8_SA(0, 0), cA, voffA); PG8_STAGE(PG8_SB(0, 1), cB + hstepB, voffB); PG8_STAGE(PG8_SA(0, 1), cA + hstepA, voffA);
        if (wr == 1) PG8_BAR;
        PG8_WAIT_V(4); PG8_BAR;
        PG8_STAGE(PG8_SB(1, 0), cB + kstep, voffB); PG8_STAGE(PG8_SA(1, 0), cA + kstep, voffA); PG8_STAGE(PG8_SB(1, 1), cB + hstepB + kstep, voffB);
        PG8_WAIT_V(6); PG8_BAR;
    }
    for (;;) {
        const bool has_next = S.next(ui + 1, nxt);
        const char* nA = has_next ? nxt.A : cA; const char* nB = has_next ? nxt.B : cB;
        for (int t = 0; t < nt; t += 2) {
            const bool last = (t == nt - 2);
            const char* a1 = cA + (size_t)(t + 1) * kstep;
            const char* a2 = last ? nA : cA + (size_t)(t + 2) * kstep; const char* b2 = last ? nB : cB + (size_t)(t + 2) * kstep;
            const char* a3 = a2 + kstep; const char* b3 = b2 + kstep;
            if (last && has_next) S.a_ready(nxt);
            if constexpr (SP2) {
            PG8_LDB(B0, 0, 0); PG8_LDB(B1, 0, 1); PG8_SCHED; PG8_LDA(At, 0, 0); PG8_STAGE(PG8_SA(1, 1), a1 + hstepA, voffA);
            PG8_WAIT_V(8); PG8_WAIT_L(0); PG8_BAR; PG8_MMA(0, 0, At, B0); PG8_MMA(0, 1, At, B1); PG8_BAR; PG8_SCHED;
            PG8_LDA(At, 0, 1); PG8_STAGE(PG8_SB(0, 0), b2, voffB); PG8_STAGE(PG8_SB(0, 1), b2 + hstepB, voffB); PG8_STAGE(PG8_SA(0, 0), a2, voffA);
            PG8_WAIT_V(8); PG8_WAIT_L(0); PG8_BAR; PG8_MMA(1, 0, At, B0); PG8_MMA(1, 1, At, B1); PG8_BAR; PG8_SCHED;
            PG8_LDB(B0, 1, 0); PG8_LDB(B1, 1, 1); PG8_SCHED; PG8_LDA(At, 1, 0); PG8_STAGE(PG8_SA(0, 1), a2 + hstepA, voffA);
            PG8_WAIT_V(8); PG8_WAIT_L(0); PG8_BAR; PG8_MMA(0, 0, At, B0); PG8_MMA(0, 1, At, B1); PG8_BAR; PG8_SCHED;
            PG8_LDA(At, 1, 1); PG8_STAGE(PG8_SB(1, 0), b3, voffB); PG8_STAGE(PG8_SB(1, 1), b3 + hstepB, voffB); PG8_STAGE(PG8_SA(1, 0), a3, voffA);
            PG8_WAIT_V(8); PG8_WAIT_L(0); PG8_BAR; PG8_MMA(1, 0, At, B0); PG8_MMA(1, 1, At, B1); PG8_BAR; PG8_SCHED;
            } else {
            PG8_LDB(B0, 0, 0); PG8_SCHED; PG8_LDA(At, 0, 0); PG8_STAGE(PG8_SA(1, 1), a1 + hstepA, voffA);
            PG8_WAIT_L(8); PG8_BAR; PG8_WAIT_L(0); PG8_MMA(0, 0, At, B0); PG8_BAR; PG8_SCHED;
            PG8_LDB(B1, 0, 1); PG8_STAGE(PG8_SB(0, 0), b2, voffB);
            PG8_BAR; PG8_WAIT_L(0); PG8_MMA(0, 1, At, B1); PG8_BAR;
            PG8_LDA(At, 0, 1); PG8_STAGE(PG8_SA(0, 0), a2, voffA);
            PG8_BAR; PG8_WAIT_L(0); PG8_MMA(1, 0, At, B0); PG8_BAR; PG8_SCHED;
            PG8_STAGE(PG8_SB(0, 1), b2 + hstepB, voffB);
            PG8_WAIT_V(6); PG8_BAR; PG8_MMA(1, 1, At, B1); PG8_BAR;
            PG8_LDB(B0, 1, 0); PG8_SCHED; PG8_LDA(At, 1, 0); PG8_STAGE(PG8_SA(0, 1), a2 + hstepA, voffA);
            PG8_WAIT_L(8); PG8_BAR; PG8_WAIT_L(0); PG8_MMA(0, 0, At, B0); PG8_BAR; PG8_SCHED;
            PG8_LDB(B1, 1, 1); PG8_STAGE(PG8_SB(1, 0), b3, voffB);
            PG8_BAR; PG8_WAIT_L(0); PG8_MMA(0, 1, At, B1); PG8_BAR;
            PG8_LDA(At, 1, 1); PG8_STAGE(PG8_SA(1, 0), a3, voffA);
            PG8_BAR; PG8_WAIT_L(0); PG8_MMA(1, 0, At, B0); PG8_BAR; PG8_SCHED;
            PG8_STAGE(PG8_SB(1, 1), b3 + hstepB, voffB);
            PG8_WAIT_V(6); PG8_BAR; PG8_MMA(1, 1, At, B1); PG8_BAR;
            }
        }
        if constexpr (ALIGN_EPI) { if (wr == 0) PG8_BAR; }
        if constexpr (!Epi::AFTER_DRAIN) { E(acc, cur, wr, wc, fr, fq); S.done(cur); }
        if (!has_next) break;
#pragma unroll
        for (int a = 0; a < 2; ++a)
#pragma unroll
            for (int b = 0; b < 2; ++b)
#pragma unroll
                for (int m = 0; m < 4; ++m)
#pragma unroll
                    for (int n = 0; n < 2; ++n) acc[a][b][m][n] = (f32x4){0.f, 0.f, 0.f, 0.f};
        cur = nxt; cA = nA; cB = nB; ++ui;
        if constexpr (ALIGN_EPI) { if (wr == 1) PG8_BAR; }
    }
    PG8_WAIT_V(0);
    if constexpr (!ALIGN_EPI) { if (wr == 0) PG8_BAR; }
    PG8_BAR;
    if constexpr (Epi::AFTER_DRAIN) { E.fused(acc, cur, wr, wc, fr, fq, lds, wid, lane); S.done(cur); }
#undef PG8_SA
#undef PG8_SB
#undef PG8_STAGE
#undef PG8_LDA
#undef PG8_LDB
#undef PG8_MMA
#undef PG8_WAIT_V
#undef PG8_WAIT_L
#undef PG8_BAR
#undef PG8_SCHED
}

__device__ __forceinline__ float bf2f(bf16_t v) { return __uint_as_float((unsigned)v << 16); }
__device__ __forceinline__ float bflo(unsigned w) { return __uint_as_float(w << 16); }
__device__ __forceinline__ float bfhi(unsigned w) { return __uint_as_float(w & 0xffff0000u); }
__device__ __forceinline__ unsigned cvt_pk_bf16(float lo, float hi) { unsigned r; asm volatile("v_cvt_pk_bf16_f32 %0, %1, %2" : "=v"(r) : "v"(lo), "v"(hi)); return r; }

template <class Epi, class Sched>
__device__ __forceinline__ void gemm_naive(const Gemm g, const Sched& S, const Epi& E) {
    const int tid = threadIdx.x, wid = tid >> 6, lane = tid & 63, wr = wid >> 2, wc = wid & 3, fr = lane & 15, fq = lane >> 4;
    Unit u;
    for (int i = 0; S.next(i, u); ++i) {
        f32x4 acc[2][2][4][2];
#pragma unroll
        for (int ai = 0; ai < 2; ++ai)
#pragma unroll
            for (int bj = 0; bj < 2; ++bj)
#pragma unroll
                for (int m = 0; m < 4; ++m)
#pragma unroll
                    for (int n = 0; n < 2; ++n) {
                        const bf16_t* a = (const bf16_t*)u.A + (size_t)(ai * 128 + wr * 64 + m * 16 + fr) * g.lda;
                        const bf16_t* b = (const bf16_t*)u.B + (size_t)(bj * 128 + wc * 32 + n * 16 + 4 * fq) * g.ldb;
                        float s0 = 0.f, s1 = 0.f, s2 = 0.f, s3 = 0.f;
                        for (int k = 0; k < g.K; k += 8) {
                            const bf16x8 av = *(const bf16x8*)(a + k), b0 = *(const bf16x8*)(b + k), b1 = *(const bf16x8*)(b + g.ldb + k), b2 = *(const bf16x8*)(b + 2 * g.ldb + k), b3 = *(const bf16x8*)(b + 3 * g.ldb + k);
#pragma unroll
                            for (int e = 0; e < 8; ++e) { const float x = bf2f((bf16_t)av[e]); s0 += x * bf2f((bf16_t)b0[e]); s1 += x * bf2f((bf16_t)b1[e]); s2 += x * bf2f((bf16_t)b2[e]); s3 += x * bf2f((bf16_t)b3[e]); }
                        }
                        acc[ai][bj][m][n] = (f32x4){s0, s1, s2, s3};
                    }
        E(acc, u, wr, wc, fr, fq);
    }
}

struct Job { const char* A; const char* B; int nM, nN; };
struct Sched2 {
    Job a, b; int G, c, lda, ldb;
    __device__ __forceinline__ bool next(int i, Unit& u) const {
        int L = i * G + c; const int na = a.nM * a.nN, nb = b.nM * b.nN;
        if (L < na) { u.job = 0; u.pm = L % a.nM; u.pn = L / a.nM; u.A = a.A + (size_t)u.pm * 256 * lda * 2; u.B = a.B + (size_t)u.pn * 256 * ldb * 2; return true; }
        L -= na;
        if (L < nb) { u.job = 1; u.pm = L % b.nM; u.pn = L / b.nM; u.A = b.A + (size_t)u.pm * 256 * lda * 2; u.B = b.B + (size_t)u.pn * 256 * ldb * 2; return true; }
        return false;
    }
    __device__ __forceinline__ void a_ready(const Unit&) const {}
    __device__ __forceinline__ void done(const Unit&) const {}
};
struct GateOrder {
    const char* xc; const char* wg; size_t dstride; int G, c;
    __device__ __forceinline__ bool next(int i, Unit& u) const {
        const int L = i * G + c; if (L >= 512) return false;
        const int grp = L >> 6, pm = L & 63, d = grp >> 2, png = grp & 3;
        u.job = d; u.pm = pm; u.pn = png; u.A = xc + (size_t)d * dstride + ((size_t)pm * 256 * 512 + png * 128) * 2; u.B = wg + (size_t)grp * 256 * 128 * 2; return true;
    }
    __device__ __forceinline__ void a_ready(const Unit&) const {}
    __device__ __forceinline__ void done(const Unit&) const {}
};

__device__ __forceinline__ float rowscale16(const float* ss, int row) {
    const f32x4* p = (const f32x4*)(ss + (size_t)row * 16); const f32x4 a = p[0], b = p[1], c = p[2], d = p[3];
    const float s = ((a[0] + a[1]) + (a[2] + a[3])) + ((b[0] + b[1]) + (b[2] + b[3])) + ((c[0] + c[1]) + (c[2] + c[3])) + ((d[0] + d[1]) + (d[2] + d[3]));
    return 1.0f / sqrtf(s * (1.0f / 1024.0f) + 1e-6f);
}
template <bool ROWSCALE> struct EpiBf {
    static constexpr bool PERM = false, AFTER_DRAIN = false;
    bf16_t* O0; int ld0; bf16_t* O1; int ld1; const float* ss;
    __device__ __forceinline__ void operator()(const f32x4 (&acc)[2][2][4][2], const Unit& u, int wr, int wc, int fr, int fq) const {
        bf16_t* O = u.job ? O1 : O0; const int ldc = u.job ? ld1 : ld0;
        const int row0 = u.pm * 256 + wr * 64 + fr, col0 = u.pn * 256 + wc * 32 + 4 * fq;
#pragma unroll
        for (int ai = 0; ai < 2; ++ai)
#pragma unroll
            for (int m = 0; m < 4; ++m) { const int row = row0 + ai * 128 + m * 16; float rs = 1.f; if (ROWSCALE) rs = rowscale16(ss, row);
                bf16_t* rowp = O + (size_t)row * ldc + col0;
#pragma unroll
                for (int bj = 0; bj < 2; ++bj)
#pragma unroll
                    for (int n = 0; n < 2; ++n) { const f32x4 v = acc[ai][bj][m][n] * rs; u32x2 w; w.x = cvt_pk_bf16(v[0], v[1]); w.y = cvt_pk_bf16(v[2], v[3]); *(u32x2*)(rowp + bj * 128 + n * 16) = w; } }
    }
};
template <bool STATS> struct EpiResid {
    static constexpr bool PERM = false, AFTER_DRAIN = false;
    const float* base; float* out; bf16_t* xb; float* ss;
    __device__ __forceinline__ void operator()(const f32x4 (&acc)[2][2][4][2], const Unit& u, int wr, int wc, int fr, int fq) const {
        const int row0 = u.pm * 256 + wr * 64 + fr, col0 = u.pn * 256 + wc * 32 + 4 * fq;
#pragma unroll
        for (int ai = 0; ai < 2; ++ai)
#pragma unroll
            for (int m = 0; m < 4; ++m) { const int row = row0 + ai * 128 + m * 16; const size_t off = (size_t)row * 1024 + col0; float s = 0.f;
#pragma unroll
                for (int bj = 0; bj < 2; ++bj)
#pragma unroll
                    for (int n = 0; n < 2; ++n) { const size_t o2 = off + bj * 128 + n * 16; const f32x4 v = *(const f32x4*)(base + o2) + acc[ai][bj][m][n]; *(f32x4*)(out + o2) = v;
                        if (STATS) { s += (v[0] * v[0] + v[1] * v[1]) + (v[2] * v[2] + v[3] * v[3]); u32x2 w; w.x = cvt_pk_bf16(v[0], v[1]); w.y = cvt_pk_bf16(v[2], v[3]); *(u32x2*)(xb + o2) = w; } }
                if (STATS) { s += __shfl_xor(s, 16); s += __shfl_xor(s, 32); if (fq == 0) ss[(size_t)row * 16 + u.pn * 4 + wc] = s; } }
    }
};
struct EpiGates {
    static constexpr bool PERM = false, AFTER_DRAIN = false;
    const bf16_t* xc; const float* b_a; const float* b_i; const float* c8t; unsigned* G; int T;
    __device__ __forceinline__ void operator()(const f32x4 (&acc)[2][2][4][2], const Unit& u, int wr, int wc, int fr, int fq) const {
        const int d = u.job, row0 = u.pm * 256 + wr * 64 + fr, ch0 = u.pn * 128 + wc * 32 + 4 * fq;
#pragma unroll
        for (int n = 0; n < 2; ++n) { const int ch = d * 512 + ch0 + n * 16; const f32x4 ba = *(const f32x4*)(b_a + ch), bi = *(const f32x4*)(b_i + ch), c8 = *(const f32x4*)(c8t + ch);
#pragma unroll
            for (int ai = 0; ai < 2; ++ai)
#pragma unroll
                for (int m = 0; m < 4; ++m) { const int row = row0 + ai * 128 + m * 16;
                    const size_t off = ((size_t)d * T + row) * 512 + ch0 + n * 16; const u32x2 xw = *(const u32x2*)(xc + off);
                    const float xv[4] = {bflo(xw.x), bfhi(xw.x), bflo(xw.y), bfhi(xw.y)}; const f32x4 pa = acc[ai][0][m][n] + ba, pi = acc[ai][1][m][n] + bi; u32x4 o;
#pragma unroll
                    for (int e = 0; e < 4; ++e) { const float r = 1.0f / (1.0f + __expf(-pa[e])), ig = 1.0f / (1.0f + __expf(-pi[e])); const float la = r * c8[e];
                        const float x2 = 2.0f * la; const float om = (x2 > -0.02f) ? -(x2 + 0.5f * x2 * x2 + x2 * x2 * x2 * (1.0f / 6.0f)) : 1.0f - __expf(x2);
                        o[e] = cvt_pk_bf16(la, sqrtf(fmaxf(om, 0.f)) * ig * xv[e]); }
                    *(u32x4*)(G + off) = o; asm volatile("" ::: "memory"); } }
    }
};
}

namespace att {
using pg8::bf16_t;
using bf16x8 = __attribute__((ext_vector_type(8))) short;
using s16x4  = __attribute__((ext_vector_type(4))) short;
using f32x16 = __attribute__((ext_vector_type(16))) float;
using u32x4  = __attribute__((ext_vector_type(4))) unsigned;
constexpr int NW = 8, QBLK = 32, KVBLK = 64;
constexpr size_t SHM_V = KVBLK * 128 * 2, SHM_K = KVBLK * 128 * 2, SHM_ATTN = 2 * SHM_V + 2 * SHM_K + NW * 64 * 4;
constexpr float THR = 8.f;
#define KSWZ(row, colB) ((row) * 256 + ((colB) ^ (((row) & 7) << 4)))
#define SBAR() __builtin_amdgcn_sched_barrier(0)
__device__ __forceinline__ int crow(int r, int hi) { return (r & 3) + 8 * (r >> 2) + 4 * hi; }
__device__ __forceinline__ unsigned cvtpk(float lo, float hi) { unsigned r; asm volatile("v_cvt_pk_bf16_f32 %0, %1, %2" : "=v"(r) : "v"(lo), "v"(hi)); return r; }
__device__ __forceinline__ void partialSM(f32x16& p0, f32x16& p1, float& m_reg, float& mn, float& alpha, float C, float thr_raw) {
  float pmax = p0[0];
#pragma unroll
  for (int r = 1; r < 16; ++r) pmax = fmaxf(pmax, p0[r]);
#pragma unroll
  for (int r = 0; r < 16; ++r) pmax = fmaxf(pmax, p1[r]);
  { auto rr = __builtin_amdgcn_permlane32_swap(__float_as_uint(pmax), __float_as_uint(pmax), false, false);
    pmax = fmaxf(__uint_as_float(rr[0]), __uint_as_float(rr[1])); }
  if (__builtin_expect(__all(pmax - m_reg <= thr_raw), 1)) { mn = m_reg; alpha = 1.f; }
  else { mn = fmaxf(m_reg, pmax); alpha = __builtin_amdgcn_exp2f((m_reg - mn) * C); m_reg = mn; }
  const float mnC = -mn * C;
#pragma unroll
  for (int r = 0; r < 16; ++r) p0[r] = fmaf(p0[r], C, mnC);
#pragma unroll
  for (int r = 0; r < 16; ++r) p1[r] = fmaf(p1[r], C, mnC);
#pragma unroll
  for (int r = 0; r < 16; ++r) p0[r] = __builtin_amdgcn_exp2f(p0[r]);
}
__device__ __forceinline__ void finishSM(f32x16& p0, f32x16& p1, float alpha, float& l_reg, bf16x8& pa0, bf16x8& pa1, bf16x8& pa2, bf16x8& pa3) {
#pragma unroll
  for (int r = 0; r < 16; ++r) p1[r] = __builtin_amdgcn_exp2f(p1[r]);
  float ps = 0;
#pragma unroll
  for (int r = 0; r < 16; ++r) ps += p0[r];
#pragma unroll
  for (int r = 0; r < 16; ++r) ps += p1[r];
  { auto rr = __builtin_amdgcn_permlane32_swap(__float_as_uint(ps), __float_as_uint(ps), false, false);
    ps = __uint_as_float(rr[0]) + __uint_as_float(rr[1]); }
  l_reg = l_reg * alpha + ps;
#define PK4(P, BASE, OUT) do { unsigned a0 = cvtpk(P[BASE + 0], P[BASE + 1]), a1 = cvtpk(P[BASE + 2], P[BASE + 3]);   \
    unsigned b0 = cvtpk(P[BASE + 4], P[BASE + 5]), b1 = cvtpk(P[BASE + 6], P[BASE + 7]);                              \
    auto r0 = __builtin_amdgcn_permlane32_swap(a0, b0, false, false); auto r1 = __builtin_amdgcn_permlane32_swap(a1, b1, false, false); \
    u32x4 w = {r0[0], r1[0], r0[1], r1[1]}; OUT = *reinterpret_cast<bf16x8*>(&w); } while (0)
  PK4(p0, 0, pa0); PK4(p0, 8, pa1); PK4(p1, 0, pa2); PK4(p1, 8, pa3);
#undef PK4
}
template <int DQK> __device__ __forceinline__ void qkt(f32x16& p0, f32x16& p1, const bf16_t* Ks, const bf16x8* qr, int r32, int hi) {
  p0 = f32x16{}; p1 = f32x16{};
#pragma unroll
  for (int d0 = 0; d0 < DQK / 16; ++d0) { const int cb = (d0 * 16 + hi * 8) * 2;
    const bf16x8 b0 = *reinterpret_cast<const bf16x8*>((const char*)Ks + KSWZ(r32, cb));
    const bf16x8 b1 = *reinterpret_cast<const bf16x8*>((const char*)Ks + KSWZ(32 + r32, cb));
    p0 = __builtin_amdgcn_mfma_f32_32x32x16_bf16(b0, qr[d0], p0, 0, 0, 0);
    p1 = __builtin_amdgcn_mfma_f32_32x32x16_bf16(b1, qr[d0], p1, 0, 0, 0); }
}
__device__ __forceinline__ int v_st(int k, int c) { const int kk = (k & ~0xC) | ((k & 4) << 1) | ((k & 8) >> 1); return ((kk >> 3) * 4 + (c >> 5)) * 512 + ((kk & 7) * 32 + (c & 31)) * 2; }
__device__ __forceinline__ int v_rd_base(int lane) { return ((lane & 3) << 3) | (((lane >> 2) & 3) << 6) | (((lane >> 4) & 1) << 5) | (((lane >> 5) & 1) << 8); }
constexpr int v_rd_off(int d0, int ks, int half) { return d0 * 512 + ks * 4096 + half * 2048; }
template <int OFF> __device__ __forceinline__ s16x4 tr_read(int vb) {
  s16x4 r; asm volatile("ds_read_b64_tr_b16 %0, %1 offset:%2" : "=&v"(r) : "v"(vb), "i"(OFF) : "memory"); return r;
}
template <int D0> __device__ __forceinline__ void pv_one(f32x16& od, int vb, bf16x8 pa0, bf16x8 pa1, bf16x8 pa2, bf16x8 pa3) {
  const s16x4 l0 = tr_read<v_rd_off(D0, 0, 0)>(vb), h0 = tr_read<v_rd_off(D0, 0, 1)>(vb), l1 = tr_read<v_rd_off(D0, 1, 0)>(vb), h1 = tr_read<v_rd_off(D0, 1, 1)>(vb);
  const s16x4 l2 = tr_read<v_rd_off(D0, 2, 0)>(vb), h2 = tr_read<v_rd_off(D0, 2, 1)>(vb), l3 = tr_read<v_rd_off(D0, 3, 0)>(vb), h3 = tr_read<v_rd_off(D0, 3, 1)>(vb);
  asm volatile("s_waitcnt lgkmcnt(0)" ::: "memory"); SBAR();
#define PK(L, H) (bf16x8){L[0], L[1], L[2], L[3], H[0], H[1], H[2], H[3]}
  od = __builtin_amdgcn_mfma_f32_32x32x16_bf16(pa0, PK(l0, h0), od, 0, 0, 0);
  od = __builtin_amdgcn_mfma_f32_32x32x16_bf16(pa1, PK(l1, h1), od, 0, 0, 0);
  od = __builtin_amdgcn_mfma_f32_32x32x16_bf16(pa2, PK(l2, h2), od, 0, 0, 0);
  od = __builtin_amdgcn_mfma_f32_32x32x16_bf16(pa3, PK(l3, h3), od, 0, 0, 0);
#undef PK
}
template <int DV> __device__ __forceinline__ void pv_all(f32x16* o, int vb, bf16x8 pa0, bf16x8 pa1, bf16x8 pa2, bf16x8 pa3) {
  pv_one<0>(o[0], vb, pa0, pa1, pa2, pa3); pv_one<1>(o[1], vb, pa0, pa1, pa2, pa3);
  if constexpr (DV == 128) { pv_one<2>(o[2], vb, pa0, pa1, pa2, pa3); pv_one<3>(o[3], vb, pa0, pa1, pa2, pa3); }
}

template <int DQK, int DV, bool QNORM>
__device__ __forceinline__ void attn_unit(const bf16_t* __restrict__ Qb, int ldq, const bf16_t* __restrict__ Kh, int ldk, const bf16_t* __restrict__ Vh, int ldv,
                                          bf16_t* __restrict__ Ob, int ldo, int seq, float scale, const float* __restrict__ qgain, char* lds) {
  const int tid = threadIdx.x, wid = tid >> 6, lane = tid & 63, r32 = lane & 31, hi = lane >> 5;
  const float C = scale * 1.4426950408889634f, thr_raw = THR / scale;
  bf16_t* V_lds = (bf16_t*)lds; bf16_t* K_lds = (bf16_t*)(lds + 2 * SHM_V);
  float* ws = (float*)(lds + 2 * SHM_V + 2 * SHM_K) + wid * 64; float* li_l = ws; float* al_l = ws + 32;
  float m_reg = -1e30f, l_reg = 0; f32x16 o[DV / 32]; bf16x8 qr[DQK / 16];
#pragma unroll
  for (int d = 0; d < DV / 32; ++d) o[d] = f32x16{};
  const bf16_t* Qw = Qb + (long)(wid * QBLK + r32) * ldq + hi * 8;
#pragma unroll
  for (int d0 = 0; d0 < DQK / 16; ++d0) qr[d0] = *reinterpret_cast<const bf16x8*>(Qw + d0 * 16);
  if constexpr (QNORM) {
    float ssq = 0.f;
#pragma unroll
    for (int d0 = 0; d0 < DQK / 16; ++d0)
#pragma unroll
      for (int e = 0; e < 8; ++e) { const float v = pg8::bf2f((bf16_t)qr[d0][e]); ssq += v * v; }
    ssq += __shfl_xor(ssq, 32);
    const float rs = 1.0f / sqrtf(ssq * (1.0f / DQK) + 1e-6f);
#pragma unroll
    for (int d0 = 0; d0 < DQK / 16; ++d0) { float v[8];
#pragma unroll
      for (int e = 0; e < 8; ++e) v[e] = pg8::bf2f((bf16_t)qr[d0][e]) * rs * qgain[d0 * 16 + hi * 8 + e];
      u32x4 w = {cvtpk(v[0], v[1]), cvtpk(v[2], v[3]), cvtpk(v[4], v[5]), cvtpk(v[6], v[7])}; qr[d0] = *reinterpret_cast<bf16x8*>(&w); }
  }
  const int sr = tid >> 4, sc = (tid & 15) * 8, vst0 = v_st(sr, sc), vst1 = v_st(32 + sr, sc);
  const bool kact = sc < DQK, vact = sc < DV;
  const int vb0 = (int)(uintptr_t)V_lds + v_rd_base(lane);
  bf16x8 svs0[2], svs1[2], sks0[2], sks1[2];
#define SLOAD(i, k0) do { if (vact) { svs0[i] = *(const bf16x8*)(&Vh[(long)((k0) + sr) * ldv + sc]); svs1[i] = *(const bf16x8*)(&Vh[(long)((k0) + 32 + sr) * ldv + sc]); } \
    if (kact) { sks0[i] = *(const bf16x8*)(&Kh[(long)((k0) + sr) * ldk + sc]); sks1[i] = *(const bf16x8*)(&Kh[(long)((k0) + 32 + sr) * ldk + sc]); } } while (0)
#define SWRITE(b, i) do { if (vact) { *(bf16x8*)((char*)V_lds + (b) * SHM_V + vst0) = svs0[i]; *(bf16x8*)((char*)V_lds + (b) * SHM_V + vst1) = svs1[i]; } \
    if (kact) { const int kc = sc * 2; *(bf16x8*)((char*)K_lds + (b) * SHM_K + KSWZ(sr, kc)) = sks0[i]; *(bf16x8*)((char*)K_lds + (b) * SHM_K + KSWZ(32 + sr, kc)) = sks1[i]; } } while (0)
#define SWAIT() asm volatile("s_waitcnt vmcnt(4)" ::: "memory")
#define RESC(a) do { if (__any((a) < 1.f)) { if (hi == 0) al_l[r32] = (a); asm volatile("s_waitcnt lgkmcnt(0)" ::: "memory"); \
    _Pragma("unroll") for (int d = 0; d < DV / 32; ++d) _Pragma("unroll") for (int r = 0; r < 16; ++r) o[d][r] *= al_l[crow(r, hi)]; } } while (0)
  f32x16 pA0, pA1, pB0, pB1; float mnA, mnB, alA, alB; bf16x8 pa0, pa1, pa2, pa3; const int NT = seq / KVBLK;
  constexpr int SE = 0, SO = 1;
  SLOAD(SE, 0); asm volatile("s_waitcnt vmcnt(0)" ::: "memory"); SWRITE(0, SE); __syncthreads();
  qkt<DQK>(pA0, pA1, K_lds, qr, r32, hi); partialSM(pA0, pA1, m_reg, mnA, alA, C, thr_raw);
  SLOAD(SO, KVBLK); if (2 < NT) SLOAD(SE, 2 * KVBLK);
  SWAIT(); SWRITE(1, SO); __syncthreads();
  for (int j = 1; j + 1 < NT; j += 2) {
    SBAR(); qkt<DQK>(pB0, pB1, (bf16_t*)((char*)K_lds + SHM_K), qr, r32, hi);
    finishSM(pA0, pA1, alA, l_reg, pa0, pa1, pa2, pa3); SBAR();
    SLOAD(SO, (j + 2) * KVBLK); SBAR();
    pv_all<DV>(o, vb0, pa0, pa1, pa2, pa3); partialSM(pB0, pB1, m_reg, mnB, alB, C, thr_raw);
    __syncthreads(); SWAIT(); SWRITE(0, SE);
    RESC(alB); __syncthreads();
    SBAR(); qkt<DQK>(pA0, pA1, K_lds, qr, r32, hi);
    finishSM(pB0, pB1, alB, l_reg, pa0, pa1, pa2, pa3); SBAR();
    if (j + 3 < NT) SLOAD(SE, (j + 3) * KVBLK); SBAR();
    pv_all<DV>(o, vb0 + (int)SHM_V, pa0, pa1, pa2, pa3); partialSM(pA0, pA1, m_reg, mnA, alA, C, thr_raw);
    __syncthreads(); SWAIT(); SWRITE(1, SO);
    RESC(alA); __syncthreads();
  }
  SBAR(); qkt<DQK>(pB0, pB1, (bf16_t*)((char*)K_lds + SHM_K), qr, r32, hi);
  finishSM(pA0, pA1, alA, l_reg, pa0, pa1, pa2, pa3); SBAR();
  pv_all<DV>(o, vb0, pa0, pa1, pa2, pa3); partialSM(pB0, pB1, m_reg, mnB, alB, C, thr_raw);
  __syncthreads(); RESC(alB);
  finishSM(pB0, pB1, alB, l_reg, pa0, pa1, pa2, pa3); SBAR();
  pv_all<DV>(o, vb0 + (int)SHM_V, pa0, pa1, pa2, pa3);
  if (hi == 0) li_l[r32] = l_reg; asm volatile("s_waitcnt lgkmcnt(0)" ::: "memory");
  float rli[16];
#pragma unroll
  for (int r = 0; r < 16; ++r) rli[r] = __builtin_amdgcn_rcpf(li_l[crow(r, hi)]);
  bf16_t* Ow = Ob + (long)(wid * QBLK) * ldo;
#pragma unroll
  for (int r = 0; r < 16; ++r) { const int orow = crow(r, hi);
#pragma unroll
    for (int d0 = 0; d0 < DV / 32; ++d0) Ow[(long)orow * ldo + d0 * 32 + r32] = (bf16_t)(cvtpk(o[d0][r] * rli[r], 0.f) & 0xffffu); }
  __syncthreads();
#undef SLOAD
#undef SWRITE
#undef SWAIT
#undef RESC
}
#undef SBAR

template <int DQK, int DV, bool QNORM>
__device__ __forceinline__ void attn_unit_naive(const bf16_t* Qb, int ldq, const bf16_t* Kh, int ldk, const bf16_t* Vh, int ldv, bf16_t* Ob, int ldo, int seq, float scale, const float* qgain, char* lds) {
  const int tid = threadIdx.x; float* ql = (float*)lds;
  if (tid < 256) {
    float ssq = 0.f;
    for (int d = 0; d < DQK; ++d) { const float v = pg8::bf2f(Qb[(long)tid * ldq + d]); ssq += v * v; }
    const float rs = QNORM ? 1.0f / sqrtf(ssq * (1.0f / DQK) + 1e-6f) : 1.f;
    for (int d = 0; d < DQK; ++d) { float v = pg8::bf2f(Qb[(long)tid * ldq + d]); if (QNORM) v = pg8::bf2f((bf16_t)(cvtpk(v * rs * qgain[d], 0.f) & 0xffffu)); ql[d * 256 + tid] = v; }
    float m = -1e30f, l = 0.f; float o[DV];
#pragma unroll
    for (int d = 0; d < DV; ++d) o[d] = 0.f;
    for (int k = 0; k < seq; ++k) { float s = 0.f;
      for (int d = 0; d < DQK; ++d) s += ql[d * 256 + tid] * pg8::bf2f(Kh[(long)k * ldk + d]);
      s *= scale; const float mn = fmaxf(m, s), al = __expf(m - mn), p = __expf(s - mn); l = l * al + p; m = mn;
#pragma unroll
      for (int d = 0; d < DV; ++d) o[d] = o[d] * al + p * pg8::bf2f(Vh[(long)k * ldv + d]); }
    const float il = 1.0f / l;
#pragma unroll
    for (int d = 0; d < DV; ++d) Ob[(long)tid * ldo + d] = (bf16_t)(cvtpk(o[d] * il, 0.f) & 0xffffu);
  }
  __syncthreads();
}
}

using pg8::bf16_t; using pg8::f32x4; using pg8::u32x4; using pg8::u32x2; using pg8::bf16x8; using pg8::bf2f; using pg8::bflo; using pg8::bfhi; using pg8::cvt_pk_bf16;
#define LAS __attribute__((address_space(3)))
constexpr int NBATCH = 2, SEQ = 8192, T = NBATCH * SEQ, DM = 1024, MEMLEN = 256, TM = NBATCH * MEMLEN;
constexpr int PROJ_LD = 1536, IN_COLS = 1440, DFF = 2816, DFF2 = 5632;
constexpr int NTHR = 512, NWAVES = 8;
constexpr float EPS = 1e-6f;
constexpr size_t MiB = 1u << 20;
constexpr size_t WS_SS = 1 * MiB, WS_WIN = 2 * MiB, WS_WUQ = 5 * MiB, WS_WUKV = 5 * MiB + 512 * 1024, WS_WG = 6 * MiB, WS_WOUT = 7 * MiB, WS_WMQ = 9 * MiB, WS_WMKV = 10 * MiB,
                 WS_WMO = 12 * MiB, WS_WUP = 13 * MiB, WS_WDN = 24 * MiB, WS_MEMN = 30 * MiB, WS_MEMKV = 31 * MiB, WS_XB = 32 * MiB, WS_KN = 32 * MiB, WS_AGG = 56 * MiB,
                 WS_PROJ = 64 * MiB, WS_CQ = 112 * MiB, WS_CKV = 120 * MiB, WS_XC = 124 * MiB, WS_QRAW = 156 * MiB, WS_KVRAW = 180 * MiB, WS_QN = 112 * MiB, WS_MLA = 136 * MiB,
                 WS_AMIX = 156 * MiB, WS_QMEM = 112 * MiB, WS_OMEM = 128 * MiB, WS_GU = 64 * MiB, WS_HID = 152 * MiB, WS_END = 240 * MiB;
constexpr int LDS_BYTES = 147456;

struct Args { const void* in[33]; float* out; unsigned char* ws; int ph_lo, ph_hi; };

struct Ctx {
    LAS unsigned char* lds; char* ldsg;
    int tid, lane, wave, bid, G;
};
#define WSP(type, off) ((type*)(args.ws + (off)))

__device__ __forceinline__ float wave_sum(float v) {
#pragma unroll
    for (int o = 1; o < 64; o <<= 1) v += __shfl_xor(v, o);
    return v;
}
__device__ __forceinline__ u32x4 pack8(const float* v) { u32x4 w; w.x = cvt_pk_bf16(v[0], v[1]); w.y = cvt_pk_bf16(v[2], v[3]); w.z = cvt_pk_bf16(v[4], v[5]); w.w = cvt_pk_bf16(v[6], v[7]); return w; }
__device__ __forceinline__ void unpack8(const u32x4 w, float* v) { v[0] = bflo(w.x); v[1] = bfhi(w.x); v[2] = bflo(w.y); v[3] = bfhi(w.y); v[4] = bflo(w.z); v[5] = bfhi(w.z); v[6] = bflo(w.w); v[7] = bfhi(w.w); }

__device__ __forceinline__ void p0_transpose_item(const float* W, const float* gain, int K, int N, bf16_t* WT, LAS float* scr, int item, int lane) {
    const int nblk = N / 32, kb = item / nblk, nb = item % nblk, k0 = 64 * kb, n0 = 32 * nb;
#pragma unroll 8
    for (int i = 0; i < 32; ++i) { const int kk = 2 * i + (lane >> 5); float v = W[(size_t)(k0 + kk) * N + n0 + (lane & 31)]; if (gain) v *= gain[k0 + kk]; scr[kk * 33 + (lane & 31)] = v; }
    asm volatile("s_waitcnt lgkmcnt(0)" ::: "memory");
    const int cch = lane & 7;
#pragma unroll
    for (int j = 0; j < 4; ++j) { const int n = (lane >> 3) + 8 * j; const LAS float* s = scr + (8 * cch) * 33 + n;
        u32x4 o; o.x = cvt_pk_bf16(s[0 * 33], s[1 * 33]); o.y = cvt_pk_bf16(s[2 * 33], s[3 * 33]); o.z = cvt_pk_bf16(s[4 * 33], s[5 * 33]); o.w = cvt_pk_bf16(s[6 * 33], s[7 * 33]);
        *(u32x4*)(WT + (size_t)(n0 + n) * K + k0 + 8 * cch) = o; }
    asm volatile("s_waitcnt lgkmcnt(0)" ::: "memory");
}
__device__ __forceinline__ void norm_row_1024(const float* xrow, const float* gain, bf16_t* orow, int lane) {
    const f32x4* xr = (const f32x4*)xrow + lane; const f32x4* gr = (const f32x4*)gain + lane;
    f32x4 v[4]; float s = 0.f;
#pragma unroll
    for (int j = 0; j < 4; ++j) { v[j] = xr[64 * j]; s += (v[j][0] * v[j][0] + v[j][1] * v[j][1]) + (v[j][2] * v[j][2] + v[j][3] * v[j][3]); }
    const float rs = 1.0f / sqrtf(wave_sum(s) * (1.0f / 1024.0f) + EPS);
#pragma unroll
    for (int j = 0; j < 4; ++j) { const f32x4 g = gr[64 * j]; u32x2 w; w.x = cvt_pk_bf16(v[j][0] * rs * g[0], v[j][1] * rs * g[1]); w.y = cvt_pk_bf16(v[j][2] * rs * g[2], v[j][3] * rs * g[3]);
        *((u32x2*)orow + lane + 64 * j) = w; }
}
__device__ __forceinline__ void phase0(Ctx& c, const Args& args) {
    LAS float* scr = (LAS float*)(c.lds + c.wave * 16384);
    const int gw = c.bid * NWAVES + c.wave, NGW = c.G * NWAVES;
    constexpr int I_IN = 16 * 45, I_UQ = 4 * 24, I_UKV = 2 * 32, I_OUT = 16 * 32, I_MQ = 16 * 16, I_MKV = 16 * 32, I_MO = 8 * 32, I_UP = 16 * 176, I_DN = 44 * 32;
    constexpr int NITEMS = I_IN + I_UQ + I_UKV + I_OUT + I_MQ + I_MKV + I_MO + I_UP + I_DN;
    for (int it = gw; it < NITEMS; it += NGW) {
        int r = it;
        if (r < I_IN) { p0_transpose_item(((const float*)args.in[4]), nullptr, 1024, IN_COLS, WSP(bf16_t, WS_WIN), scr, r, c.lane); continue; } r -= I_IN;
        if (r < I_UQ) { p0_transpose_item(((const float*)args.in[13]), nullptr, 256, 768, WSP(bf16_t, WS_WUQ), scr, r, c.lane); continue; } r -= I_UQ;
        if (r < I_UKV) { p0_transpose_item(((const float*)args.in[15]), nullptr, 128, 1024, WSP(bf16_t, WS_WUKV), scr, r, c.lane); continue; } r -= I_UKV;
        if (r < I_OUT) { p0_transpose_item(((const float*)args.in[20]), nullptr, 1024, 1024, WSP(bf16_t, WS_WOUT), scr, r, c.lane); continue; } r -= I_OUT;
        if (r < I_MQ) { p0_transpose_item(((const float*)args.in[23]), ((const float*)args.in[21]), 1024, 512, WSP(bf16_t, WS_WMQ), scr, r, c.lane); continue; } r -= I_MQ;
        if (r < I_MKV) { p0_transpose_item(((const float*)args.in[24]), nullptr, 1024, 1024, WSP(bf16_t, WS_WMKV), scr, r, c.lane); continue; } r -= I_MKV;
        if (r < I_MO) { p0_transpose_item(((const float*)args.in[27]), nullptr, 512, 1024, WSP(bf16_t, WS_WMO), scr, r, c.lane); continue; } r -= I_MO;
        if (r < I_UP) { p0_transpose_item(((const float*)args.in[29]), ((const float*)args.in[28]), 1024, DFF2, WSP(bf16_t, WS_WUP), scr, r, c.lane); continue; } r -= I_UP;
        p0_transpose_item(((const float*)args.in[32]), nullptr, DFF, 1024, WSP(bf16_t, WS_WDN), scr, r, c.lane);
    }
    const int gt = c.bid * NTHR + c.tid, NGT = c.G * NTHR;
    for (int i = gt; i < (PROJ_LD - IN_COLS) * 1024 / 8; i += NGT) *((u32x4*)(WSP(bf16_t, WS_WIN) + (size_t)IN_COLS * 1024) + i) = (u32x4){0u, 0u, 0u, 0u};
    for (int i = gt; i < 8 * 256 * 128; i += NGT) {
        const int k = i & 127, n = (i >> 7) & 255, grp = i >> 15, d = grp >> 2, png = grp & 3;
        const int gate = n >> 7, cl = n & 127, blk_n = cl >> 6, dout = cl & 63, blk_k = k >> 6, cin = k & 63;
        float v = 0.f;
        if (blk_n == blk_k) { const float* W = gate ? ((const float*)args.in[9]) : ((const float*)args.in[7]); v = W[((size_t)(d * 8 + png * 2 + blk_n) * 64 + cin) * 64 + dout]; }
        WSP(bf16_t, WS_WG)[i] = (bf16_t)(cvt_pk_bf16(v, 0.f) & 0xffffu);
    }
    for (int i = gt; i < 1024; i += NGT) WSP(float, 0)[i] = -8.0f * log1pf(expf(-((const float*)args.in[11])[i]));
    for (int m = gw; m < T + TM; m += NGW) {
        if (m < T) norm_row_1024(((const float*)args.in[0]) + (size_t)m * DM, ((const float*)args.in[3]), WSP(bf16_t, WS_XB) + (size_t)m * DM, c.lane);
        else norm_row_1024(((const float*)args.in[1]) + (size_t)(m - T) * DM, ((const float*)args.in[22]), WSP(bf16_t, WS_MEMN) + (size_t)(m - T) * DM, c.lane);
    }
}

__device__ __forceinline__ void phase2(Ctx& c, const Args& args) {
    const int gw = c.bid * NWAVES + c.wave, NGW = c.G * NWAVES, lane = c.lane;
    const bf16_t* proj = WSP(bf16_t, WS_PROJ);
    for (int row = gw; row < T + TM; row += NGW) {
        if (row >= T) {
            bf16_t* kp = WSP(bf16_t, WS_MEMKV) + (size_t)(row - T) * 1024 + lane * 8; float v[8]; unpack8(*(const u32x4*)kp, v);
            float s = 0.f;
#pragma unroll
            for (int e = 0; e < 8; ++e) s += v[e] * v[e];
            s += __shfl_xor(s, 1); s += __shfl_xor(s, 2); s += __shfl_xor(s, 4); s += __shfl_xor(s, 8);
            const float rs = 1.0f / sqrtf(s * (1.0f / 128.0f) + EPS);
#pragma unroll
            for (int e = 0; e < 8; ++e) v[e] *= rs * ((const float*)args.in[26])[(lane & 15) * 8 + e];
            *(u32x4*)kp = pack8(v);
            continue;
        }
        const bf16_t* pr = proj + (size_t)row * PROJ_LD;
        {
            const u32x2 w = *(const u32x2*)(pr + 1024 + lane * 4); float v[4] = {bflo(w.x), bfhi(w.x), bflo(w.y), bfhi(w.y)};
            const float rs = 1.0f / sqrtf(wave_sum((v[0] * v[0] + v[1] * v[1]) + (v[2] * v[2] + v[3] * v[3])) * (1.0f / 256.0f) + EPS);
            const f32x4 g = *(const f32x4*)(((const float*)args.in[12]) + lane * 4); u32x2 o; o.x = cvt_pk_bf16(v[0] * rs * g[0], v[1] * rs * g[1]); o.y = cvt_pk_bf16(v[2] * rs * g[2], v[3] * rs * g[3]);
            *(u32x2*)(WSP(bf16_t, WS_CQ) + (size_t)row * 256 + lane * 4) = o;
        }
        {
            const unsigned w = *(const unsigned*)(pr + 1280 + lane * 2); const float v0 = bflo(w), v1 = bfhi(w);
            const float rs = 1.0f / sqrtf(wave_sum(v0 * v0 + v1 * v1) * (1.0f / 128.0f) + EPS);
            *(unsigned*)(WSP(bf16_t, WS_CKV) + (size_t)row * 128 + lane * 2) = cvt_pk_bf16(v0 * rs * ((const float*)args.in[14])[lane * 2], v1 * rs * ((const float*)args.in[14])[lane * 2 + 1]);
        }
        {
            const int t = row & (SEQ - 1), ch = lane * 8;
            float xs[7][8];
#pragma unroll
            for (int dt = -3; dt <= 3; ++dt) { const int tt = t + dt;
                if (tt >= 0 && tt < SEQ) unpack8(*(const u32x4*)(pr + (long)dt * PROJ_LD + ch), xs[dt + 3]);
                else {
#pragma unroll
                    for (int e = 0; e < 8; ++e) xs[dt + 3][e] = 0.f; } }
            float of[8], ob[8];
#pragma unroll
            for (int e = 0; e < 8; ++e) { of[e] = ((const float*)args.in[6])[ch + e]; ob[e] = ((const float*)args.in[6])[512 + ch + e]; }
#pragma unroll
            for (int k = 0; k < 4; ++k)
#pragma unroll
                for (int e = 0; e < 8; ++e) { of[e] += ((const float*)args.in[5])[(0 * 4 + k) * 512 + ch + e] * xs[k][e]; ob[e] += ((const float*)args.in[5])[(1 * 4 + k) * 512 + ch + e] * xs[3 + k][e]; }
            *(u32x4*)(WSP(bf16_t, WS_XC) + (size_t)row * 512 + ch) = pack8(of);
            *(u32x4*)(WSP(bf16_t, WS_XC) + ((size_t)T + row) * 512 + ch) = pack8(ob);
        }
    }
}

__device__ __forceinline__ void phase4(Ctx& c, const Args& args) {
    const int gw = c.bid * NWAVES + c.wave, NGW = c.G * NWAVES, lane = c.lane, h = lane >> 3, sub = lane & 7;
    const bf16_t* proj = WSP(bf16_t, WS_PROJ); const bf16_t* qraw = WSP(bf16_t, WS_QRAW); const bf16_t* kvraw = WSP(bf16_t, WS_KVRAW);
    bf16_t* Qn = WSP(bf16_t, WS_QN); bf16_t* Kn = WSP(bf16_t, WS_KN);
    for (int row = gw; row < T; row += NGW) {
        const float posf = (float)((const int*)args.in[2])[row]; float cs[2], sn[2];
#pragma unroll
        for (int jj = 0; jj < 2; ++jj) { const int j = 2 * sub + jj; const float inv = exp2f(-(float)j * 0.8304820237218406f);
            const float ang = posf * inv; const double rev = (double)ang * 0.15915494309189535; const float fr = (float)(rev - rint(rev));
            cs[jj] = __builtin_amdgcn_cosf(fr); sn[jj] = __builtin_amdgcn_sinf(fr); }
#pragma unroll
        for (int which = 0; which < 2; ++which) {
            const bf16_t* np = which ? kvraw + (size_t)row * 1024 + h * 128 + sub * 8 : qraw + (size_t)row * 768 + h * 96 + sub * 8;
            const bf16_t* rp = which ? proj + (size_t)row * PROJ_LD + 1408 + 2 * sub : qraw + (size_t)row * 768 + h * 96 + 64 + 2 * sub;
            const float* gain = which ? ((const float*)args.in[17]) : ((const float*)args.in[16]);
            float v[8]; unpack8(*(const u32x4*)np, v); const unsigned r1 = *(const unsigned*)rp, r2 = *(const unsigned*)(rp + 16);
            float t1[2] = {bflo(r1), bfhi(r1)}, t2[2] = {bflo(r2), bfhi(r2)};
            float s = (t1[0] * t1[0] + t1[1] * t1[1]) + (t2[0] * t2[0] + t2[1] * t2[1]);
#pragma unroll
            for (int e = 0; e < 8; ++e) s += v[e] * v[e];
            s += __shfl_xor(s, 1); s += __shfl_xor(s, 2); s += __shfl_xor(s, 4);
            const float rs = 1.0f / sqrtf(s * (1.0f / 96.0f) + EPS);
#pragma unroll
            for (int e = 0; e < 8; ++e) v[e] *= rs * gain[sub * 8 + e];
#pragma unroll
            for (int jj = 0; jj < 2; ++jj) { t1[jj] *= rs * gain[64 + 2 * sub + jj]; t2[jj] *= rs * gain[80 + 2 * sub + jj]; }
            float o1[2], o2[2];
#pragma unroll
            for (int jj = 0; jj < 2; ++jj) { o1[jj] = t1[jj] * cs[jj] - t2[jj] * sn[jj]; o2[jj] = t1[jj] * sn[jj] + t2[jj] * cs[jj]; }
            bf16_t* op = (which ? Kn : Qn) + (size_t)row * 768 + h * 96;
            *(u32x4*)(op + sub * 8) = pack8(v);
            *(unsigned*)(op + 64 + 2 * sub) = cvt_pk_bf16(o1[0], o1[1]);
            *(unsigned*)(op + 80 + 2 * sub) = cvt_pk_bf16(o2[0], o2[1]);
        }
    }
    const unsigned* Gt = (const unsigned*)args.out; float2* agg = WSP(float2, WS_AGG);
    for (int it = c.bid; it < 512; it += c.G) {
        const int d = it >> 8, chunk = it & 255; const unsigned* gp = Gt + ((size_t)d * T + (size_t)chunk * 64) * 512 + c.tid;
        float sl = 0.f, bv = 0.f;
#pragma unroll 16
        for (int i = 0; i < 64; ++i) { const int tt = d ? 63 - i : i; const unsigned w = gp[(size_t)tt * 512]; const float la = bflo(w); sl += la; bv = __expf(la) * bv + bfhi(w); }
        agg[(size_t)it * 512 + c.tid] = make_float2(sl, bv);
    }
}

__device__ __forceinline__ float gelu_tanh(float y) { const float u = 0.7978845608028654f * (y + 0.044715f * y * y * y); const float th = 1.0f - 2.0f / (__expf(2.0f * u) + 1.0f); return 0.5f * y * (1.0f + th); }
__device__ __forceinline__ void phase6(Ctx& c, const Args& args) {
    const unsigned* Gt = (const unsigned*)args.out; const float2* agg = WSP(float2, WS_AGG); const bf16_t* proj = WSP(bf16_t, WS_PROJ);
    LAS float* hl = (LAS float*)c.lds;
    bf16_t* amix = WSP(bf16_t, WS_AMIX); const bf16_t* mla = WSP(bf16_t, WS_MLA);
    const int ch = c.tid;
    for (int chunk = c.bid; chunk < 256; chunk += c.G) {
        const int b = chunk >> 7, cc = chunk & 127;
        float cf = 0.f, cb = 0.f;
#pragma unroll 8
        for (int q = 0; q < cc; ++q) { const float2 a = agg[((size_t)b * 128 + q) * 512 + ch]; cf = __expf(a.x) * cf + a.y; }
#pragma unroll 8
        for (int q = 127; q > cc; --q) { const float2 a = agg[((size_t)256 + b * 128 + q) * 512 + ch]; cb = __expf(a.x) * cb + a.y; }
        const size_t row0 = (size_t)chunk * 64;
        { const unsigned* gp = Gt + row0 * 512 + ch; float hcur = cf;
#pragma unroll 16
          for (int i = 0; i < 64; ++i) { const unsigned w = gp[(size_t)i * 512]; hcur = __expf(bflo(w)) * hcur + bfhi(w); hl[i * 512 + ch] = hcur; } }
        { const unsigned* gp = Gt + ((size_t)T + row0) * 512 + ch; const bf16_t* yp = proj + row0 * PROJ_LD + 512 + ch; float hcur = cb;
#pragma unroll 16
          for (int i = 63; i >= 0; --i) { const unsigned w = gp[(size_t)i * 512]; hcur = __expf(bflo(w)) * hcur + bfhi(w); const float y = bf2f(yp[(size_t)i * PROJ_LD]);
              hl[i * 512 + ch] = (hl[i * 512 + ch] + hcur) * gelu_tanh(y); } }
        __syncthreads();
#pragma unroll
        for (int rr = 0; rr < 8; ++rr) { const int r = c.wave * 8 + rr; const size_t row = row0 + r;
            float v[8]; { const LAS f32x4* p = (const LAS f32x4*)(hl + r * 512 + c.lane * 8); const f32x4 a = p[0], bq = p[1]; v[0] = a[0]; v[1] = a[1]; v[2] = a[2]; v[3] = a[3]; v[4] = bq[0]; v[5] = bq[1]; v[6] = bq[2]; v[7] = bq[3]; }
            float s = 0.f;
#pragma unroll
            for (int e = 0; e < 8; ++e) s += v[e] * v[e];
            float rs = 1.0f / sqrtf(wave_sum(s) * (1.0f / 512.0f) + EPS);
#pragma unroll
            for (int e = 0; e < 8; ++e) v[e] *= rs * ((const float*)args.in[18])[c.lane * 8 + e];
            *(u32x4*)(amix + row * 1024 + c.lane * 8) = pack8(v);
            unpack8(*(const u32x4*)(mla + row * 512 + c.lane * 8), v); s = 0.f;
#pragma unroll
            for (int e = 0; e < 8; ++e) s += v[e] * v[e];
            rs = 1.0f / sqrtf(wave_sum(s) * (1.0f / 512.0f) + EPS);
#pragma unroll
            for (int e = 0; e < 8; ++e) v[e] *= rs * ((const float*)args.in[19])[c.lane * 8 + e];
            *(u32x4*)(amix + row * 1024 + 512 + c.lane * 8) = pack8(v);
        }
        __syncthreads();
    }
}

__device__ __forceinline__ void phase12(Ctx& c, const Args& args, int bsel) {
    const bf16_t* gu = WSP(bf16_t, WS_GU); bf16_t* hid = WSP(bf16_t, WS_HID) + (size_t)bsel * SEQ * DFF;
    const int NI = SEQ * (DFF / 8);
    for (int it = c.bid * NTHR + c.tid; it < NI; it += c.G * NTHR) {
        const int t = it / (DFF / 8), j = (it % (DFF / 8)) * 8;
        float g[8], u[8];
#pragma unroll
        for (int e = 0; e < 8; ++e) { g[e] = ((const float*)args.in[31])[j + e]; u[e] = ((const float*)args.in[31])[DFF + j + e]; }
#pragma unroll
        for (int k = 0; k < 3; ++k) { const int tt = t + k - 1; if (tt < 0 || tt >= SEQ) continue;
            float a[8], bq[8]; unpack8(*(const u32x4*)(gu + (size_t)tt * DFF2 + j), a); unpack8(*(const u32x4*)(gu + (size_t)tt * DFF2 + DFF + j), bq);
#pragma unroll
            for (int e = 0; e < 8; ++e) { g[e] += ((const float*)args.in[30])[(size_t)k * DFF2 + j + e] * a[e]; u[e] += ((const float*)args.in[30])[(size_t)k * DFF2 + DFF + j + e] * bq[e]; } }
        float o[8];
#pragma unroll
        for (int e = 0; e < 8; ++e) o[e] = g[e] / (1.0f + __expf(-g[e])) * u[e];
        *(u32x4*)(hid + (size_t)t * DFF + j) = pack8(o);
    }
}

template <class Epi, class Sched> __device__ __forceinline__ void run_gemm(Ctx& c, const pg8::Gemm g, const Sched& S, const Epi& E) {
#if FAST_GEMM
    pg8::gemm_phase<Epi, Sched, true, true>(c.lds, g, S, E);
#else
    pg8::gemm_naive<Epi, Sched>(g, S, E);
#endif
}
__device__ __forceinline__ pg8::Sched2 sched1(Ctx& c, const void* A, const void* B, int nM, int nN, int lda, int ldb) {
    pg8::Sched2 s; s.a = pg8::Job{(const char*)A, (const char*)B, nM, nN}; s.b = pg8::Job{nullptr, nullptr, 0, 0}; s.G = c.G; s.c = c.bid; s.lda = lda; s.ldb = ldb; return s;
}
template <int DQK, int DV, bool QNORM> __device__ __forceinline__ void run_attn(Ctx& c, const bf16_t* Qb, int ldq, const bf16_t* Kh, int ldk, const bf16_t* Vh, int ldv, bf16_t* Ob, int ldo, int seq, float scale, const float* qg) {
#if FAST_ATTN
    att::attn_unit<DQK, DV, QNORM>(Qb, ldq, Kh, ldk, Vh, ldv, Ob, ldo, seq, scale, qg, c.ldsg);
#else
    att::attn_unit_naive<DQK, DV, QNORM>(Qb, ldq, Kh, ldk, Vh, ldv, Ob, ldo, seq, scale, qg, c.ldsg);
#endif
}

constexpr int N_PHASES = 16;
__global__ void __launch_bounds__(NTHR) fwd_kernel(Args args) {
    extern __shared__ __attribute__((aligned(16))) unsigned char lds_raw[];
    cg::grid_group grid = cg::this_grid();
    Ctx c;
    c.lds = (LAS unsigned char*)lds_raw; c.ldsg = (char*)lds_raw;
    c.tid = threadIdx.x; c.lane = c.tid & 63; c.wave = __builtin_amdgcn_readfirstlane(c.tid >> 6); c.bid = blockIdx.x; c.G = gridDim.x;
    const int lo = args.ph_lo, hi = args.ph_hi;
#ifndef PH_MASK
#define PH_MASK 0xFFFF
#endif
#define IN(k) (((PH_MASK >> (k)) & 1) && lo <= (k) && (k) < hi)
#define SEAM(k) do { if (IN(k) && IN((k) + 1)) grid.sync(); } while (0)

    if (IN(0)) { phase0(c, args); } SEAM(0);
    if (IN(1)) {
        pg8::Sched2 S; S.a = pg8::Job{(const char*)WSP(bf16_t, WS_XB), (const char*)WSP(bf16_t, WS_WIN), T / 256, PROJ_LD / 256};
        S.b = pg8::Job{(const char*)WSP(bf16_t, WS_MEMN), (const char*)WSP(bf16_t, WS_WMKV), TM / 256, 4}; S.G = c.G; S.c = c.bid; S.lda = 1024; S.ldb = 1024;
        pg8::EpiBf<false> E{WSP(bf16_t, WS_PROJ), PROJ_LD, WSP(bf16_t, WS_MEMKV), 1024, nullptr};
        run_gemm(c, pg8::Gemm{1024, 1024, 1024}, S, E);
    } SEAM(1);
    if (IN(2)) { phase2(c, args); } SEAM(2);
    if (IN(3)) {
#ifndef P3SEL
#define P3SEL 7
#endif
        if (P3SEL & 1) { pg8::Sched2 S = sched1(c, WSP(bf16_t, WS_CQ), WSP(bf16_t, WS_WUQ), T / 256, 3, 256, 256); pg8::EpiBf<false> E{WSP(bf16_t, WS_QRAW), 768, nullptr, 0, nullptr}; run_gemm(c, pg8::Gemm{256, 256, 256}, S, E); }
        if (P3SEL & 2) { pg8::Sched2 S = sched1(c, WSP(bf16_t, WS_CKV), WSP(bf16_t, WS_WUKV), T / 256, 4, 128, 128); pg8::EpiBf<false> E{WSP(bf16_t, WS_KVRAW), 1024, nullptr, 0, nullptr}; run_gemm(c, pg8::Gemm{128, 128, 128}, S, E); }
        if (P3SEL & 4) { pg8::GateOrder S{(const char*)WSP(bf16_t, WS_XC), (const char*)WSP(bf16_t, WS_WG), (size_t)T * 512 * 2, c.G, c.bid};
          pg8::EpiGates E{WSP(bf16_t, WS_XC), ((const float*)args.in[8]), ((const float*)args.in[10]), WSP(float, 0), (unsigned*)args.out, T}; run_gemm(c, pg8::Gemm{128, 512, 128}, S, E); }
    } SEAM(3);
    if (IN(4)) { phase4(c, args); } SEAM(4);
    if (IN(5)) {
        for (int L = c.bid; L < 512; L += c.G) { const int bh = (L >> 8) * 8 + (L & 7), qb = (L & 255) >> 3; const int b = bh >> 3, h = bh & 7;
            run_attn<96, 64, false>(c, WSP(bf16_t, WS_QN) + ((size_t)b * SEQ + qb * 256) * 768 + h * 96, 768, WSP(bf16_t, WS_KN) + (size_t)b * SEQ * 768 + h * 96, 768,
                                    WSP(bf16_t, WS_KVRAW) + (size_t)b * SEQ * 1024 + h * 128 + 64, 1024, WSP(bf16_t, WS_MLA) + ((size_t)b * SEQ + qb * 256) * 512 + h * 64, 512, SEQ, 0.10206207261596575f, nullptr); }
    } SEAM(5);
    if (IN(6)) { phase6(c, args); } SEAM(6);
    if (IN(7)) {
        pg8::Sched2 S = sched1(c, WSP(bf16_t, WS_AMIX), WSP(bf16_t, WS_WOUT), T / 256, 4, 1024, 1024); pg8::EpiResid<true> E{((const float*)args.in[0]), args.out, WSP(bf16_t, WS_XB), WSP(float, WS_SS)};
        run_gemm(c, pg8::Gemm{1024, 1024, 1024}, S, E);
    } SEAM(7);
    if (IN(8)) {
        pg8::Sched2 S = sched1(c, WSP(bf16_t, WS_XB), WSP(bf16_t, WS_WMQ), T / 256, 2, 1024, 1024); pg8::EpiBf<true> E{WSP(bf16_t, WS_QMEM), 512, nullptr, 0, WSP(float, WS_SS)};
        run_gemm(c, pg8::Gemm{1024, 1024, 1024}, S, E);
    } SEAM(8);
    if (IN(9)) {
        for (int L = c.bid; L < 256; L += c.G) { const int rb = L >> 2, h = L & 3, b = rb >> 5;
            run_attn<128, 128, true>(c, WSP(bf16_t, WS_QMEM) + (size_t)rb * 256 * 512 + h * 128, 512, WSP(bf16_t, WS_MEMKV) + (size_t)b * MEMLEN * 1024 + h * 128, 1024,
                                     WSP(bf16_t, WS_MEMKV) + (size_t)b * MEMLEN * 1024 + 512 + h * 128, 1024, WSP(bf16_t, WS_OMEM) + (size_t)rb * 256 * 512 + h * 128, 512, MEMLEN, 0.08838834764831845f, ((const float*)args.in[25])); }
    } SEAM(9);
    if (IN(10)) {
        pg8::Sched2 S = sched1(c, WSP(bf16_t, WS_OMEM), WSP(bf16_t, WS_WMO), T / 256, 4, 512, 512); pg8::EpiResid<true> E{args.out, args.out, WSP(bf16_t, WS_XB), WSP(float, WS_SS)};
        run_gemm(c, pg8::Gemm{512, 512, 512}, S, E);
    } SEAM(10);
#pragma unroll 1
    for (int bsel = 0; bsel < 2; ++bsel) {
        if (IN(11 + 2 * bsel)) {
            pg8::Sched2 S = sched1(c, WSP(bf16_t, WS_XB) + (size_t)bsel * SEQ * 1024, WSP(bf16_t, WS_WUP), SEQ / 256, DFF2 / 256, 1024, 1024);
            pg8::EpiBf<true> E{WSP(bf16_t, WS_GU), DFF2, nullptr, 0, WSP(float, WS_SS) + (size_t)bsel * SEQ * 16};
            run_gemm(c, pg8::Gemm{1024, 1024, 1024}, S, E);
        } SEAM(11 + 2 * bsel);
        if (IN(12 + 2 * bsel)) { phase12(c, args, bsel); } SEAM(12 + 2 * bsel);
    }
    if (IN(15)) {
        pg8::Sched2 S = sched1(c, WSP(bf16_t, WS_HID), WSP(bf16_t, WS_WDN), T / 256, 4, DFF, DFF); pg8::EpiResid<false> E{args.out, args.out, nullptr, nullptr};
        run_gemm(c, pg8::Gemm{DFF, DFF, DFF}, S, E);
    }
#undef IN
#undef SEAM
}

#ifndef N_LAUNCHES
#define N_LAUNCHES 1
#endif
extern "C" void kernel_launch(void* const* d_in, const int* in_sizes, int n_in, void* d_out, int out_size, void* d_ws, size_t ws_size, hipStream_t stream) {
    static int grid = 0;
    if (grid == 0) {
        if (n_in != 33 || in_sizes[0] != T * DM || out_size != T * DM || ws_size < WS_END) { fprintf(stderr, "kernel_launch: unexpected shapes (n_in %d, in0 %d, out %d, ws %zu)\n", n_in, n_in > 0 ? in_sizes[0] : -1, out_size, ws_size); grid = -1; return; }
        int dev = 0, cus = 0, per_cu = 0;
        if (hipGetDevice(&dev) != hipSuccess || hipDeviceGetAttribute(&cus, hipDeviceAttributeMultiprocessorCount, dev) != hipSuccess) { grid = -1; return; }
        if (hipFuncSetAttribute((const void*)fwd_kernel, hipFuncAttributeMaxDynamicSharedMemorySize, LDS_BYTES) != hipSuccess) { fprintf(stderr, "kernel_launch: hipFuncSetAttribute failed\n"); grid = -1; return; }
        if (hipOccupancyMaxActiveBlocksPerMultiprocessor(&per_cu, (const void*)fwd_kernel, NTHR, LDS_BYTES) != hipSuccess || per_cu < 1) { fprintf(stderr, "kernel_launch: occupancy query says %d\n", per_cu); per_cu = 1; }
        (void)hipGetLastError();
        if (per_cu > 1) per_cu = 1;
        grid = cus * per_cu;
    }
    if (grid < 0) return;
    Args a{};
    for (int i = 0; i < 33; ++i) a.in[i] = d_in[i];
    a.out = (float*)d_out; a.ws = (unsigned char*)d_ws;
#if N_LAUNCHES == 1
    a.ph_lo = 0; a.ph_hi = N_PHASES;
    void* kargs[] = {&a};
    const hipError_t e = hipLaunchCooperativeKernel((const void*)fwd_kernel, dim3(grid), dim3(NTHR), kargs, LDS_BYTES, stream);
    if (e != hipSuccess) fprintf(stderr, "kernel_launch: cooperative launch failed: %s (grid %d)\n", hipGetErrorString(e), grid);
#else
    for (int p = 0; p < N_PHASES; ++p) { a.ph_lo = p; a.ph_hi = p + 1; hipLaunchKernelGGL(fwd_kernel, dim3(grid), dim3(NTHR), LDS_BYTES, stream, a); }
#endif
}
```

```cpp
#include <hip/hip_runtime.h>
#include <hip/hip_cooperative_groups.h>
#include <cstdio>
#include <cstdint>
namespace cg = cooperative_groups;

#ifndef FAST_GEMM
#define FAST_GEMM 1
#endif
#ifndef FAST_ATTN
#define FAST_ATTN 1
#endif

namespace pg8 {
#define PG8_LAS __attribute__((address_space(3)))
typedef unsigned short bf16_t;
typedef short bf16x8 __attribute__((ext_vector_type(8)));
typedef float f32x4 __attribute__((ext_vector_type(4)));
typedef unsigned u32x4 __attribute__((ext_vector_type(4)));
constexpr int BM = 256, BK = 64, HALF = 128, HTB = HALF * BK * 2  , STAGE_BYTES = 8 * HTB, NXCD = 8, WGM = 8;

__host__ __device__ __forceinline__ int lds_byte(int r, int c) { const int st = (r >> 4) * 2 + (c >> 5), rr = r & 15, cc = c & 31, ob = rr * 64 + cc * 2; return st * 1024 + (ob ^ (((ob >> 9) & 1) << 5)); }
__host__ __device__ __forceinline__ void stage_rc(int b, int& R, int& C) { const int st = b / 1024, sb = b % 1024, swz = sb ^ (((sb >> 9) & 1) << 5); R = (st >> 1) * 16 + swz / 64; C = (st & 1) * 32 + (swz % 64) / 2; }
__host__ __device__ __forceinline__ int perm32(int rho) { const int n = rho >> 4, i = rho & 15; return 8 * (i >> 2) + 4 * n + (i & 3); }

typedef unsigned u32x2 __attribute__((ext_vector_type(2)));
struct Unit { int pm, pn, job; const char* A; const char* B; };
struct Gemm { int K, lda, ldb; };

template <class Epi, class Sched, bool ALIGN_EPI = false, bool SP2 = false>
__device__ __forceinline__ void gemm_phase(PG8_LAS unsigned char* lds, const Gemm g, const Sched& S, const Epi& E) {
    const int tid = threadIdx.x, wid = __builtin_amdgcn_readfirstlane(tid >> 6), lane = tid & 63, wr = wid >> 2, wc = wid & 3, fr = lane & 15, fq = lane >> 4;
    int Kopq = g.K; asm volatile("" : "+s"(Kopq));
    const int K = Kopq, nt = K / BK;
    unsigned voffA[2], voffB[2];
#pragma unroll
    for (int i = 0; i < 2; ++i) { int R, C; stage_rc(tid * 16 + i * 8192, R, C); const int Rb = Epi::PERM ? ((R & ~31) + perm32(R & 31)) : R;
        voffA[i] = (unsigned)(R * g.lda + C) * 2u; voffB[i] = (unsigned)(Rb * g.ldb + C) * 2u; }
    const size_t kstep = (size_t)(BK * 2);
    const size_t hstepA = (size_t)HALF * g.lda * 2, hstepB = (size_t)HALF * g.ldb * 2;
    const unsigned ldsw = (unsigned)wid * 1024u;
    const int aoff = lds_byte(wr * 64 + fr, fq * 8), boff = lds_byte(wc * 32 + fr, fq * 8);
#define PG8_SA(b, h) (((b) * 2 + (h)) * HTB)
#define PG8_SB(b, h) ((4 + (b) * 2 + (h)) * HTB)
#define PG8_STAGE(bufoff, gbase, voff) do { _Pragma("unroll") for (int _i = 0; _i < 2; ++_i) \
        __builtin_amdgcn_global_load_lds((const unsigned*)((const char*)(gbase) + (voff)[_i]), (PG8_LAS unsigned*)(lds + (bufoff) + ldsw + _i * 8192), 16, 0, 0); } while (0)
#define PG8_LDA(dst, b, h) do { _Pragma("unroll") for (int m = 0; m < 4; ++m) _Pragma("unroll") for (int k = 0; k < 2; ++k) dst[m][k] = *(const PG8_LAS bf16x8*)(lds + PG8_SA(b, h) + aoff + m * 2048 + k * 1024); } while (0)
#define PG8_LDB(dst, b, h) do { _Pragma("unroll") for (int n = 0; n < 2; ++n) _Pragma("unroll") for (int k = 0; k < 2; ++k) dst[n][k] = *(const PG8_LAS bf16x8*)(lds + PG8_SB(b, h) + boff + n * 2048 + k * 1024); } while (0)
#define PG8_MMA(ai, bj, At, Bt) do { __builtin_amdgcn_s_setprio(1); _Pragma("unroll") for (int m = 0; m < 4; ++m) _Pragma("unroll") for (int n = 0; n < 2; ++n) _Pragma("unroll") for (int k = 0; k < 2; ++k) \
        acc[ai][bj][m][n] = __builtin_amdgcn_mfma_f32_16x16x32_bf16(Bt[n][k], At[m][k], acc[ai][bj][m][n], 0, 0, 0); __builtin_amdgcn_s_setprio(0); } while (0)
#define PG8_WAIT_V(n) asm volatile("s_waitcnt vmcnt(" #n ")" ::: "memory")
#define PG8_WAIT_L(n) asm volatile("s_waitcnt lgkmcnt(" #n ")" ::: "memory")
#define PG8_BAR __builtin_amdgcn_s_barrier()
#define PG8_SCHED __builtin_amdgcn_sched_barrier(0)
    Unit cur, nxt; int ui = 0;
    if (!S.next(0, cur)) return;
    f32x4 acc[2][2][4][2];
#pragma unroll
    for (int a = 0; a < 2; ++a)
#pragma unroll
        for (int b = 0; b < 2; ++b)
#pragma unroll
            for (int m = 0; m < 4; ++m)
#pragma unroll
                for (int n = 0; n < 2; ++n) acc[a][b][m][n] = (f32x4){0.f, 0.f, 0.f, 0.f};
    bf16x8 At[4][2], B0[2][2], B1[2][2];
    const char* cA = cur.A; const char* cB = cur.B;
    S.a_ready(cur);
    if constexpr (SP2) {
        PG8_STAGE(PG8_SB(0, 0), cB, voffB); PG8_STAGE(PG8_SB(0, 1), cB + hstepB, voffB); PG8_STAGE(PG8_SA(0, 0), cA, voffA); PG8_STAGE(PG8_SA(0, 1), cA + hstepA, voffA);
        if (wr == 1) PG8_BAR;
        PG8_WAIT_V(2); PG8_BAR;
        PG8_STAGE(PG8_SB(1, 0), cB + kstep, voffB); PG8_STAGE(PG8_SA(1, 0), cA + kstep, voffA); PG8_STAGE(PG8_SB(1, 1), cB + hstepB + kstep, voffB);
        PG8_WAIT_V(6); PG8_BAR;
    } else {
        PG8_STAGE(PG8_SB(0, 0), cB, voffB); PG8_STAGE(PG8_SA(0, 0), cA, voffA); PG8_STAGE(PG8_SB(0, 1), cB + hstepB, voffB); PG8_STAGE(PG8_SA(0, 1), cA + hstepA, voffA);
        if (wr == 1) PG8_BAR;
        PG8_WAIT_V(4); PG8_BAR;
        PG8_STAGE(PG8_SB(1, 0), cB + kstep, voffB); PG8_STAGE(PG8_SA(1, 0), cA + kstep, voffA); PG8_STAGE(PG8_SB(1, 1), cB + hstepB + kstep, voffB);
        PG8_WAIT_V(6); PG8_BAR;
    }
    for (;;) {
        const bool has_next = S.next(ui + 1, nxt);
        const char* nA = has_next ? nxt.A : cA; const char* nB = has_next ? nxt.B : cB;
        for (int t = 0; t < nt; t += 2) {
            const bool last = (t == nt - 2);
            const char* a1 = cA + (size_t)(t + 1) * kstep;
            const char* a2 = last ? nA : cA + (size_t)(t + 2) * kstep; const char* b2 = last ? nB : cB + (size_t)(t + 2) * kstep;
            const char* a3 = a2 + kstep; const char* b3 = b2 + kstep;
            if (last && has_next) S.a_ready(nxt);
            if constexpr (SP2) {
            PG8_LDB(B0, 0, 0); PG8_LDB(B1, 0, 1); PG8_SCHED; PG8_LDA(At, 0, 0); PG8_STAGE(PG8_SA(1, 1), a1 + hstepA, voffA);
            PG8_WAIT_V(8); PG8_WAIT_L(0); PG8_BAR; PG8_MMA(0, 0, At, B0); PG8_MMA(0, 1, At, B1); PG8_BAR; PG8_SCHED;
            PG8_LDA(At, 0, 1); PG8_STAGE(PG8_SB(0, 0), b2, voffB); PG8_STAGE(PG8_SB(0, 1), b2 + hstepB, voffB); PG8_STAGE(PG8_SA(0, 0), a2, voffA);
            PG8_WAIT_V(8); PG8_WAIT_L(0); PG8_BAR; PG8_MMA(1, 0, At, B0); PG8_MMA(1, 1, At, B1); PG8_BAR; PG8_SCHED;
            PG8_LDB(B0, 1, 0); PG8_LDB(B1, 1, 1); PG8_SCHED; PG8_LDA(At, 1, 0); PG8_STAGE(PG8_SA(0, 1), a2 + hstepA, voffA);
            PG8_WAIT_V(8); PG8_WAIT_L(0); PG8_BAR; PG8_MMA(0, 0, At, B0); PG8_MMA(0, 1, At, B1); PG8_BAR; PG8_SCHED;
            PG8_LDA(At, 1, 1); PG8_STAGE(PG8_SB(1, 0), b3, voffB); PG8_STAGE(PG8_SB(1, 1), b3 + hstepB, voffB); PG8_STAGE(PG8_SA(1, 0), a3, voffA);
            PG8_WAIT_V(8); PG8_WAIT_L(0); PG8_BAR; PG8_MMA(1, 0, At, B0); PG8_MMA(1, 1, At, B1); PG8_BAR; PG8_SCHED;
            } else {
            PG8_LDB(B0, 0, 0); PG8_SCHED; PG8_LDA(At, 0, 0); PG8_STAGE(PG8_SA(1, 1), a1 + hstepA, voffA);
            PG8_WAIT_L(8); PG8_BAR; PG8_WAIT_L(0); PG8_MMA(0, 0, At, B0); PG8_BAR; PG8_SCHED;
            PG8_LDB(B1, 0, 1); PG8_STAGE(PG8_SB(0, 0), b2, voffB);
            PG8_BAR; PG8_WAIT_L(0); PG8_MMA(0, 1, At, B1); PG8_BAR;
            PG8_LDA(At, 0, 1); PG8_STAGE(PG8_SA(0, 0), a2, voffA);
            PG8_BAR; PG8_WAIT_L(0); PG8_MMA(1, 0, At, B0); PG8_BAR; PG8_SCHED;
            PG8_STAGE(PG8_SB(0, 1), b2 + hstepB, voffB);
            PG8_WAIT_V(6); PG8_BAR; PG8_MMA(1, 1, At, B1); PG8_BAR;
            PG8_LDB(B0, 1, 0); PG8_SCHED; PG8_LDA(At, 1, 0); PG8_STAGE(PG8_SA(0, 1), a2 + hstepA, voffA);
            PG8_WAIT_L(8); PG8_BAR; PG8_WAIT_L(0); PG8_MMA(0, 0, At, B0); PG8_BAR; PG8_SCHED;
            PG8_LDB(B1, 1, 1); PG8_STAGE(PG8_SB(1, 0), b3, voffB);
            PG8_BAR; PG8_WAIT_L(0); PG8_MMA(0, 1, At, B1); PG8_BAR;
            PG8_LDA(At, 1, 1); PG8_STAGE(PG8_SA(1, 0), a3, voffA);
            PG8_BAR; PG8_WAIT_L(0); PG8_MMA(1, 0, At, B0); PG8_BAR; PG8_SCHED;
            PG8_STAGE(PG8_SB(1, 1), b3 + hstepB, voffB);
            PG8_WAIT_V(6); PG8_BAR; PG8_MMA(1, 1, At, B1); PG8_BAR;
            }
        }
        if constexpr (ALIGN_EPI) { if (wr == 0) PG8_BAR; }
        if constexpr (!Epi::AFTER_DRAIN) { E(acc, cur, wr, wc, fr, fq); S.done(cur); }
        if (!has_next) break;
#pragma unroll
        for (int a = 0; a < 2; ++a)
#pragma unroll
            for (int b = 0; b < 2; ++b)
#pragma unroll
                for (int m = 0; m < 4; ++m)
#pragma unroll
                    for (int n = 0; n < 2; ++n) acc[a][b][m][n] = (f32x4){0.f, 0.f, 0.f, 0.f};
        cur = nxt; cA = nA; cB = nB; ++ui;
        if constexpr (ALIGN_EPI) { if (wr == 1) PG8_BAR; }
    }
    PG8_WAIT_V(0);
    if constexpr (!ALIGN_EPI) { if (wr == 0) PG8_BAR; }
    PG8_BAR;
    if constexpr (Epi::AFTER_DRAIN) { E.fused(acc, cur, wr, wc, fr, fq, lds, wid, lane); S.done(cur); }
#undef PG8_SA
#undef PG8_SB
#undef PG8_STAGE
#undef PG8_LDA
#undef PG8_LDB
#undef PG8_MMA
#undef PG8_WAIT_V
#undef PG8_WAIT_L
#undef PG8_BAR
#undef PG8_SCHED
}

__device__ __forceinline__ float bf2f(bf16_t v) { return __uint_as_float((unsigned)v << 16); }
__device__ __forceinline__ float bflo(unsigned w) { return __uint_as_float(w << 16); }
__device__ __forceinline__ float bfhi(unsigned w) { return __uint_as_float(w & 0xffff0000u); }
__device__ __forceinline__ unsigned cvt_pk_bf16(float lo, float hi) { unsigned r; asm volatile("v_cvt_pk_bf16_f32 %0, %1, %2" : "=v"(r) : "v"(lo), "v"(hi)); return r; }

template <class Epi, class Sched>
__device__ __forceinline__ void gemm_naive(const Gemm g, const Sched& S, const Epi& E) {
    const int tid = threadIdx.x, wid = tid >> 6, lane = tid & 63, wr = wid >> 2, wc = wid & 3, fr = lane & 15, fq = lane >> 4;
    Unit u;
    for (int i = 0; S.next(i, u); ++i) {
        f32x4 acc[2][2][4][2];
#pragma unroll
        for (int ai = 0; ai < 2; ++ai)
#pragma unroll
            for (int bj = 0; bj < 2; ++bj)
#pragma unroll
                for (int m = 0; m < 4; ++m)
#pragma unroll
                    for (int n = 0; n < 2; ++n) {
                        const bf16_t* a = (const bf16_t*)u.A + (size_t)(ai * 128 + wr * 64 + m * 16 + fr) * g.lda;
                        const bf16_t* b = (const bf16_t*)u.B + (size_t)(bj * 128 + wc * 32 + n * 16 + 4 * fq) * g.ldb;
                        float s0 = 0.f, s1 = 0.f, s2 = 0.f, s3 = 0.f;
                        for (int k = 0; k < g.K; k += 8) {
                            const bf16x8 av = *(const bf16x8*)(a + k), b0 = *(const bf16x8*)(b + k), b1 = *(const bf16x8*)(b + g.ldb + k), b2 = *(const bf16x8*)(b + 2 * g.ldb + k), b3 = *(const bf16x8*)(b + 3 * g.ldb + k);
#pragma unroll
                            for (int e = 0; e < 8; ++e) { const float x = bf2f((bf16_t)av[e]); s0 += x * bf2f((bf16_t)b0[e]); s1 += x * bf2f((bf16_t)b1[e]); s2 += x * bf2f((bf16_t)b2[e]); s3 += x * bf2f((bf16_t)b3[e]); }
                        }
                        acc[ai][bj][m][n] = (f32x4){s0, s1, s2, s3};
                    }
        E(acc, u, wr, wc, fr, fq);
    }
}

struct Job { const char* A; const char* B; int nM, nN; };
struct Sched2 {
    Job a, b; int G, c, lda, ldb;
    __device__ __forceinline__ bool next(int i, Unit& u) const {
        int L = i * G + c; const int na = a.nM * a.nN, nb = b.nM * b.nN;
        if (L < na) { u.job = 0; u.pm = L % a.nM; u.pn = L / a.nM; u.A = a.A + (size_t)u.pm * 256 * lda * 2; u.B = a.B + (size_t)u.pn * 256 * ldb * 2; return true; }
        L -= na;
        if (L < nb) { u.job = 1; u.pm = L % b.nM; u.pn = L / b.nM; u.A = b.A + (size_t)u.pm * 256 * lda * 2; u.B = b.B + (size_t)u.pn * 256 * ldb * 2; return true; }
        return false;
    }
    __device__ __forceinline__ void a_ready(const Unit&) const {}
    __device__ __forceinline__ void done(const Unit&) const {}
};
struct GateOrder {
    const char* xc; const char* wg; size_t dstride; int G, c;
    __device__ __forceinline__ bool next(int i, Unit& u) const {
        const int L = i * G + c; if (L >= 512) return false;
        const int grp = L >> 6, pm = L & 63, d = grp >> 2, png = grp & 3;
        u.job = d; u.pm = pm; u.pn = png; u.A = xc + (size_t)d * dstride + ((size_t)pm * 256 * 512 + png * 128) * 2; u.B = wg + (size_t)grp * 256 * 128 * 2; return true;
    }
    __device__ __forceinline__ void a_ready(const Unit&) const {}
    __device__ __forceinline__ void done(const Unit&) const {}
};

__device__ __forceinline__ float rowscale16(const float* ss, int row) {
    const f32x4* p = (const f32x4*)(ss + (size_t)row * 16); const f32x4 a = p[0], b = p[1], c = p[2], d = p[3];
    const float s = ((a[0] + a[1]) + (a[2] + a[3])) + ((b[0] + b[1]) + (b[2] + b[3])) + ((c[0] + c[1]) + (c[2] + c[3])) + ((d[0] + d[1]) + (d[2] + d[3]));
    return 1.0f / sqrtf(s * (1.0f / 1024.0f) + 1e-6f);
}
template <bool ROWSCALE> struct EpiBf {
    static constexpr bool PERM = false, AFTER_DRAIN = false;
    bf16_t* O0; int ld0; bf16_t* O1; int ld1; const float* ss;
    __device__ __forceinline__ void operator()(const f32x4 (&acc)[2][2][4][2], const Unit& u, int wr, int wc, int fr, int fq) const {
        bf16_t* O = u.job ? O1 : O0; const int ldc = u.job ? ld1 : ld0;
        const int row0 = u.pm * 256 + wr * 64 + fr, col0 = u.pn * 256 + wc * 32 + 4 * fq;
#pragma unroll
        for (int ai = 0; ai < 2; ++ai)
#pragma unroll
            for (int m = 0; m < 4; ++m) { const int row = row0 + ai * 128 + m * 16; float rs = 1.f; if (ROWSCALE) rs = rowscale16(ss, row);
                bf16_t* rowp = O + (size_t)row * ldc + col0;
#pragma unroll
                for (int bj = 0; bj < 2; ++bj)
#pragma unroll
                    for (int n = 0; n < 2; ++n) { const f32x4 v = acc[ai][bj][m][n] * rs; u32x2 w; w.x = cvt_pk_bf16(v[0], v[1]); w.y = cvt_pk_bf16(v[2], v[3]); *(u32x2*)(rowp + bj * 128 + n * 16) = w; } }
    }
};
template <bool STATS> struct EpiResid {
    static constexpr bool PERM = false, AFTER_DRAIN = false;
    const float* base; float* out; bf16_t* xb; float* ss;
    __device__ __forceinline__ void operator()(const f32x4 (&acc)[2][2][4][2], const Unit& u, int wr, int wc, int fr, int fq) const {
        const int row0 = u.pm * 256 + wr * 64 + fr, col0 = u.pn * 256 + wc * 32 + 4 * fq;
#pragma unroll
        for (int ai = 0; ai < 2; ++ai)
#pragma unroll
            for (int m = 0; m < 4; ++m) { const int row = row0 + ai * 128 + m * 16; const size_t off = (size_t)row * 1024 + col0; float s = 0.f;
#pragma unroll
                for (int bj = 0; bj < 2; ++bj)
#pragma unroll
                    for (int n = 0; n < 2; ++n) { const size_t o2 = off + bj * 128 + n * 16; const f32x4 v = *(const f32x4*)(base + o2) + acc[ai][bj][m][n]; *(f32x4*)(out + o2) = v;
                        if (STATS) { s += (v[0] * v[0] + v[1] * v[1]) + (v[2] * v[2] + v[3] * v[3]); u32x2 w; w.x = cvt_pk_bf16(v[0], v[1]); w.y = cvt_pk_bf16(v[2], v[3]); *(u32x2*)(xb + o2) = w; } }
                if (STATS) { s += __shfl_xor(s, 16); s += __shfl_xor(s, 32); if (fq == 0) ss[(size_t)row * 16 + u.pn * 4 + wc] = s; } }
    }
};
struct EpiGates {
    static constexpr bool PERM = false, AFTER_DRAIN = false;
    const bf16_t* xc; const float* b_a; const float* b_i; const float* c8t; unsigned* G; int T;
    __device__ __forceinline__ void operator()(const f32x4 (&acc)[2][2][4][2], const Unit& u, int wr, int wc, int fr, int fq) const {
        const int d = u.job, row0 = u.pm * 256 + wr * 64 + fr, ch0 = u.pn * 128 + wc * 32 + 4 * fq;
#pragma unroll
        for (int n = 0; n < 2; ++n) { const int ch = d * 512 + ch0 + n * 16; const f32x4 ba = *(const f32x4*)(b_a + ch), bi = *(const f32x4*)(b_i + ch), c8 = *(const f32x4*)(c8t + ch);
#pragma unroll
            for (int ai = 0; ai < 2; ++ai)
#pragma unroll
                for (int m = 0; m < 4; ++m) { const int row = row0 + ai * 128 + m * 16;
                    const size_t off = ((size_t)d * T + row) * 512 + ch0 + n * 16; const u32x2 xw = *(const u32x2*)(xc + off);
                    const float xv[4] = {bflo(xw.x), bfhi(xw.x), bflo(xw.y), bfhi(xw.y)}; const f32x4 pa = acc[ai][0][m][n] + ba, pi = acc[ai][1][m][n] + bi; u32x4 o;
#pragma unroll
                    for (int e = 0; e < 4; ++e) { const float r = 1.0f / (1.0f + __expf(-pa[e])), ig = 1.0f / (1.0f + __expf(-pi[e])); const float la = r * c8[e];
                        const float x2 = 2.0f * la; const float om = (x2 > -0.02f) ? -(x2 + 0.5f * x2 * x2 + x2 * x2 * x2 * (1.0f / 6.0f)) : 1.0f - __expf(x2);
                        o[e] = cvt_pk_bf16(la, sqrtf(fmaxf(om, 0.f)) * ig * xv[e]); }
                    *(u32x4*)(G + off) = o; asm volatile("" ::: "memory"); } }
    }
};
}

namespace att {
using pg8::bf16_t;
using bf16x8 = __attribute__((ext_vector_type(8))) short;
using s16x4  = __attribute__((ext_vector_type(4))) short;
using f32x16 = __attribute__((ext_vector_type(16))) float;
using u32x4  = __attribute__((ext_vector_type(4))) unsigned;
constexpr int NW = 8, QBLK = 32, KVBLK = 64;
constexpr size_t SHM_V = KVBLK * 128 * 2, SHM_K = KVBLK * 128 * 2, SHM_ATTN = 2 * SHM_V + 2 * SHM_K + NW * 64 * 4;
constexpr float THR = 8.f;
#define KSWZ(row, colB) ((row) * 256 + ((colB) ^ (((row) & 7) << 4)))
#define SBAR() __builtin_amdgcn_sched_barrier(0)
__device__ __forceinline__ int crow(int r, int hi) { return (r & 3) + 8 * (r >> 2) + 4 * hi; }
__device__ __forceinline__ unsigned cvtpk(float lo, float hi) { unsigned r; asm volatile("v_cvt_pk_bf16_f32 %0, %1, %2" : "=v"(r) : "v"(lo), "v"(hi)); return r; }
__device__ __forceinline__ void partialSM(f32x16& p0, f32x16& p1, float& m_reg, float& mn, float& alpha, float C, float thr_raw) {
  float pmax = p0[0];
#pragma unroll
  for (int r = 1; r < 16; ++r) pmax = fmaxf(pmax, p0[r]);
#pragma unroll
  for (int r = 0; r < 16; ++r) pmax = fmaxf(pmax, p1[r]);
  { auto rr = __builtin_amdgcn_permlane32_swap(__float_as_uint(pmax), __float_as_uint(pmax), false, false);
    pmax = fmaxf(__uint_as_float(rr[0]), __uint_as_float(rr[1])); }
  if (__builtin_expect(__all(pmax - m_reg <= thr_raw), 1)) { mn = m_reg; alpha = 1.f; }
  else { mn = fmaxf(m_reg, pmax); alpha = __builtin_amdgcn_exp2f((m_reg - mn) * C); m_reg = mn; }
  const float mnC = -mn * C;
#pragma unroll
  for (int r = 0; r < 16; ++r) p0[r] = fmaf(p0[r], C, mnC);
#pragma unroll
  for (int r = 0; r < 16; ++r) p1[r] = fmaf(p1[r], C, mnC);
#pragma unroll
  for (int r = 0; r < 16; ++r) p0[r] = __builtin_amdgcn_exp2f(p0[r]);
}
__device__ __forceinline__ void finishSM(f32x16& p0, f32x16& p1, float alpha, float& l_reg, bf16x8& pa0, bf16x8& pa1, bf16x8& pa2, bf16x8& pa3) {
#pragma unroll
  for (int r = 0; r < 16; ++r) p1[r] = __builtin_amdgcn_exp2f(p1[r]);
  float ps = 0;
#pragma unroll
  for (int r = 0; r < 16; ++r) ps += p0[r];
#pragma unroll
  for (int r = 0; r < 16; ++r) ps += p1[r];
  { auto rr = __builtin_amdgcn_permlane32_swap(__float_as_uint(ps), __float_as_uint(ps), false, false);
    ps = __uint_as_float(rr[0]) + __uint_as_float(rr[1]); }
  l_reg = l_reg * alpha + ps;
#define PK4(P, BASE, OUT) do { unsigned a0 = cvtpk(P[BASE + 0], P[BASE + 1]), a1 = cvtpk(P[BASE + 2], P[BASE + 3]);   \
    unsigned b0 = cvtpk(P[BASE + 4], P[BASE + 5]), b1 = cvtpk(P[BASE + 6], P[BASE + 7]);                              \
    auto r0 = __builtin_amdgcn_permlane32_swap(a0, b0, false, false); auto r1 = __builtin_amdgcn_permlane32_swap(a1, b1, false, false); \
    u32x4 w = {r0[0], r1[0], r0[1], r1[1]}; OUT = *reinterpret_cast<bf16x8*>(&w); } while (0)
  PK4(p0, 0, pa0); PK4(p0, 8, pa1); PK4(p1, 0, pa2); PK4(p1, 8, pa3);
#undef PK4
}
template <int DQK> __device__ __forceinline__ void qkt(f32x16& p0, f32x16& p1, const bf16_t* Ks, const bf16x8* qr, int r32, int hi) {
  p0 = f32x16{}; p1 = f32x16{};
#pragma unroll
  for (int d0 = 0; d0 < DQK / 16; ++d0) { const int cb = (d0 * 16 + hi * 8) * 2;
    const bf16x8 b0 = *reinterpret_cast<const bf16x8*>((const char*)Ks + KSWZ(r32, cb));
    const bf16x8 b1 = *reinterpret_cast<const bf16x8*>((const char*)Ks + KSWZ(32 + r32, cb));
    p0 = __builtin_amdgcn_mfma_f32_32x32x16_bf16(b0, qr[d0], p0, 0, 0, 0);
    p1 = __builtin_amdgcn_mfma_f32_32x32x16_bf16(b1, qr[d0], p1, 0, 0, 0); }
}
__device__ __forceinline__ int v_st(int k, int c) { const int kk = (k & ~0xC) | ((k & 4) << 1) | ((k & 8) >> 1); return ((kk >> 3) * 4 + (c >> 5)) * 512 + ((kk & 7) * 32 + (c & 31)) * 2; }
__device__ __forceinline__ int v_rd_base(int lane) { return ((lane & 3) << 3) | (((lane >> 2) & 3) << 6) | (((lane >> 4) & 1) << 5) | (((lane >> 5) & 1) << 8); }
constexpr int v_rd_off(int d0, int ks, int half) { return d0 * 512 + ks * 4096 + half * 2048; }
template <int OFF> __device__ __forceinline__ s16x4 tr_read(int vb) {
  s16x4 r; asm volatile("ds_read_b64_tr_b16 %0, %1 offset:%2" : "=&v"(r) : "v"(vb), "i"(OFF) : "memory"); return r;
}
template <int D0> __device__ __forceinline__ void pv_one(f32x16& od, int vb, bf16x8 pa0, bf16x8 pa1, bf16x8 pa2, bf16x8 pa3) {
  const s16x4 l0 = tr_read<v_rd_off(D0, 0, 0)>(vb), h0 = tr_read<v_rd_off(D0, 0, 1)>(vb), l1 = tr_read<v_rd_off(D0, 1, 0)>(vb), h1 = tr_read<v_rd_off(D0, 1, 1)>(vb);
  const s16x4 l2 = tr_read<v_rd_off(D0, 2, 0)>(vb), h2 = tr_read<v_rd_off(D0, 2, 1)>(vb), l3 = tr_read<v_rd_off(D0, 3, 0)>(vb), h3 = tr_read<v_rd_off(D0, 3, 1)>(vb);
  asm volatile("s_waitcnt lgkmcnt(0)" ::: "memory"); SBAR();
#define PK(L, H) (bf16x8){L[0], L[1], L[2], L[3], H[0], H[1], H[2], H[3]}
  od = __builtin_amdgcn_mfma_f32_32x32x16_bf16(pa0, PK(l0, h0), od, 0, 0, 0);
  od = __builtin_amdgcn_mfma_f32_32x32x16_bf16(pa1, PK(l1, h1), od, 0, 0, 0);
  od = __builtin_amdgcn_mfma_f32_32x32x16_bf16(pa2, PK(l2, h2), od, 0, 0, 0);
  od = __builtin_amdgcn_mfma_f32_32x32x16_bf16(pa3, PK(l3, h3), od, 0, 0, 0);
#undef PK
}
template <int DV> __device__ __forceinline__ void pv_all(f32x16* o, int vb, bf16x8 pa0, bf16x8 pa1, bf16x8 pa2, bf16x8 pa3) {
  pv_one<0>(o[0], vb, pa0, pa1, pa2, pa3); pv_one<1>(o[1], vb, pa0, pa1, pa2, pa3);
  if constexpr (DV == 128) { pv_one<2>(o[2], vb, pa0, pa1, pa2, pa3); pv_one<3>(o[3], vb, pa0, pa1, pa2, pa3); }
}

template <int DQK, int DV, bool QNORM>
__device__ __forceinline__ void attn_unit(const bf16_t* __restrict__ Qb, int ldq, const bf16_t* __restrict__ Kh, int ldk, const bf16_t* __restrict__ Vh, int ldv,
                                          bf16_t* __restrict__ Ob, int ldo, int seq, float scale, const float* __restrict__ qgain, char* lds) {
  const int tid = threadIdx.x, wid = tid >> 6, lane = tid & 63, r32 = lane & 31, hi = lane >> 5;
  const float C = scale * 1.4426950408889634f, thr_raw = THR / scale;
  bf16_t* V_lds = (bf16_t*)lds; bf16_t* K_lds = (bf16_t*)(lds + 2 * SHM_V);
  float* ws = (float*)(lds + 2 * SHM_V + 2 * SHM_K) + wid * 64; float* li_l = ws; float* al_l = ws + 32;
  float m_reg = -1e30f, l_reg = 0; f32x16 o[DV / 32]; bf16x8 qr[DQK / 16];
#pragma unroll
  for (int d = 0; d < DV / 32; ++d) o[d] = f32x16{};
  const bf16_t* Qw = Qb + (long)(wid * QBLK + r32) * ldq + hi * 8;
#pragma unroll
  for (int d0 = 0; d0 < DQK / 16; ++d0) qr[d0] = *reinterpret_cast<const bf16x8*>(Qw + d0 * 16);
  if constexpr (QNORM) {
    float ssq = 0.f;
#pragma unroll
    for (int d0 = 0; d0 < DQK / 16; ++d0)
#pragma unroll
      for (int e = 0; e < 8; ++e) { const float v = pg8::bf2f((bf16_t)qr[d0][e]); ssq += v * v; }
    ssq += __shfl_xor(ssq, 32);
    const float rs = 1.0f / sqrtf(ssq * (1.0f / DQK) + 1e-6f);
#pragma unroll
    for (int d0 = 0; d0 < DQK / 16; ++d0) { float v[8];
#pragma unroll
      for (int e = 0; e < 8; ++e) v[e] = pg8::bf2f((bf16_t)qr[d0][e]) * rs * qgain[d0 * 16 + hi * 8 + e];
      u32x4 w = {cvtpk(v[0], v[1]), cvtpk(v[2], v[3]), cvtpk(v[4], v[5]), cvtpk(v[6], v[7])}; qr[d0] = *reinterpret_cast<bf16x8*>(&w); }
  }
  const int sr = tid >> 4, sc = (tid & 15) * 8, vst0 = v_st(sr, sc), vst1 = v_st(32 + sr, sc);
  const bool kact = sc < DQK, vact = sc < DV;
  const int vb0 = (int)(uintptr_t)V_lds + v_rd_base(lane);
  bf16x8 svs0[2], svs1[2], sks0[2], sks1[2];
#define SLOAD(i, k0) do { if (vact) { svs0[i] = *(const bf16x8*)(&Vh[(long)((k0) + sr) * ldv + sc]); svs1[i] = *(const bf16x8*)(&Vh[(long)((k0) + 32 + sr) * ldv + sc]); } \
    if (kact) { sks0[i] = *(const bf16x8*)(&Kh[(long)((k0) + sr) * ldk + sc]); sks1[i] = *(const bf16x8*)(&Kh[(long)((k0) + 32 + sr) * ldk + sc]); } } while (0)
#define SWRITE(b, i) do { if (vact) { *(bf16x8*)((char*)V_lds + (b) * SHM_V + vst0) = svs0[i]; *(bf16x8*)((char*)V_lds + (b) * SHM_V + vst1) = svs1[i]; } \
    if (kact) { const int kc = sc * 2; *(bf16x8*)((char*)K_lds + (b) * SHM_K + KSWZ(sr, kc)) = sks0[i]; *(bf16x8*)((char*)K_lds + (b) * SHM_K + KSWZ(32 + sr, kc)) = sks1[i]; } } while (0)
#define SWAIT() asm volatile("s_waitcnt vmcnt(4)" ::: "memory")
#define RESC(a) do { if (__any((a) < 1.f)) { if (hi == 0) al_l[r32] = (a); asm volatile("s_waitcnt lgkmcnt(0)" ::: "memory"); \
    _Pragma("unroll") for (int d = 0; d < DV / 32; ++d) _Pragma("unroll") for (int r = 0; r < 16; ++r) o[d][r] *= al_l[crow(r, hi)]; } } while (0)
  f32x16 pA0, pA1, pB0, pB1; float mnA, mnB, alA, alB; bf16x8 pa0, pa1, pa2, pa3; const int NT = seq / KVBLK;
  constexpr int SE = 0, SO = 1;
  SLOAD(SE, 0); asm volatile("s_waitcnt vmcnt(0)" ::: "memory"); SWRITE(0, SE); __syncthreads();
  qkt<DQK>(pA0, pA1, K_lds, qr, r32, hi); partialSM(pA0, pA1, m_reg, mnA, alA, C, thr_raw);
  SLOAD(SO, KVBLK); if (2 < NT) SLOAD(SE, 2 * KVBLK);
  SWAIT(); SWRITE(1, SO); __syncthreads();
  for (int j = 1; j + 1 < NT; j += 2) {
    SBAR(); qkt<DQK>(pB0, pB1, (bf16_t*)((char*)K_lds + SHM_K), qr, r32, hi);
    finishSM(pA0, pA1, alA, l_reg, pa0, pa1, pa2, pa3); SBAR();
    SLOAD(SO, (j + 2) * KVBLK); SBAR();
    pv_all<DV>(o, vb0, pa0, pa1, pa2, pa3); partialSM(pB0, pB1, m_reg, mnB, alB, C, thr_raw);
    __syncthreads(); SWAIT(); SWRITE(0, SE);
    RESC(alB); __syncthreads();
    SBAR(); qkt<DQK>(pA0, pA1, K_lds, qr, r32, hi);
    finishSM(pB0, pB1, alB, l_reg, pa0, pa1, pa2, pa3); SBAR();
    if (j + 3 < NT) SLOAD(SE, (j + 3) * KVBLK); SBAR();
    pv_all<DV>(o, vb0 + (int)SHM_V, pa0, pa1, pa2, pa3); partialSM(pA0, pA1, m_reg, mnA, alA, C, thr_raw);
    __syncthreads(); SWAIT(); SWRITE(1, SO);
    RESC(alA); __syncthreads();
  }
  SBAR(); qkt<DQK>(pB0, pB1, (bf16_t*)((char*)K_lds + SHM_K), qr, r32, hi);
  finishSM(pA0, pA1, alA, l_reg, pa0, pa1, pa2, pa3); SBAR();
  pv_all<DV>(o, vb0, pa0, pa1, pa2, pa3); partialSM(pB0, pB1, m_reg, mnB, alB, C, thr_raw);
  __syncthreads(); RESC(alB);
  finishSM(pB0, pB1, alB, l_reg, pa0, pa1, pa2, pa3); SBAR();
  pv_all<DV>(o, vb0 + (int)SHM_V, pa0, pa1, pa2, pa3);
  if (hi == 0) li_l[r32] = l_reg; asm volatile("s_waitcnt lgkmcnt(0)" ::: "memory");
  float rli[16];
#pragma unroll
  for (int r = 0; r < 16; ++r) rli[r] = __builtin_amdgcn_rcpf(li_l[crow(r, hi)]);
  bf16_t* Ow = Ob + (long)(wid * QBLK) * ldo;
#pragma unroll
  for (int r = 0; r < 16; ++r) { const int orow = crow(r, hi);
#pragma unroll
    for (int d0 = 0; d0 < DV / 32; ++d0) Ow[(long)orow * ldo + d0 * 32 + r32] = (bf16_t)(cvtpk(o[d0][r] * rli[r], 0.f) & 0xffffu); }
  __syncthreads();
#undef SLOAD
#undef SWRITE
#undef SWAIT
#undef RESC
}
#undef SBAR

template <int DQK, int DV, bool QNORM>
__device__ __forceinline__ void attn_unit_naive(const bf16_t* Qb, int ldq, const bf16_t* Kh, int ldk, const bf16_t* Vh, int ldv, bf16_t* Ob, int ldo, int seq, float scale, const float* qgain, char* lds) {
  const int tid = threadIdx.x; float* ql = (float*)lds;
  if (tid < 256) {
    float ssq = 0.f;
    for (int d = 0; d < DQK; ++d) { const float v = pg8::bf2f(Qb[(long)tid * ldq + d]); ssq += v * v; }
    const float rs = QNORM ? 1.0f / sqrtf(ssq * (1.0f / DQK) + 1e-6f) : 1.f;
    for (int d = 0; d < DQK; ++d) { float v = pg8::bf2f(Qb[(long)tid * ldq + d]); if (QNORM) v = pg8::bf2f((bf16_t)(cvtpk(v * rs * qgain[d], 0.f) & 0xffffu)); ql[d * 256 + tid] = v; }
    float m = -1e30f, l = 0.f; float o[DV];
#pragma unroll
    for (int d = 0; d < DV; ++d) o[d] = 0.f;
    for (int k = 0; k < seq; ++k) { float s = 0.f;
      for (int d = 0; d < DQK; ++d) s += ql[d * 256 + tid] * pg8::bf2f(Kh[(long)k * ldk + d]);
      s *= scale; const float mn = fmaxf(m, s), al = __expf(m - mn), p = __expf(s - mn); l = l * al + p; m = mn;
#pragma unroll
      for (int d = 0; d < DV; ++d) o[d] = o[d] * al + p * pg8::bf2f(Vh[(long)k * ldv + d]); }
    const float il = 1.0f / l;
#pragma unroll
    for (int d = 0; d < DV; ++d) Ob[(long)tid * ldo + d] = (bf16_t)(cvtpk(o[d] * il, 0.f) & 0xffffu);
  }
  __syncthreads();
}
}

using pg8::bf16_t; using pg8::f32x4; using pg8::u32x4; using pg8::u32x2; using pg8::bf16x8; using pg8::bf2f; using pg8::bflo; using pg8::bfhi; using pg8::cvt_pk_bf16;
#define LAS __attribute__((address_space(3)))
constexpr int NBATCH = 2, SEQ = 8192, T = NBATCH * SEQ, DM = 1024, MEMLEN = 256, TM = NBATCH * MEMLEN;
constexpr int PROJ_LD = 1536, IN_COLS = 1440, DFF = 2816, DFF2 = 5632;
constexpr int NTHR = 512, NWAVES = 8;
constexpr float EPS = 1e-6f;
constexpr size_t MiB = 1u << 20;
constexpr size_t WS_SS = 1 * MiB, WS_WIN = 2 * MiB, WS_WUQ = 5 * MiB, WS_WUKV = 5 * MiB + 512 * 1024, WS_WG = 6 * MiB, WS_WOUT = 7 * MiB, WS_WMQ = 9 * MiB, WS_WMKV = 10 * MiB,
                 WS_WMO = 12 * MiB, WS_WUP = 13 * MiB, WS_WDN = 24 * MiB, WS_MEMN = 30 * MiB, WS_MEMKV = 31 * MiB, WS_XB = 32 * MiB, WS_KN = 32 * MiB, WS_AGG = 56 * MiB,
                 WS_PROJ = 64 * MiB, WS_CQ = 112 * MiB, WS_CKV = 120 * MiB, WS_XC = 124 * MiB, WS_QRAW = 156 * MiB, WS_KVRAW = 180 * MiB, WS_QN = 112 * MiB, WS_MLA = 136 * MiB,
                 WS_AMIX = 156 * MiB, WS_QMEM = 112 * MiB, WS_OMEM = 128 * MiB, WS_GU = 64 * MiB, WS_HID = 152 * MiB, WS_END = 240 * MiB;
constexpr int LDS_BYTES = 147456, LDSCTL_OFF = 131072, MISC_OFF = LDSCTL_OFF + 320;
constexpr size_t WS_BAR = 65536, BAR_ZERO_BYTES = 16384;

struct Args { const void* in[33]; float* out; unsigned char* ws; int ph_lo, ph_hi; };

struct Ctx {
    LAS unsigned char* lds; char* ldsg;
    int tid, lane, wave, bid, G;
};
#define WSP(type, off) ((type*)(args.ws + (off)))

#define XB_TMO      128
#define XB_XCNT(j)  (256  + 64 * (j))
#define XB_XSUB(j)  (1280 + 64 * (j))
#define XB_XGEN(j)  (2304 + 64 * (j))
#define XB_TOP      3328
#define XB_TOPGEN   3392
#define XCD_BAR_WORDS 3456
#define XB_SPIN_CAP (1u << 18)

__device__ __forceinline__ unsigned xb_ld(unsigned* p)              { return __hip_atomic_load(p, __ATOMIC_RELAXED, __HIP_MEMORY_SCOPE_AGENT); }
__device__ __forceinline__ unsigned xb_add(unsigned* p, unsigned v) { return __hip_atomic_fetch_add(p, v, __ATOMIC_RELAXED, __HIP_MEMORY_SCOPE_AGENT); }
__device__ __forceinline__ unsigned xb_xcc_id() { return (unsigned)__builtin_amdgcn_s_getreg((3 << 11) | 20) & 0xFu; }
#define XB_SPIN(cond, bar) do { unsigned _sp = 0; while (cond) { __builtin_amdgcn_s_sleep(1); \
    if ((++_sp & 255u) == 0u) { if (xb_ld(&(bar)[XB_TMO])) break; if (_sp > XB_SPIN_CAP) { atomicAdd(&(bar)[XB_TMO], 1u); break; } } } } while (0)

struct XcdBarrier {
    unsigned* bar; unsigned x;
    volatile LAS unsigned* st;
};

__device__ __forceinline__ XcdBarrier xcd_barrier_post(unsigned* bar, volatile LAS unsigned* st) {
    XcdBarrier b; b.bar = bar; b.x = xb_xcc_id(); b.st = st;
    if (threadIdx.x == 0) (void)xb_add(&bar[XB_XCNT(b.x)], 1u);
    return b;
}
__device__ __forceinline__ void xcd_barrier_complete(unsigned* bar, unsigned x, unsigned& nloc, unsigned& nx) {
    const unsigned G = gridDim.x * gridDim.y * gridDim.z;
    unsigned sum, cnt, mine, sp = 0u;
    for (;;) {
        sum = 0u; cnt = 0u; mine = 0u;
#pragma unroll
        for (unsigned j = 0; j < 16; ++j) { const unsigned c = xb_ld(&bar[XB_XCNT(j)]); sum += c; cnt += (c > 0u) ? 1u : 0u; mine = (j == x) ? c : mine; }
        if (sum == G) break;
        __builtin_amdgcn_s_sleep(1);
        if ((++sp & 255u) == 0u) { if (xb_ld(&bar[XB_TMO])) break; if (sp > XB_SPIN_CAP) { atomicAdd(&bar[XB_TMO], 1u); break; } }
    }
    nloc = mine > 0u ? mine : 1u; nx = cnt > 0u ? cnt : 1u;
}

__device__ __forceinline__ void xcd_barrier(const XcdBarrier& b) {
    asm volatile("s_waitcnt vmcnt(0)" ::: "memory");
    __syncthreads();
    if (threadIdx.x == 0) {
        unsigned* bar = b.bar;
        __builtin_amdgcn_s_waitcnt(0);
        unsigned nloc = b.st[0], nx = b.st[1];
        if (nloc == 0u) { xcd_barrier_complete(bar, b.x, nloc, nx); b.st[0] = nloc; b.st[1] = nx; }
        const unsigned old = xb_add(&bar[XB_XSUB(b.x)], 1u);
        const unsigned gen = old / nloc;
        if (old + 1u == (gen + 1u) * nloc) {
            __builtin_amdgcn_fence(__ATOMIC_RELEASE, "agent");
            asm volatile("s_waitcnt vmcnt(0)" ::: "memory");
            const unsigned og = xb_add(&bar[XB_TOP], 1u);
            const unsigned tg = og / nx;
            if (og + 1u == (tg + 1u) * nx) xb_add(&bar[XB_TOPGEN], 1u);
            else XB_SPIN(xb_ld(&bar[XB_TOPGEN]) == tg, bar);
            __builtin_amdgcn_fence(__ATOMIC_ACQUIRE, "agent");
            xb_add(&bar[XB_XGEN(b.x)], 1u);
            asm volatile("s_waitcnt vmcnt(0)" ::: "memory");
        } else {
            XB_SPIN(xb_ld(&bar[XB_XGEN(b.x)]) == gen, bar);
            __builtin_amdgcn_fence(__ATOMIC_ACQUIRE, "agent");
            asm volatile("s_waitcnt vmcnt(0)" ::: "memory");
        }
    }
    __syncthreads();
}


__device__ __forceinline__ float wave_sum(float v) {
#pragma unroll
    for (int o = 1; o < 64; o <<= 1) v += __shfl_xor(v, o);
    return v;
}
__device__ __forceinline__ u32x4 pack8(const float* v) { u32x4 w; w.x = cvt_pk_bf16(v[0], v[1]); w.y = cvt_pk_bf16(v[2], v[3]); w.z = cvt_pk_bf16(v[4], v[5]); w.w = cvt_pk_bf16(v[6], v[7]); return w; }
__device__ __forceinline__ void unpack8(const u32x4 w, float* v) { v[0] = bflo(w.x); v[1] = bfhi(w.x); v[2] = bflo(w.y); v[3] = bfhi(w.y); v[4] = bflo(w.z); v[5] = bfhi(w.z); v[6] = bflo(w.w); v[7] = bfhi(w.w); }

__device__ __forceinline__ void p0_transpose_item(const float* W, const float* gain, int K, int N, bf16_t* WT, LAS float* scr, int item, int lane) {
    const int nblk = N / 32, kb = item / nblk, nb = item % nblk, k0 = 64 * kb, n0 = 32 * nb;
#pragma unroll 8
    for (int i = 0; i < 32; ++i) { const int kk = 2 * i + (lane >> 5); float v = W[(size_t)(k0 + kk) * N + n0 + (lane & 31)]; if (gain) v *= gain[k0 + kk]; scr[kk * 33 + (lane & 31)] = v; }
    asm volatile("s_waitcnt lgkmcnt(0)" ::: "memory");
    const int cch = lane & 7;
#pragma unroll
    for (int j = 0; j < 4; ++j) { const int n = (lane >> 3) + 8 * j; const LAS float* s = scr + (8 * cch) * 33 + n;
        u32x4 o; o.x = cvt_pk_bf16(s[0 * 33], s[1 * 33]); o.y = cvt_pk_bf16(s[2 * 33], s[3 * 33]); o.z = cvt_pk_bf16(s[4 * 33], s[5 * 33]); o.w = cvt_pk_bf16(s[6 * 33], s[7 * 33]);
        *(u32x4*)(WT + (size_t)(n0 + n) * K + k0 + 8 * cch) = o; }
    asm volatile("s_waitcnt lgkmcnt(0)" ::: "memory");
}
__device__ __forceinline__ void norm_row_1024(const float* xrow, const float* gain, bf16_t* orow, int lane) {
    const f32x4* xr = (const f32x4*)xrow + lane; const f32x4* gr = (const f32x4*)gain + lane;
    f32x4 v[4]; float s = 0.f;
#pragma unroll
    for (int j = 0; j < 4; ++j) { v[j] = xr[64 * j]; s += (v[j][0] * v[j][0] + v[j][1] * v[j][1]) + (v[j][2] * v[j][2] + v[j][3] * v[j][3]); }
    const float rs = 1.0f / sqrtf(wave_sum(s) * (1.0f / 1024.0f) + EPS);
#pragma unroll
    for (int j = 0; j < 4; ++j) { const f32x4 g = gr[64 * j]; u32x2 w; w.x = cvt_pk_bf16(v[j][0] * rs * g[0], v[j][1] * rs * g[1]); w.y = cvt_pk_bf16(v[j][2] * rs * g[2], v[j][3] * rs * g[3]);
        *((u32x2*)orow + lane + 64 * j) = w; }
}
__device__ __forceinline__ void phase0(Ctx& c, const Args& args) {
    LAS float* scr = (LAS float*)(c.lds + c.wave * 16384);
    const int gw = c.bid * NWAVES + c.wave, NGW = c.G * NWAVES;
    constexpr int I_IN = 16 * 45, I_UQ = 4 * 24, I_UKV = 2 * 32, I_OUT = 16 * 32, I_MQ = 16 * 16, I_MKV = 16 * 32, I_MO = 8 * 32, I_UP = 16 * 176, I_DN = 44 * 32;
    constexpr int NITEMS = I_IN + I_UQ + I_UKV + I_OUT + I_MQ + I_MKV + I_MO + I_UP + I_DN;
    for (int it = gw; it < NITEMS; it += NGW) {
        int r = it;
        if (r < I_IN) { p0_transpose_item(((const float*)args.in[4]), nullptr, 1024, IN_COLS, WSP(bf16_t, WS_WIN), scr, r, c.lane); continue; } r -= I_IN;
        if (r < I_UQ) { p0_transpose_item(((const float*)args.in[13]), nullptr, 256, 768, WSP(bf16_t, WS_WUQ), scr, r, c.lane); continue; } r -= I_UQ;
        if (r < I_UKV) { p0_transpose_item(((const float*)args.in[15]), nullptr, 128, 1024, WSP(bf16_t, WS_WUKV), scr, r, c.lane); continue; } r -= I_UKV;
        if (r < I_OUT) { p0_transpose_item(((const float*)args.in[20]), nullptr, 1024, 1024, WSP(bf16_t, WS_WOUT), scr, r, c.lane); continue; } r -= I_OUT;
        if (r < I_MQ) { p0_transpose_item(((const float*)args.in[23]), ((const float*)args.in[21]), 1024, 512, WSP(bf16_t, WS_WMQ), scr, r, c.lane); continue; } r -= I_MQ;
        if (r < I_MKV) { p0_transpose_item(((const float*)args.in[24]), nullptr, 1024, 1024, WSP(bf16_t, WS_WMKV), scr, r, c.lane); continue; } r -= I_MKV;
        if (r < I_MO) { p0_transpose_item(((const float*)args.in[27]), nullptr, 512, 1024, WSP(bf16_t, WS_WMO), scr, r, c.lane); continue; } r -= I_MO;
        if (r < I_UP) { p0_transpose_item(((const float*)args.in[29]), ((const float*)args.in[28]), 1024, DFF2, WSP(bf16_t, WS_WUP), scr, r, c.lane); continue; } r -= I_UP;
        p0_transpose_item(((const float*)args.in[32]), nullptr, DFF, 1024, WSP(bf16_t, WS_WDN), scr, r, c.lane);
    }
    const int gt = c.bid * NTHR + c.tid, NGT = c.G * NTHR;
    for (int i = gt; i < (PROJ_LD - IN_COLS) * 1024 / 8; i += NGT) *((u32x4*)(WSP(bf16_t, WS_WIN) + (size_t)IN_COLS * 1024) + i) = (u32x4){0u, 0u, 0u, 0u};
    for (int i = gt; i < 8 * 256 * 128; i += NGT) {
        const int k = i & 127, n = (i >> 7) & 255, grp = i >> 15, d = grp >> 2, png = grp & 3;
        const int gate = n >> 7, cl = n & 127, blk_n = cl >> 6, dout = cl & 63, blk_k = k >> 6, cin = k & 63;
        float v = 0.f;
        if (blk_n == blk_k) { const float* W = gate ? ((const float*)args.in[9]) : ((const float*)args.in[7]); v = W[((size_t)(d * 8 + png * 2 + blk_n) * 64 + cin) * 64 + dout]; }
        WSP(bf16_t, WS_WG)[i] = (bf16_t)(cvt_pk_bf16(v, 0.f) & 0xffffu);
    }
    for (int i = gt; i < 1024; i += NGT) WSP(float, 0)[i] = -8.0f * log1pf(expf(-((const float*)args.in[11])[i]));
    for (int m = gw; m < T + TM; m += NGW) {
        if (m < T) norm_row_1024(((const float*)args.in[0]) + (size_t)m * DM, ((const float*)args.in[3]), WSP(bf16_t, WS_XB) + (size_t)m * DM, c.lane);
        else norm_row_1024(((const float*)args.in[1]) + (size_t)(m - T) * DM, ((const float*)args.in[22]), WSP(bf16_t, WS_MEMN) + (size_t)(m - T) * DM, c.lane);
    }
}

__device__ __forceinline__ void phase2(Ctx& c, const Args& args) {
    const int gw = c.bid * NWAVES + c.wave, NGW = c.G * NWAVES, lane = c.lane;
    const bf16_t* proj = WSP(bf16_t, WS_PROJ);
    for (int row = gw; row < T + TM; row += NGW) {
        if (row >= T) {
            bf16_t* kp = WSP(bf16_t, WS_MEMKV) + (size_t)(row - T) * 1024 + lane * 8; float v[8]; unpack8(*(const u32x4*)kp, v);
            float s = 0.f;
#pragma unroll
            for (int e = 0; e < 8; ++e) s += v[e] * v[e];
            s += __shfl_xor(s, 1); s += __shfl_xor(s, 2); s += __shfl_xor(s, 4); s += __shfl_xor(s, 8);
            const float rs = 1.0f / sqrtf(s * (1.0f / 128.0f) + EPS);
#pragma unroll
            for (int e = 0; e < 8; ++e) v[e] *= rs * ((const float*)args.in[26])[(lane & 15) * 8 + e];
            *(u32x4*)kp = pack8(v);
            continue;
        }
        const bf16_t* pr = proj + (size_t)row * PROJ_LD;
        {
            const u32x2 w = *(const u32x2*)(pr + 1024 + lane * 4); float v[4] = {bflo(w.x), bfhi(w.x), bflo(w.y), bfhi(w.y)};
            const float rs = 1.0f / sqrtf(wave_sum((v[0] * v[0] + v[1] * v[1]) + (v[2] * v[2] + v[3] * v[3])) * (1.0f / 256.0f) + EPS);
            const f32x4 g = *(const f32x4*)(((const float*)args.in[12]) + lane * 4); u32x2 o; o.x = cvt_pk_bf16(v[0] * rs * g[0], v[1] * rs * g[1]); o.y = cvt_pk_bf16(v[2] * rs * g[2], v[3] * rs * g[3]);
            *(u32x2*)(WSP(bf16_t, WS_CQ) + (size_t)row * 256 + lane * 4) = o;
        }
        {
            const unsigned w = *(const unsigned*)(pr + 1280 + lane * 2); const float v0 = bflo(w), v1 = bfhi(w);
            const float rs = 1.0f / sqrtf(wave_sum(v0 * v0 + v1 * v1) * (1.0f / 128.0f) + EPS);
            *(unsigned*)(WSP(bf16_t, WS_CKV) + (size_t)row * 128 + lane * 2) = cvt_pk_bf16(v0 * rs * ((const float*)args.in[14])[lane * 2], v1 * rs * ((const float*)args.in[14])[lane * 2 + 1]);
        }
        {
            const int t = row & (SEQ - 1), ch = lane * 8;
            float xs[7][8];
#pragma unroll
            for (int dt = -3; dt <= 3; ++dt) { const int tt = t + dt;
                if (tt >= 0 && tt < SEQ) unpack8(*(const u32x4*)(pr + (long)dt * PROJ_LD + ch), xs[dt + 3]);
                else {
#pragma unroll
                    for (int e = 0; e < 8; ++e) xs[dt + 3][e] = 0.f; } }
            float of[8], ob[8];
#pragma unroll
            for (int e = 0; e < 8; ++e) { of[e] = ((const float*)args.in[6])[ch + e]; ob[e] = ((const float*)args.in[6])[512 + ch + e]; }
#pragma unroll
            for (int k = 0; k < 4; ++k)
#pragma unroll
                for (int e = 0; e < 8; ++e) { of[e] += ((const float*)args.in[5])[(0 * 4 + k) * 512 + ch + e] * xs[k][e]; ob[e] += ((const float*)args.in[5])[(1 * 4 + k) * 512 + ch + e] * xs[3 + k][e]; }
            *(u32x4*)(WSP(bf16_t, WS_XC) + (size_t)row * 512 + ch) = pack8(of);
            *(u32x4*)(WSP(bf16_t, WS_XC) + ((size_t)T + row) * 512 + ch) = pack8(ob);
        }
    }
}

__device__ __forceinline__ void phase4(Ctx& c, const Args& args) {
    const int gw = c.bid * NWAVES + c.wave, NGW = c.G * NWAVES, lane = c.lane, h = lane >> 3, sub = lane & 7;
    const bf16_t* proj = WSP(bf16_t, WS_PROJ); const bf16_t* qraw = WSP(bf16_t, WS_QRAW); const bf16_t* kvraw = WSP(bf16_t, WS_KVRAW);
    bf16_t* Qn = WSP(bf16_t, WS_QN); bf16_t* Kn = WSP(bf16_t, WS_KN);
    for (int row = gw; row < T; row += NGW) {
        const float posf = (float)((const int*)args.in[2])[row]; float cs[2], sn[2];
#pragma unroll
        for (int jj = 0; jj < 2; ++jj) { const int j = 2 * sub + jj; const float inv = exp2f(-(float)j * 0.8304820237218406f);
            const float ang = posf * inv; const double rev = (double)ang * 0.15915494309189535; const float fr = (float)(rev - rint(rev));
            cs[jj] = __builtin_amdgcn_cosf(fr); sn[jj] = __builtin_amdgcn_sinf(fr); }
#pragma unroll
        for (int which = 0; which < 2; ++which) {
            const bf16_t* np = which ? kvraw + (size_t)row * 1024 + h * 128 + sub * 8 : qraw + (size_t)row * 768 + h * 96 + sub * 8;
            const bf16_t* rp = which ? proj + (size_t)row * PROJ_LD + 1408 + 2 * sub : qraw + (size_t)row * 768 + h * 96 + 64 + 2 * sub;
            const float* gain = which ? ((const float*)args.in[17]) : ((const float*)args.in[16]);
            float v[8]; unpack8(*(const u32x4*)np, v); const unsigned r1 = *(const unsigned*)rp, r2 = *(const unsigned*)(rp + 16);
            float t1[2] = {bflo(r1), bfhi(r1)}, t2[2] = {bflo(r2), bfhi(r2)};
            float s = (t1[0] * t1[0] + t1[1] * t1[1]) + (t2[0] * t2[0] + t2[1] * t2[1]);
#pragma unroll
            for (int e = 0; e < 8; ++e) s += v[e] * v[e];
            s += __shfl_xor(s, 1); s += __shfl_xor(s, 2); s += __shfl_xor(s, 4);
            const float rs = 1.0f / sqrtf(s * (1.0f / 96.0f) + EPS);
#pragma unroll
            for (int e = 0; e < 8; ++e) v[e] *= rs * gain[sub * 8 + e];
#pragma unroll
            for (int jj = 0; jj < 2; ++jj) { t1[jj] *= rs * gain[64 + 2 * sub + jj]; t2[jj] *= rs * gain[80 + 2 * sub + jj]; }
            float o1[2], o2[2];
#pragma unroll
            for (int jj = 0; jj < 2; ++jj) { o1[jj] = t1[jj] * cs[jj] - t2[jj] * sn[jj]; o2[jj] = t1[jj] * sn[jj] + t2[jj] * cs[jj]; }
            bf16_t* op = (which ? Kn : Qn) + (size_t)row * 768 + h * 96;
            *(u32x4*)(op + sub * 8) = pack8(v);
            *(unsigned*)(op + 64 + 2 * sub) = cvt_pk_bf16(o1[0], o1[1]);
            *(unsigned*)(op + 80 + 2 * sub) = cvt_pk_bf16(o2[0], o2[1]);
        }
    }
    const unsigned* Gt = (const unsigned*)args.out; float2* agg = WSP(float2, WS_AGG);
    for (int it = c.bid; it < 512; it += c.G) {
        const int d = it >> 8, chunk = it & 255; const unsigned* gp = Gt + ((size_t)d * T + (size_t)chunk * 64) * 512 + c.tid;
        float sl = 0.f, bv = 0.f;
#pragma unroll 16
        for (int i = 0; i < 64; ++i) { const int tt = d ? 63 - i : i; const unsigned w = gp[(size_t)tt * 512]; const float la = bflo(w); sl += la; bv = __expf(la) * bv + bfhi(w); }
        agg[(size_t)it * 512 + c.tid] = make_float2(sl, bv);
    }
}

__device__ __forceinline__ float gelu_tanh(float y) { const float u = 0.7978845608028654f * (y + 0.044715f * y * y * y); const float th = 1.0f - 2.0f / (__expf(2.0f * u) + 1.0f); return 0.5f * y * (1.0f + th); }
__device__ __forceinline__ void phase6(Ctx& c, const Args& args) {
    const unsigned* Gt = (const unsigned*)args.out; const float2* agg = WSP(float2, WS_AGG); const bf16_t* proj = WSP(bf16_t, WS_PROJ);
    LAS float* hl = (LAS float*)c.lds;
    bf16_t* amix = WSP(bf16_t, WS_AMIX); const bf16_t* mla = WSP(bf16_t, WS_MLA);
    const int ch = c.tid;
    for (int chunk = c.bid; chunk < 256; chunk += c.G) {
        const int b = chunk >> 7, cc = chunk & 127;
        float cf = 0.f, cb = 0.f;
#pragma unroll 8
        for (int q = 0; q < cc; ++q) { const float2 a = agg[((size_t)b * 128 + q) * 512 + ch]; cf = __expf(a.x) * cf + a.y; }
#pragma unroll 8
        for (int q = 127; q > cc; --q) { const float2 a = agg[((size_t)256 + b * 128 + q) * 512 + ch]; cb = __expf(a.x) * cb + a.y; }
        const size_t row0 = (size_t)chunk * 64;
        { const unsigned* gp = Gt + row0 * 512 + ch; float hcur = cf;
#pragma unroll 16
          for (int i = 0; i < 64; ++i) { const unsigned w = gp[(size_t)i * 512]; hcur = __expf(bflo(w)) * hcur + bfhi(w); hl[i * 512 + ch] = hcur; } }
        { const unsigned* gp = Gt + ((size_t)T + row0) * 512 + ch; const bf16_t* yp = proj + row0 * PROJ_LD + 512 + ch; float hcur = cb;
#pragma unroll 16
          for (int i = 63; i >= 0; --i) { const unsigned w = gp[(size_t)i * 512]; hcur = __expf(bflo(w)) * hcur + bfhi(w); const float y = bf2f(yp[(size_t)i * PROJ_LD]);
              hl[i * 512 + ch] = (hl[i * 512 + ch] + hcur) * gelu_tanh(y); } }
        __syncthreads();
#pragma unroll
        for (int rr = 0; rr < 8; ++rr) { const int r = c.wave * 8 + rr; const size_t row = row0 + r;
            float v[8]; { const LAS f32x4* p = (const LAS f32x4*)(hl + r * 512 + c.lane * 8); const f32x4 a = p[0], bq = p[1]; v[0] = a[0]; v[1] = a[1]; v[2] = a[2]; v[3] = a[3]; v[4] = bq[0]; v[5] = bq[1]; v[6] = bq[2]; v[7] = bq[3]; }
            float s = 0.f;
#pragma unroll
            for (int e = 0; e < 8; ++e) s += v[e] * v[e];
            float rs = 1.0f / sqrtf(wave_sum(s) * (1.0f / 512.0f) + EPS);
#pragma unroll
            for (int e = 0; e < 8; ++e) v[e] *= rs * ((const float*)args.in[18])[c.lane * 8 + e];
            *(u32x4*)(amix + row * 1024 + c.lane * 8) = pack8(v);
            unpack8(*(const u32x4*)(mla + row * 512 + c.lane * 8), v); s = 0.f;
#pragma unroll
            for (int e = 0; e < 8; ++e) s += v[e] * v[e];
            rs = 1.0f / sqrtf(wave_sum(s) * (1.0f / 512.0f) + EPS);
#pragma unroll
            for (int e = 0; e < 8; ++e) v[e] *= rs * ((const float*)args.in[19])[c.lane * 8 + e];
            *(u32x4*)(amix + row * 1024 + 512 + c.lane * 8) = pack8(v);
        }
        __syncthreads();
    }
}

__device__ __forceinline__ void phase12(Ctx& c, const Args& args, int bsel) {
    const bf16_t* gu = WSP(bf16_t, WS_GU); bf16_t* hid = WSP(bf16_t, WS_HID) + (size_t)bsel * SEQ * DFF;
    const int NI = SEQ * (DFF / 8);
    for (int it = c.bid * NTHR + c.tid; it < NI; it += c.G * NTHR) {
        const int t = it / (DFF / 8), j = (it % (DFF / 8)) * 8;
        float g[8], u[8];
#pragma unroll
        for (int e = 0; e < 8; ++e) { g[e] = ((const float*)args.in[31])[j + e]; u[e] = ((const float*)args.in[31])[DFF + j + e]; }
#pragma unroll
        for (int k = 0; k < 3; ++k) { const int tt = t + k - 1; if (tt < 0 || tt >= SEQ) continue;
            float a[8], bq[8]; unpack8(*(const u32x4*)(gu + (size_t)tt * DFF2 + j), a); unpack8(*(const u32x4*)(gu + (size_t)tt * DFF2 + DFF + j), bq);
#pragma unroll
            for (int e = 0; e < 8; ++e) { g[e] += ((const float*)args.in[30])[(size_t)k * DFF2 + j + e] * a[e]; u[e] += ((const float*)args.in[30])[(size_t)k * DFF2 + DFF + j + e] * bq[e]; } }
        float o[8];
#pragma unroll
        for (int e = 0; e < 8; ++e) o[e] = g[e] / (1.0f + __expf(-g[e])) * u[e];
        *(u32x4*)(hid + (size_t)t * DFF + j) = pack8(o);
    }
}

template <class Epi, class Sched> __device__ __forceinline__ void run_gemm(Ctx& c, const pg8::Gemm g, const Sched& S, const Epi& E) {
#if FAST_GEMM
    pg8::gemm_phase<Epi, Sched, true, true>(c.lds, g, S, E);
#else
    pg8::gemm_naive<Epi, Sched>(g, S, E);
#endif
}
__device__ __forceinline__ pg8::Sched2 sched1(Ctx& c, const void* A, const void* B, int nM, int nN, int lda, int ldb) {
    pg8::Sched2 s; s.a = pg8::Job{(const char*)A, (const char*)B, nM, nN}; s.b = pg8::Job{nullptr, nullptr, 0, 0}; s.G = c.G; s.c = c.bid; s.lda = lda; s.ldb = ldb; return s;
}
template <int DQK, int DV, bool QNORM> __device__ __forceinline__ void run_attn(Ctx& c, const bf16_t* Qb, int ldq, const bf16_t* Kh, int ldk, const bf16_t* Vh, int ldv, bf16_t* Ob, int ldo, int seq, float scale, const float* qg) {
#if FAST_ATTN
    att::attn_unit<DQK, DV, QNORM>(Qb, ldq, Kh, ldk, Vh, ldv, Ob, ldo, seq, scale, qg, c.ldsg);
#else
    att::attn_unit_naive<DQK, DV, QNORM>(Qb, ldq, Kh, ldk, Vh, ldv, Ob, ldo, seq, scale, qg, c.ldsg);
#endif
}

__device__ __forceinline__ void ph1(Ctx& c, const Args& args) {
    pg8::Sched2 S; S.a = pg8::Job{(const char*)WSP(bf16_t, WS_XB), (const char*)WSP(bf16_t, WS_WIN), T / 256, PROJ_LD / 256};
    S.b = pg8::Job{(const char*)WSP(bf16_t, WS_MEMN), (const char*)WSP(bf16_t, WS_WMKV), TM / 256, 4}; S.G = c.G; S.c = c.bid; S.lda = 1024; S.ldb = 1024;
    pg8::EpiBf<false> E{WSP(bf16_t, WS_PROJ), PROJ_LD, WSP(bf16_t, WS_MEMKV), 1024, nullptr};
    run_gemm(c, pg8::Gemm{1024, 1024, 1024}, S, E);
}
__device__ __forceinline__ void ph3(Ctx& c, const Args& args) {
    { pg8::Sched2 S = sched1(c, WSP(bf16_t, WS_CQ), WSP(bf16_t, WS_WUQ), T / 256, 3, 256, 256); pg8::EpiBf<false> E{WSP(bf16_t, WS_QRAW), 768, nullptr, 0, nullptr}; run_gemm(c, pg8::Gemm{256, 256, 256}, S, E); }
    { pg8::Sched2 S = sched1(c, WSP(bf16_t, WS_CKV), WSP(bf16_t, WS_WUKV), T / 256, 4, 128, 128); pg8::EpiBf<false> E{WSP(bf16_t, WS_KVRAW), 1024, nullptr, 0, nullptr}; run_gemm(c, pg8::Gemm{128, 128, 128}, S, E); }
    { pg8::GateOrder S{(const char*)WSP(bf16_t, WS_XC), (const char*)WSP(bf16_t, WS_WG), (size_t)T * 512 * 2, c.G, c.bid};
      pg8::EpiGates E{WSP(bf16_t, WS_XC), ((const float*)args.in[8]), ((const float*)args.in[10]), WSP(float, 0), (unsigned*)args.out, T}; run_gemm(c, pg8::Gemm{128, 512, 128}, S, E); }
}
__device__ __forceinline__ void ph5(Ctx& c, const Args& args) {
    for (int L = c.bid; L < 512; L += c.G) { const int bh = (L >> 8) * 8 + (L & 7), qb = (L & 255) >> 3; const int b = bh >> 3, h = bh & 7;
        run_attn<96, 64, false>(c, WSP(bf16_t, WS_QN) + ((size_t)b * SEQ + qb * 256) * 768 + h * 96, 768, WSP(bf16_t, WS_KN) + (size_t)b * SEQ * 768 + h * 96, 768,
                                WSP(bf16_t, WS_KVRAW) + (size_t)b * SEQ * 1024 + h * 128 + 64, 1024, WSP(bf16_t, WS_MLA) + ((size_t)b * SEQ + qb * 256) * 512 + h * 64, 512, SEQ, 0.10206207261596575f, nullptr); }
}
__device__ __forceinline__ void ph7(Ctx& c, const Args& args) {
    pg8::Sched2 S = sched1(c, WSP(bf16_t, WS_AMIX), WSP(bf16_t, WS_WOUT), T / 256, 4, 1024, 1024); pg8::EpiResid<true> E{((const float*)args.in[0]), args.out, WSP(bf16_t, WS_XB), WSP(float, WS_SS)};
    run_gemm(c, pg8::Gemm{1024, 1024, 1024}, S, E);
}
__device__ __forceinline__ void ph8(Ctx& c, const Args& args) {
    pg8::Sched2 S = sched1(c, WSP(bf16_t, WS_XB), WSP(bf16_t, WS_WMQ), T / 256, 2, 1024, 1024); pg8::EpiBf<true> E{WSP(bf16_t, WS_QMEM), 512, nullptr, 0, WSP(float, WS_SS)};
    run_gemm(c, pg8::Gemm{1024, 1024, 1024}, S, E);
}
__device__ __forceinline__ void ph9(Ctx& c, const Args& args) {
    for (int L = c.bid; L < 256; L += c.G) { const int rb = L >> 2, h = L & 3, b = rb >> 5;
        run_attn<128, 128, true>(c, WSP(bf16_t, WS_QMEM) + (size_t)rb * 256 * 512 + h * 128, 512, WSP(bf16_t, WS_MEMKV) + (size_t)b * MEMLEN * 1024 + h * 128, 1024,
                                 WSP(bf16_t, WS_MEMKV) + (size_t)b * MEMLEN * 1024 + 512 + h * 128, 1024, WSP(bf16_t, WS_OMEM) + (size_t)rb * 256 * 512 + h * 128, 512, MEMLEN, 0.08838834764831845f, ((const float*)args.in[25])); }
}
__device__ __forceinline__ void ph10(Ctx& c, const Args& args) {
    pg8::Sched2 S = sched1(c, WSP(bf16_t, WS_OMEM), WSP(bf16_t, WS_WMO), T / 256, 4, 512, 512); pg8::EpiResid<true> E{args.out, args.out, WSP(bf16_t, WS_XB), WSP(float, WS_SS)};
    run_gemm(c, pg8::Gemm{512, 512, 512}, S, E);
}
__device__ __forceinline__ void ph11(Ctx& c, const Args& args, int bsel) {
    pg8::Sched2 S = sched1(c, WSP(bf16_t, WS_XB) + (size_t)bsel * SEQ * 1024, WSP(bf16_t, WS_WUP), SEQ / 256, DFF2 / 256, 1024, 1024);
    pg8::EpiBf<true> E{WSP(bf16_t, WS_GU), DFF2, nullptr, 0, WSP(float, WS_SS) + (size_t)bsel * SEQ * 16};
    run_gemm(c, pg8::Gemm{1024, 1024, 1024}, S, E);
}
__device__ __forceinline__ void ph15(Ctx& c, const Args& args) {
    pg8::Sched2 S = sched1(c, WSP(bf16_t, WS_HID), WSP(bf16_t, WS_WDN), T / 256, 4, DFF, DFF); pg8::EpiResid<false> E{args.out, args.out, nullptr, nullptr};
    run_gemm(c, pg8::Gemm{DFF, DFF, DFF}, S, E);
}

constexpr int N_PHASES = 16;
#ifndef PH_MASK
#define PH_MASK 0xFFFF
#endif
#ifndef DUP_MASK
#define DUP_MASK 0
#endif
#ifndef EXTRA_SYNCS
#define EXTRA_SYNCS 0
#endif
__global__ void __launch_bounds__(NTHR) fwd_kernel(Args args) {
    extern __shared__ __attribute__((aligned(16))) unsigned char lds_raw[];
    cg::grid_group grid = cg::this_grid();
    Ctx c;
    c.lds = (LAS unsigned char*)lds_raw; c.ldsg = (char*)lds_raw;
    c.tid = threadIdx.x; c.lane = c.tid & 63; c.wave = __builtin_amdgcn_readfirstlane(c.tid >> 6); c.bid = blockIdx.x; c.G = gridDim.x;
    for (int u = c.tid; u < (LDS_BYTES - LDSCTL_OFF) / 4; u += NTHR) ((LAS unsigned*)(c.lds + LDSCTL_OFF))[u] = 0u;
    __syncthreads();
    XcdBarrier bar = xcd_barrier_post((unsigned*)(args.ws + WS_BAR), (volatile LAS unsigned*)(c.lds + MISC_OFF) + 8);
    const int lo = args.ph_lo, hi = args.ph_hi;
#define IN(k) (((PH_MASK >> (k)) & 1) && lo <= (k) && (k) < hi)
#define DUPQ(k) (((DUP_MASK >> (k)) & 1) && IN(k))
#define SEAM(k) do { if (IN(k) && IN((k) + 1)) { if ((k) == 0) grid.sync(); else xcd_barrier(bar); } } while (0)
#define PH(k, call) do { if (IN(k)) { call; } if (DUPQ(k)) { grid.sync(); call; } } while (0)
    PH(0, phase0(c, args)); SEAM(0);
#pragma unroll 1
    for (int es_ = 0; es_ < EXTRA_SYNCS; ++es_) grid.sync();
    PH(1, ph1(c, args)); SEAM(1);
    PH(2, phase2(c, args)); SEAM(2);
    PH(3, ph3(c, args)); SEAM(3);
    PH(4, phase4(c, args)); SEAM(4);
    PH(5, ph5(c, args)); SEAM(5);
    PH(6, phase6(c, args)); SEAM(6);
    PH(7, ph7(c, args)); SEAM(7);
    PH(8, ph8(c, args)); SEAM(8);
    PH(9, ph9(c, args)); SEAM(9);
    PH(10, ph10(c, args)); SEAM(10);
    PH(11, ph11(c, args, 0)); SEAM(11);
    PH(12, phase12(c, args, 0)); SEAM(12);
    PH(13, ph11(c, args, 1)); SEAM(13);
    PH(14, phase12(c, args, 1)); SEAM(14);
    PH(15, ph15(c, args));
#undef IN
#undef SEAM
}

#ifndef N_LAUNCHES
#define N_LAUNCHES 1
#endif
extern "C" void kernel_launch(void* const* d_in, const int* in_sizes, int n_in, void* d_out, int out_size, void* d_ws, size_t ws_size, hipStream_t stream) {
    static int grid = 0;
    if (grid == 0) {
        if (n_in != 33 || in_sizes[0] != T * DM || out_size != T * DM || ws_size < WS_END) { fprintf(stderr, "kernel_launch: unexpected shapes (n_in %d, in0 %d, out %d, ws %zu)\n", n_in, n_in > 0 ? in_sizes[0] : -1, out_size, ws_size); grid = -1; return; }
        int dev = 0, cus = 0, per_cu = 0;
        if (hipGetDevice(&dev) != hipSuccess || hipDeviceGetAttribute(&cus, hipDeviceAttributeMultiprocessorCount, dev) != hipSuccess) { grid = -1; return; }
        if (hipFuncSetAttribute((const void*)fwd_kernel, hipFuncAttributeMaxDynamicSharedMemorySize, LDS_BYTES) != hipSuccess) { fprintf(stderr, "kernel_launch: hipFuncSetAttribute failed\n"); grid = -1; return; }
        if (hipOccupancyMaxActiveBlocksPerMultiprocessor(&per_cu, (const void*)fwd_kernel, NTHR, LDS_BYTES) != hipSuccess || per_cu < 1) { fprintf(stderr, "kernel_launch: occupancy query says %d\n", per_cu); per_cu = 1; }
        (void)hipGetLastError();
        if (per_cu > 1) per_cu = 1;
        grid = cus * per_cu;
    }
    if (grid < 0) return;
    if (hipMemsetAsync((char*)d_ws + WS_BAR, 0, BAR_ZERO_BYTES, stream) != hipSuccess) { fprintf(stderr, "kernel_launch: hipMemsetAsync failed\n"); return; }
    Args a{};
    for (int i = 0; i < 33; ++i) a.in[i] = d_in[i];
    a.out = (float*)d_out; a.ws = (unsigned char*)d_ws;
#if N_LAUNCHES == 1
    a.ph_lo = 0; a.ph_hi = N_PHASES;
    void* kargs[] = {&a};
    const hipError_t e = hipLaunchCooperativeKernel((const void*)fwd_kernel, dim3(grid), dim3(NTHR), kargs, LDS_BYTES, stream);
    if (e != hipSuccess) fprintf(stderr, "kernel_launch: cooperative launch failed: %s (grid %d)\n", hipGetErrorString(e), grid);
#else
    for (int p = 0; p < N_PHASES; ++p) { a.ph_lo = p; a.ph_hi = p + 1; hipLaunchKernelGGL(fwd_kernel, dim3(grid), dim3(NTHR), LDS_BYTES, stream, a); }
#endif
}
```

```cpp
#include <hip/hip_runtime.h>
#include <hip/hip_cooperative_groups.h>
#include <cstdio>
#include <cstdint>
namespace cg = cooperative_groups;

#ifndef FAST_GEMM
#define FAST_GEMM 1
#endif
#ifndef FAST_ATTN
#define FAST_ATTN 1
#endif

namespace pg8 {
#define PG8_LAS __attribute__((address_space(3)))
typedef unsigned short bf16_t;
typedef short bf16x8 __attribute__((ext_vector_type(8)));
typedef float f32x4 __attribute__((ext_vector_type(4)));
typedef unsigned u32x4 __attribute__((ext_vector_type(4)));
constexpr int BM = 256, BK = 64, HALF = 128, HTB = HALF * BK * 2  , STAGE_BYTES = 8 * HTB, NXCD = 8, WGM = 8;

__host__ __device__ __forceinline__ int lds_byte(int r, int c) { const int st = (r >> 4) * 2 + (c >> 5), rr = r & 15, cc = c & 31, ob = rr * 64 + cc * 2; return st * 1024 + (ob ^ (((ob >> 9) & 1) << 5)); }
__host__ __device__ __forceinline__ void stage_rc(int b, int& R, int& C) { const int st = b / 1024, sb = b % 1024, swz = sb ^ (((sb >> 9) & 1) << 5); R = (st >> 1) * 16 + swz / 64; C = (st & 1) * 32 + (swz % 64) / 2; }
__host__ __device__ __forceinline__ int perm32(int rho) { const int n = rho >> 4, i = rho & 15; return 8 * (i >> 2) + 4 * n + (i & 3); }

typedef unsigned u32x2 __attribute__((ext_vector_type(2)));
struct Unit { int pm, pn, job; const char* A; const char* B; };
struct Gemm { int K, lda, ldb; };

template <class Epi, class Sched, bool ALIGN_EPI = false, bool SP2 = false>
__device__ __forceinline__ void gemm_phase(PG8_LAS unsigned char* lds, const Gemm g, const Sched& S, const Epi& E) {
    const int tid = threadIdx.x, wid = __builtin_amdgcn_readfirstlane(tid >> 6), lane = tid & 63, wr = wid >> 2, wc = wid & 3, fr = lane & 15, fq = lane >> 4;
    int Kopq = g.K; asm volatile("" : "+s"(Kopq));
    const int K = Kopq, nt = K / BK;
    unsigned voffA[2], voffB[2];
#pragma unroll
    for (int i = 0; i < 2; ++i) { int R, C; stage_rc(tid * 16 + i * 8192, R, C); const int Rb = Epi::PERM ? ((R & ~31) + perm32(R & 31)) : R;
        voffA[i] = (unsigned)(R * g.lda + C) * 2u; voffB[i] = (unsigned)(Rb * g.ldb + C) * 2u; }
    const size_t kstep = (size_t)(BK * 2);
    const size_t hstepA = (size_t)HALF * g.lda * 2, hstepB = (size_t)HALF * g.ldb * 2;
    const unsigned ldsw = (unsigned)wid * 1024u;
    const int aoff = lds_byte(wr * 64 + fr, fq * 8), boff = lds_byte(wc * 32 + fr, fq * 8);
#define PG8_SA(b, h) (((b) * 2 + (h)) * HTB)
#define PG8_SB(b, h) ((4 + (b) * 2 + (h)) * HTB)
#define PG8_STAGE(bufoff, gbase, voff) do { _Pragma("unroll") for (int _i = 0; _i < 2; ++_i) \
        __builtin_amdgcn_global_load_lds((const unsigned*)((const char*)(gbase) + (voff)[_i]), (PG8_LAS unsigned*)(lds + (bufoff) + ldsw + _i * 8192), 16, 0, 0); } while (0)
#define PG8_LDA(dst, b, h) do { _Pragma("unroll") for (int m = 0; m < 4; ++m) _Pragma("unroll") for (int k = 0; k < 2; ++k) dst[m][k] = *(const PG8_LAS bf16x8*)(lds + PG8_SA(b, h) + aoff + m * 2048 + k * 1024); } while (0)
#define PG8_LDB(dst, b, h) do { _Pragma("unroll") for (int n = 0; n < 2; ++n) _Pragma("unroll") for (int k = 0; k < 2; ++k) dst[n][k] = *(const PG8_LAS bf16x8*)(lds + PG8_SB(b, h) + boff + n * 2048 + k * 1024); } while (0)
#define PG8_MMA(ai, bj, At, Bt) do { __builtin_amdgcn_s_setprio(1); _Pragma("unroll") for (int m = 0; m < 4; ++m) _Pragma("unroll") for (int n = 0; n < 2; ++n) _Pragma("unroll") for (int k = 0; k < 2; ++k) \
        acc[ai][bj][m][n] = __builtin_amdgcn_mfma_f32_16x16x32_bf16(Bt[n][k], At[m][k], acc[ai][bj][m][n], 0, 0, 0); __builtin_amdgcn_s_setprio(0); } while (0)
#define PG8_WAIT_V(n) asm volatile("s_waitcnt vmcnt(" #n ")" ::: "memory")
#define PG8_WAIT_L(n) asm volatile("s_waitcnt lgkmcnt(" #n ")" ::: "memory")
#define PG8_BAR __builtin_amdgcn_s_barrier()
#define PG8_SCHED __builtin_amdgcn_sched_barrier(0)
    Unit cur, nxt; int ui = 0;
    if (!S.next(0, cur)) return;
    f32x4 acc[2][2][4][2];
#pragma unroll
    for (int a = 0; a < 2; ++a)
#pragma unroll
        for (int b = 0; b < 2; ++b)
#pragma unroll
            for (int m = 0; m < 4; ++m)
#pragma unroll
                for (int n = 0; n < 2; ++n) acc[a][b][m][n] = (f32x4){0.f, 0.f, 0.f, 0.f};
    bf16x8 At[4][2], B0[2][2], B1[2][2];
    const char* cA = cur.A; const char* cB = cur.B;
    S.a_ready(cur);
    if constexpr (SP2) {
        PG8_STAGE(PG8_SB(0, 0), cB, voffB); PG8_STAGE(PG8_SB(0, 1), cB + hstepB, voffB); PG8_STAGE(PG8_SA(0, 0), cA, voffA); PG8_STAGE(PG8_SA(0, 1), cA + hstepA, voffA);
        if (wr == 1) PG8_BAR;
        PG8_WAIT_V(2); PG8_BAR;
        PG8_STAGE(PG8_SB(1, 0), cB + kstep, voffB); PG8_STAGE(PG8_SA(1, 0), cA + kstep, voffA); PG8_STAGE(PG8_SB(1, 1), cB + hstepB + kstep, voffB);
        PG8_WAIT_V(6); PG8_BAR;
    } else {
        PG8_STAGE(PG8_SB(0, 0), cB, voffB); PG8_STAGE(PG8_SA(0, 0), cA, voffA); PG8_STAGE(PG8_SB(0, 1), cB + hstepB, voffB); PG8_STAGE(PG8_SA(0, 1), cA + hstepA, voffA);
        if (wr == 1) PG8_BAR;
        PG8_WAIT_V(4); PG8_BAR;
        PG8_STAGE(PG8_SB(1, 0), cB + kstep, voffB); PG8_STAGE(PG8_SA(1, 0), cA + kstep, voffA); PG8_STAGE(PG8_SB(1, 1), cB + hstepB + kstep, voffB);
        PG8_WAIT_V(6); PG8_BAR;
    }
    for (;;) {
        const bool has_next = S.next(ui + 1, nxt);
        const char* nA = has_next ? nxt.A : cA; const char* nB = has_next ? nxt.B : cB;
        for (int t = 0; t < nt; t += 2) {
            const bool last = (t == nt - 2);
            const char* a1 = cA + (size_t)(t + 1) * kstep;
            const char* a2 = last ? nA : cA + (size_t)(t + 2) * kstep; const char* b2 = last ? nB : cB + (size_t)(t + 2) * kstep;
            const char* a3 = a2 + kstep; const char* b3 = b2 + kstep;
            if (last && has_next) S.a_ready(nxt);
            if constexpr (SP2) {
            PG8_LDB(B0, 0, 0); PG8_LDB(B1, 0, 1); PG8_SCHED; PG8_LDA(At, 0, 0); PG8_STAGE(PG8_SA(1, 1), a1 + hstepA, voffA);
            PG8_WAIT_V(8); PG8_WAIT_L(0); PG8_BAR; PG8_MMA(0, 0, At, B0); PG8_MMA(0, 1, At, B1); PG8_BAR; PG8_SCHED;
            PG8_LDA(At, 0, 1); PG8_STAGE(PG8_SB(0, 0), b2, voffB); PG8_STAGE(PG8_SB(0, 1), b2 + hstepB, voffB); PG8_STAGE(PG8_SA(0, 0), a2, voffA);
            PG8_WAIT_V(8); PG8_WAIT_L(0); PG8_BAR; PG8_MMA(1, 0, At, B0); PG8_MMA(1, 1, At, B1); PG8_BAR; PG8_SCHED;
            PG8_LDB(B0, 1, 0); PG8_LDB(B1, 1, 1); PG8_SCHED; PG8_LDA(At, 1, 0); PG8_STAGE(PG8_SA(0, 1), a2 + hstepA, voffA);
            PG8_WAIT_V(8); PG8_WAIT_L(0); PG8_BAR; PG8_MMA(0, 0, At, B0); PG8_MMA(0, 1, At, B1); PG8_BAR; PG8_SCHED;
            PG8_LDA(At, 1, 1); PG8_STAGE(PG8_SB(1, 0), b3, voffB); PG8_STAGE(PG8_SB(1, 1), b3 + hstepB, voffB); PG8_STAGE(PG8_SA(1, 0), a3, voffA);
            PG8_WAIT_V(8); PG8_WAIT_L(0); PG8_BAR; PG8_MMA(1, 0, At, B0); PG8_MMA(1, 1, At, B1); PG8_BAR; PG8_SCHED;
            } else {
            PG8_LDB(B0, 0, 0); PG8_SCHED; PG8_LDA(At, 0, 0); PG8_STAGE(PG8_SA(1, 1), a1 + hstepA, voffA);
            PG8_WAIT_L(8); PG8_BAR; PG8_WAIT_L(0); PG8_MMA(0, 0, At, B0); PG8_BAR; PG8_SCHED;
            PG8_LDB(B1, 0, 1); PG8_STAGE(PG8_SB(0, 0), b2, voffB);
            PG8_BAR; PG8_WAIT_L(0); PG8_MMA(0, 1, At, B1); PG8_BAR;
            PG8_LDA(At, 0, 1); PG8_STAGE(PG8_SA(0, 0), a2, voffA);
            PG8_BAR; PG8_WAIT_L(0); PG8_MMA(1, 0, At, B0); PG8_BAR; PG8_SCHED;
            PG8_STAGE(PG8_SB(0, 1), b2 + hstepB, voffB);
            PG8_WAIT_V(6); PG8_BAR; PG8_MMA(1, 1, At, B1); PG8_BAR;
            PG8_LDB(B0, 1, 0); PG8_SCHED; PG8_LDA(At, 1, 0); PG8_STAGE(PG8_SA(0, 1), a2 + hstepA, voffA);
            PG8_WAIT_L(8); PG8_BAR; PG8_WAIT_L(0); PG8_MMA(0, 0, At, B0); PG8_BAR; PG8_SCHED;
            PG8_LDB(B1, 1, 1); PG8_STAGE(PG8_SB(1, 0), b3, voffB);
            PG8_BAR; PG8_WAIT_L(0); PG8_MMA(0, 1, At, B1); PG8_BAR;
            PG8_LDA(At, 1, 1); PG8_STAGE(PG8_SA(1, 0), a3, voffA);
            PG8_BAR; PG8_WAIT_L(0); PG8_MMA(1, 0, At, B0); PG8_BAR; PG8_SCHED;
            PG8_STAGE(PG8_SB(1, 1), b3 + hstepB, voffB);
            PG8_WAIT_V(6); PG8_BAR; PG8_MMA(1, 1, At, B1); PG8_BAR;
            }
        }
        if constexpr (ALIGN_EPI) { if (wr == 0) PG8_BAR; }
        if constexpr (!Epi::AFTER_DRAIN) { E(acc, cur, wr, wc, fr, fq); S.done(cur); }
        if (!has_next) break;
#pragma unroll
        for (int a = 0; a < 2; ++a)
#pragma unroll
            for (int b = 0; b < 2; ++b)
#pragma unroll
                for (int m = 0; m < 4; ++m)
#pragma unroll
                    for (int n = 0; n < 2; ++n) acc[a][b][m][n] = (f32x4){0.f, 0.f, 0.f, 0.f};
        cur = nxt; cA = nA; cB = nB; ++ui;
        if constexpr (ALIGN_EPI) { if (wr == 1) PG8_BAR; }
    }
    PG8_WAIT_V(0);
    if constexpr (!ALIGN_EPI) { if (wr == 0) PG8_BAR; }
    PG8_BAR;
    if constexpr (Epi::AFTER_DRAIN) { E.fused(acc, cur, wr, wc, fr, fq, lds, wid, lane); S.done(cur); }
#undef PG8_SA
#undef PG8_SB
#undef PG8_STAGE
#undef PG8_LDA
#undef PG8_LDB
#undef PG8_MMA
#undef PG8_WAIT_V
#undef PG8_WAIT_L
#undef PG8_BAR
#undef PG8_SCHED
}

__device__ __forceinline__ float bf2f(bf16_t v) { return __uint_as_float((unsigned)v << 16); }
__device__ __forceinline__ float bflo(unsigned w) { return __uint_as_float(w << 16); }
__device__ __forceinline__ float bfhi(unsigned w) { return __uint_as_float(w & 0xffff0000u); }
__device__ __forceinline__ unsigned cvt_pk_bf16(float lo, float hi) { unsigned r; asm volatile("v_cvt_pk_bf16_f32 %0, %1, %2" : "=v"(r) : "v"(lo), "v"(hi)); return r; }

template <class Epi, class Sched>
__device__ __forceinline__ void gemm_naive(const Gemm g, const Sched& S, const Epi& E) {
    const int tid = threadIdx.x, wid = tid >> 6, lane = tid & 63, wr = wid >> 2, wc = wid & 3, fr = lane & 15, fq = lane >> 4;
    Unit u;
    for (int i = 0; S.next(i, u); ++i) {
        f32x4 acc[2][2][4][2];
#pragma unroll
        for (int ai = 0; ai < 2; ++ai)
#pragma unroll
            for (int bj = 0; bj < 2; ++bj)
#pragma unroll
                for (int m = 0; m < 4; ++m)
#pragma unroll
                    for (int n = 0; n < 2; ++n) {
                        const bf16_t* a = (const bf16_t*)u.A + (size_t)(ai * 128 + wr * 64 + m * 16 + fr) * g.lda;
                        const bf16_t* b = (const bf16_t*)u.B + (size_t)(bj * 128 + wc * 32 + n * 16 + 4 * fq) * g.ldb;
                        float s0 = 0.f, s1 = 0.f, s2 = 0.f, s3 = 0.f;
                        for (int k = 0; k < g.K; k += 8) {
                            const bf16x8 av = *(const bf16x8*)(a + k), b0 = *(const bf16x8*)(b + k), b1 = *(const bf16x8*)(b + g.ldb + k), b2 = *(const bf16x8*)(b + 2 * g.ldb + k), b3 = *(const bf16x8*)(b + 3 * g.ldb + k);
#pragma unroll
                            for (int e = 0; e < 8; ++e) { const float x = bf2f((bf16_t)av[e]); s0 += x * bf2f((bf16_t)b0[e]); s1 += x * bf2f((bf16_t)b1[e]); s2 += x * bf2f((bf16_t)b2[e]); s3 += x * bf2f((bf16_t)b3[e]); }
                        }
                        acc[ai][bj][m][n] = (f32x4){s0, s1, s2, s3};
                    }
        E(acc, u, wr, wc, fr, fq);
    }
}

struct Job { const char* A; const char* B; int nM, nN; };
struct Sched2 {
    Job a, b; int G, c, lda, ldb;
    __device__ __forceinline__ bool next(int i, Unit& u) const {
        int L = i * G + c; const int na = a.nM * a.nN, nb = b.nM * b.nN;
        if (L < na) { u.job = 0; u.pm = L % a.nM; u.pn = L / a.nM; u.A = a.A + (size_t)u.pm * 256 * lda * 2; u.B = a.B + (size_t)u.pn * 256 * ldb * 2; return true; }
        L -= na;
        if (L < nb) { u.job = 1; u.pm = L % b.nM; u.pn = L / b.nM; u.A = b.A + (size_t)u.pm * 256 * lda * 2; u.B = b.B + (size_t)u.pn * 256 * ldb * 2; return true; }
        return false;
    }
    __device__ __forceinline__ void a_ready(const Unit&) const {}
    __device__ __forceinline__ void done(const Unit&) const {}
};
struct GateOrder {
    const char* xc; const char* wg; size_t dstride; int G, c;
    __device__ __forceinline__ bool next(int i, Unit& u) const {
        const int L = i * G + c; if (L >= 512) return false;
        const int grp = L >> 6, pm = L & 63, d = grp >> 2, png = grp & 3;
        u.job = d; u.pm = pm; u.pn = png; u.A = xc + (size_t)d * dstride + ((size_t)pm * 256 * 512 + png * 128) * 2; u.B = wg + (size_t)grp * 256 * 128 * 2; return true;
    }
    __device__ __forceinline__ void a_ready(const Unit&) const {}
    __device__ __forceinline__ void done(const Unit&) const {}
};

__device__ __forceinline__ float rowscale16(const float* ss, int row) {
    const f32x4* p = (const f32x4*)(ss + (size_t)row * 16); const f32x4 a = p[0], b = p[1], c = p[2], d = p[3];
    const float s = ((a[0] + a[1]) + (a[2] + a[3])) + ((b[0] + b[1]) + (b[2] + b[3])) + ((c[0] + c[1]) + (c[2] + c[3])) + ((d[0] + d[1]) + (d[2] + d[3]));
    return 1.0f / sqrtf(s * (1.0f / 1024.0f) + 1e-6f);
}
template <bool ROWSCALE> struct EpiBf {
    static constexpr bool PERM = false, AFTER_DRAIN = false;
    bf16_t* O0; int ld0; bf16_t* O1; int ld1; const float* ss;
    __device__ __forceinline__ void operator()(const f32x4 (&acc)[2][2][4][2], const Unit& u, int wr, int wc, int fr, int fq) const {
        bf16_t* O = u.job ? O1 : O0; const int ldc = u.job ? ld1 : ld0;
        const int row0 = u.pm * 256 + wr * 64 + fr, col0 = u.pn * 256 + wc * 32 + 4 * fq;
#pragma unroll
        for (int ai = 0; ai < 2; ++ai)
#pragma unroll
            for (int m = 0; m < 4; ++m) { const int row = row0 + ai * 128 + m * 16; float rs = 1.f; if (ROWSCALE) rs = rowscale16(ss, row);
                bf16_t* rowp = O + (size_t)row * ldc + col0;
#pragma unroll
                for (int bj = 0; bj < 2; ++bj)
#pragma unroll
                    for (int n = 0; n < 2; ++n) { const f32x4 v = acc[ai][bj][m][n] * rs; u32x2 w; w.x = cvt_pk_bf16(v[0], v[1]); w.y = cvt_pk_bf16(v[2], v[3]); *(u32x2*)(rowp + bj * 128 + n * 16) = w; } }
    }
};
template <bool STATS> struct EpiResid {
    static constexpr bool PERM = false, AFTER_DRAIN = false;
    const float* base; float* out; bf16_t* xb; float* ss;
    __device__ __forceinline__ void operator()(const f32x4 (&acc)[2][2][4][2], const Unit& u, int wr, int wc, int fr, int fq) const {
        const int row0 = u.pm * 256 + wr * 64 + fr, col0 = u.pn * 256 + wc * 32 + 4 * fq;
#pragma unroll
        for (int ai = 0; ai < 2; ++ai)
#pragma unroll
            for (int m = 0; m < 4; ++m) { const int row = row0 + ai * 128 + m * 16; const size_t off = (size_t)row * 1024 + col0; float s = 0.f;
#pragma unroll
                for (int bj = 0; bj < 2; ++bj)
#pragma unroll
                    for (int n = 0; n < 2; ++n) { const size_t o2 = off + bj * 128 + n * 16; const f32x4 v = *(const f32x4*)(base + o2) + acc[ai][bj][m][n]; *(f32x4*)(out + o2) = v;
                        if (STATS) { s += (v[0] * v[0] + v[1] * v[1]) + (v[2] * v[2] + v[3] * v[3]); u32x2 w; w.x = cvt_pk_bf16(v[0], v[1]); w.y = cvt_pk_bf16(v[2], v[3]); *(u32x2*)(xb + o2) = w; } }
                if (STATS) { s += __shfl_xor(s, 16); s += __shfl_xor(s, 32); if (fq == 0) ss[(size_t)row * 16 + u.pn * 4 + wc] = s; } }
    }
};
struct EpiGates {
    static constexpr bool PERM = false, AFTER_DRAIN = false;
    const bf16_t* xc; const float* b_a; const float* b_i; const float* c8t; unsigned* G; int T;
    __device__ __forceinline__ void operator()(const f32x4 (&acc)[2][2][4][2], const Unit& u, int wr, int wc, int fr, int fq) const {
        const int d = u.job, row0 = u.pm * 256 + wr * 64 + fr, ch0 = u.pn * 128 + wc * 32 + 4 * fq;
#pragma unroll
        for (int n = 0; n < 2; ++n) { const int ch = d * 512 + ch0 + n * 16; const f32x4 ba = *(const f32x4*)(b_a + ch), bi = *(const f32x4*)(b_i + ch), c8 = *(const f32x4*)(c8t + ch);
#pragma unroll
            for (int ai = 0; ai < 2; ++ai)
#pragma unroll
                for (int m = 0; m < 4; ++m) { const int row = row0 + ai * 128 + m * 16;
                    const size_t off = ((size_t)d * T + row) * 512 + ch0 + n * 16; const u32x2 xw = *(const u32x2*)(xc + off);
                    const float xv[4] = {bflo(xw.x), bfhi(xw.x), bflo(xw.y), bfhi(xw.y)}; const f32x4 pa = acc[ai][0][m][n] + ba, pi = acc[ai][1][m][n] + bi; u32x4 o;
#pragma unroll
                    for (int e = 0; e < 4; ++e) { const float r = 1.0f / (1.0f + __expf(-pa[e])), ig = 1.0f / (1.0f + __expf(-pi[e])); const float la = r * c8[e];
                        const float x2 = 2.0f * la; const float om = (x2 > -0.02f) ? -(x2 + 0.5f * x2 * x2 + x2 * x2 * x2 * (1.0f / 6.0f)) : 1.0f - __expf(x2);
                        o[e] = cvt_pk_bf16(la, sqrtf(fmaxf(om, 0.f)) * ig * xv[e]); }
                    *(u32x4*)(G + off) = o; asm volatile("" ::: "memory"); } }
    }
};
}

namespace att {
using pg8::bf16_t;
using bf16x8 = __attribute__((ext_vector_type(8))) short;
using s16x4  = __attribute__((ext_vector_type(4))) short;
using f32x16 = __attribute__((ext_vector_type(16))) float;
using u32x4  = __attribute__((ext_vector_type(4))) unsigned;
constexpr int NW = 8, QBLK = 32, KVBLK = 64;
constexpr size_t SHM_V = KVBLK * 128 * 2, SHM_K = KVBLK * 128 * 2, SHM_ATTN = 2 * SHM_V + 2 * SHM_K + NW * 64 * 4;
constexpr float THR = 8.f;
#define KSWZ(row, colB) ((row) * 256 + ((colB) ^ (((row) & 7) << 4)))
#define SBAR() __builtin_amdgcn_sched_barrier(0)
__device__ __forceinline__ int crow(int r, int hi) { return (r & 3) + 8 * (r >> 2) + 4 * hi; }
__device__ __forceinline__ unsigned cvtpk(float lo, float hi) { unsigned r; asm volatile("v_cvt_pk_bf16_f32 %0, %1, %2" : "=v"(r) : "v"(lo), "v"(hi)); return r; }
__device__ __forceinline__ void partialSM(f32x16& p0, f32x16& p1, float& m_reg, float& mn, float& alpha, float C, float thr_raw) {
  float pmax = p0[0];
#pragma unroll
  for (int r = 1; r < 16; ++r) pmax = fmaxf(pmax, p0[r]);
#pragma unroll
  for (int r = 0; r < 16; ++r) pmax = fmaxf(pmax, p1[r]);
  { auto rr = __builtin_amdgcn_permlane32_swap(__float_as_uint(pmax), __float_as_uint(pmax), false, false);
    pmax = fmaxf(__uint_as_float(rr[0]), __uint_as_float(rr[1])); }
  if (__builtin_expect(__all(pmax - m_reg <= thr_raw), 1)) { mn = m_reg; alpha = 1.f; }
  else { mn = fmaxf(m_reg, pmax); alpha = __builtin_amdgcn_exp2f((m_reg - mn) * C); m_reg = mn; }
  const float mnC = -mn * C;
#pragma unroll
  for (int r = 0; r < 16; ++r) p0[r] = fmaf(p0[r], C, mnC);
#pragma unroll
  for (int r = 0; r < 16; ++r) p1[r] = fmaf(p1[r], C, mnC);
#pragma unroll
  for (int r = 0; r < 16; ++r) p0[r] = __builtin_amdgcn_exp2f(p0[r]);
}
__device__ __forceinline__ void finishSM(f32x16& p0, f32x16& p1, float alpha, float& l_reg, bf16x8& pa0, bf16x8& pa1, bf16x8& pa2, bf16x8& pa3) {
#pragma unroll
  for (int r = 0; r < 16; ++r) p1[r] = __builtin_amdgcn_exp2f(p1[r]);
  float ps = 0;
#pragma unroll
  for (int r = 0; r < 16; ++r) ps += p0[r];
#pragma unroll
  for (int r = 0; r < 16; ++r) ps += p1[r];
  { auto rr = __builtin_amdgcn_permlane32_swap(__float_as_uint(ps), __float_as_uint(ps), false, false);
    ps = __uint_as_float(rr[0]) + __uint_as_float(rr[1]); }
  l_reg = l_reg * alpha + ps;
#define PK4(P, BASE, OUT) do { unsigned a0 = cvtpk(P[BASE + 0], P[BASE + 1]), a1 = cvtpk(P[BASE + 2], P[BASE + 3]);   \
    unsigned b0 = cvtpk(P[BASE + 4], P[BASE + 5]), b1 = cvtpk(P[BASE + 6], P[BASE + 7]);                              \
    auto r0 = __builtin_amdgcn_permlane32_swap(a0, b0, false, false); auto r1 = __builtin_amdgcn_permlane32_swap(a1, b1, false, false); \
    u32x4 w = {r0[0], r1[0], r0[1], r1[1]}; OUT = *reinterpret_cast<bf16x8*>(&w); } while (0)
  PK4(p0, 0, pa0); PK4(p0, 8, pa1); PK4(p1, 0, pa2); PK4(p1, 8, pa3);
#undef PK4
}
template <int DQK> __device__ __forceinline__ void qkt(f32x16& p0, f32x16& p1, const bf16_t* Ks, const bf16x8* qr, int r32, int hi) {
  p0 = f32x16{}; p1 = f32x16{};
#pragma unroll
  for (int d0 = 0; d0 < DQK / 16; ++d0) { const int cb = (d0 * 16 + hi * 8) * 2;
    const bf16x8 b0 = *reinterpret_cast<const bf16x8*>((const char*)Ks + KSWZ(r32, cb));
    const bf16x8 b1 = *reinterpret_cast<const bf16x8*>((const char*)Ks + KSWZ(32 + r32, cb));
    p0 = __builtin_amdgcn_mfma_f32_32x32x16_bf16(b0, qr[d0], p0, 0, 0, 0);
    p1 = __builtin_amdgcn_mfma_f32_32x32x16_bf16(b1, qr[d0], p1, 0, 0, 0); }
}
__device__ __forceinline__ int v_st(int k, int c) { const int kk = (k & ~0xC) | ((k & 4) << 1) | ((k & 8) >> 1); return ((kk >> 3) * 4 + (c >> 5)) * 512 + ((kk & 7) * 32 + (c & 31)) * 2; }
__device__ __forceinline__ int v_rd_base(int lane) { return ((lane & 3) << 3) | (((lane >> 2) & 3) << 6) | (((lane >> 4) & 1) << 5) | (((lane >> 5) & 1) << 8); }
constexpr int v_rd_off(int d0, int ks, int half) { return d0 * 512 + ks * 4096 + half * 2048; }
template <int OFF> __device__ __forceinline__ s16x4 tr_read(int vb) {
  s16x4 r; asm volatile("ds_read_b64_tr_b16 %0, %1 offset:%2" : "=&v"(r) : "v"(vb), "i"(OFF) : "memory"); return r;
}
template <int D0> __device__ __forceinline__ void pv_one(f32x16& od, int vb, bf16x8 pa0, bf16x8 pa1, bf16x8 pa2, bf16x8 pa3) {
  const s16x4 l0 = tr_read<v_rd_off(D0, 0, 0)>(vb), h0 = tr_read<v_rd_off(D0, 0, 1)>(vb), l1 = tr_read<v_rd_off(D0, 1, 0)>(vb), h1 = tr_read<v_rd_off(D0, 1, 1)>(vb);
  const s16x4 l2 = tr_read<v_rd_off(D0, 2, 0)>(vb), h2 = tr_read<v_rd_off(D0, 2, 1)>(vb), l3 = tr_read<v_rd_off(D0, 3, 0)>(vb), h3 = tr_read<v_rd_off(D0, 3, 1)>(vb);
  asm volatile("s_waitcnt lgkmcnt(0)" ::: "memory"); SBAR();
#define PK(L, H) (bf16x8){L[0], L[1], L[2], L[3], H[0], H[1], H[2], H[3]}
  od = __builtin_amdgcn_mfma_f32_32x32x16_bf16(pa0, PK(l0, h0), od, 0, 0, 0);
  od = __builtin_amdgcn_mfma_f32_32x32x16_bf16(pa1, PK(l1, h1), od, 0, 0, 0);
  od = __builtin_amdgcn_mfma_f32_32x32x16_bf16(pa2, PK(l2, h2), od, 0, 0, 0);
  od = __builtin_amdgcn_mfma_f32_32x32x16_bf16(pa3, PK(l3, h3), od, 0, 0, 0);
#undef PK
}
template <int DV> __device__ __forceinline__ void pv_all(f32x16* o, int vb, bf16x8 pa0, bf16x8 pa1, bf16x8 pa2, bf16x8 pa3) {
  pv_one<0>(o[0], vb, pa0, pa1, pa2, pa3); pv_one<1>(o[1], vb, pa0, pa1, pa2, pa3);
  if constexpr (DV == 128) { pv_one<2>(o[2], vb, pa0, pa1, pa2, pa3); pv_one<3>(o[3], vb, pa0, pa1, pa2, pa3); }
}

template <int DQK, int DV, bool QNORM>
__device__ __forceinline__ void attn_unit(const bf16_t* __restrict__ Qb, int ldq, const bf16_t* __restrict__ Kh, int ldk, const bf16_t* __restrict__ Vh, int ldv,
                                          bf16_t* __restrict__ Ob, int ldo, int seq, float scale, const float* __restrict__ qgain, char* lds) {
  const int tid = threadIdx.x, wid = tid >> 6, lane = tid & 63, r32 = lane & 31, hi = lane >> 5;
  const float C = scale * 1.4426950408889634f, thr_raw = THR / scale;
  bf16_t* V_lds = (bf16_t*)lds; bf16_t* K_lds = (bf16_t*)(lds + 2 * SHM_V);
  float* ws = (float*)(lds + 2 * SHM_V + 2 * SHM_K) + wid * 64; float* li_l = ws; float* al_l = ws + 32;
  float m_reg = -1e30f, l_reg = 0; f32x16 o[DV / 32]; bf16x8 qr[DQK / 16];
#pragma unroll
  for (int d = 0; d < DV / 32; ++d) o[d] = f32x16{};
  const bf16_t* Qw = Qb + (long)(wid * QBLK + r32) * ldq + hi * 8;
#pragma unroll
  for (int d0 = 0; d0 < DQK / 16; ++d0) qr[d0] = *reinterpret_cast<const bf16x8*>(Qw + d0 * 16);
  if constexpr (QNORM) {
    float ssq = 0.f;
#pragma unroll
    for (int d0 = 0; d0 < DQK / 16; ++d0)
#pragma unroll
      for (int e = 0; e < 8; ++e) { const float v = pg8::bf2f((bf16_t)qr[d0][e]); ssq += v * v; }
    ssq += __shfl_xor(ssq, 32);
    const float rs = 1.0f / sqrtf(ssq * (1.0f / DQK) + 1e-6f);
#pragma unroll
    for (int d0 = 0; d0 < DQK / 16; ++d0) { float v[8];
#pragma unroll
      for (int e = 0; e < 8; ++e) v[e] = pg8::bf2f((bf16_t)qr[d0][e]) * rs * qgain[d0 * 16 + hi * 8 + e];
      u32x4 w = {cvtpk(v[0], v[1]), cvtpk(v[2], v[3]), cvtpk(v[4], v[5]), cvtpk(v[6], v[7])}; qr[d0] = *reinterpret_cast<bf16x8*>(&w); }
  }
  const int sr = tid >> 4, sc = (tid & 15) * 8, vst0 = v_st(sr, sc), vst1 = v_st(32 + sr, sc);
  const bool kact = sc < DQK, vact = sc < DV;
  const int vb0 = (int)(uintptr_t)V_lds + v_rd_base(lane);
  bf16x8 svs0[2], svs1[2], sks0[2], sks1[2];
#define SLOAD(i, k0) do { if (vact) { svs0[i] = *(const bf16x8*)(&Vh[(long)((k0) + sr) * ldv + sc]); svs1[i] = *(const bf16x8*)(&Vh[(long)((k0) + 32 + sr) * ldv + sc]); } \
    if (kact) { sks0[i] = *(const bf16x8*)(&Kh[(long)((k0) + sr) * ldk + sc]); sks1[i] = *(const bf16x8*)(&Kh[(long)((k0) + 32 + sr) * ldk + sc]); } } while (0)
#define SWRITE(b, i) do { if (vact) { *(bf16x8*)((char*)V_lds + (b) * SHM_V + vst0) = svs0[i]; *(bf16x8*)((char*)V_lds + (b) * SHM_V + vst1) = svs1[i]; } \
    if (kact) { const int kc = sc * 2; *(bf16x8*)((char*)K_lds + (b) * SHM_K + KSWZ(sr, kc)) = sks0[i]; *(bf16x8*)((char*)K_lds + (b) * SHM_K + KSWZ(32 + sr, kc)) = sks1[i]; } } while (0)
#define SWAIT() asm volatile("s_waitcnt vmcnt(4)" ::: "memory")
#define RESC(a) do { if (__any((a) < 1.f)) { if (hi == 0) al_l[r32] = (a); asm volatile("s_waitcnt lgkmcnt(0)" ::: "memory"); \
    _Pragma("unroll") for (int d = 0; d < DV / 32; ++d) _Pragma("unroll") for (int r = 0; r < 16; ++r) o[d][r] *= al_l[crow(r, hi)]; } } while (0)
  f32x16 pA0, pA1, pB0, pB1; float mnA, mnB, alA, alB; bf16x8 pa0, pa1, pa2, pa3; const int NT = seq / KVBLK;
  constexpr int SE = 0, SO = 1;
  SLOAD(SE, 0); asm volatile("s_waitcnt vmcnt(0)" ::: "memory"); SWRITE(0, SE); __syncthreads();
  qkt<DQK>(pA0, pA1, K_lds, qr, r32, hi); partialSM(pA0, pA1, m_reg, mnA, alA, C, thr_raw);
  SLOAD(SO, KVBLK); if (2 < NT) SLOAD(SE, 2 * KVBLK);
  SWAIT(); SWRITE(1, SO); __syncthreads();
  for (int j = 1; j + 1 < NT; j += 2) {
    SBAR(); qkt<DQK>(pB0, pB1, (bf16_t*)((char*)K_lds + SHM_K), qr, r32, hi);
    finishSM(pA0, pA1, alA, l_reg, pa0, pa1, pa2, pa3); SBAR();
    SLOAD(SO, (j + 2) * KVBLK); SBAR();
    pv_all<DV>(o, vb0, pa0, pa1, pa2, pa3); partialSM(pB0, pB1, m_reg, mnB, alB, C, thr_raw);
    __syncthreads(); SWAIT(); SWRITE(0, SE);
    RESC(alB); __syncthreads();
    SBAR(); qkt<DQK>(pA0, pA1, K_lds, qr, r32, hi);
    finishSM(pB0, pB1, alB, l_reg, pa0, pa1, pa2, pa3); SBAR();
    if (j + 3 < NT) SLOAD(SE, (j + 3) * KVBLK); SBAR();
    pv_all<DV>(o, vb0 + (int)SHM_V, pa0, pa1, pa2, pa3); partialSM(pA0, pA1, m_reg, mnA, alA, C, thr_raw);
    __syncthreads(); SWAIT(); SWRITE(1, SO);
    RESC(alA); __syncthreads();
  }
  SBAR(); qkt<DQK>(pB0, pB1, (bf16_t*)((char*)K_lds + SHM_K), qr, r32, hi);
  finishSM(pA0, pA1, alA, l_reg, pa0, pa1, pa2, pa3); SBAR();
  pv_all<DV>(o, vb0, pa0, pa1, pa2, pa3); partialSM(pB0, pB1, m_reg, mnB, alB, C, thr_raw);
  __syncthreads(); RESC(alB);
  finishSM(pB0, pB1, alB, l_reg, pa0, pa1, pa2, pa3); SBAR();
  pv_all<DV>(o, vb0 + (int)SHM_V, pa0, pa1, pa2, pa3);
  if (hi == 0) li_l[r32] = l_reg; asm volatile("s_waitcnt lgkmcnt(0)" ::: "memory");
  float rli[16];
#pragma unroll
  for (int r = 0; r < 16; ++r) rli[r] = __builtin_amdgcn_rcpf(li_l[crow(r, hi)]);
  bf16_t* Ow = Ob + (long)(wid * QBLK) * ldo;
#pragma unroll
  for (int r = 0; r < 16; ++r) { const int orow = crow(r, hi);
#pragma unroll
    for (int d0 = 0; d0 < DV / 32; ++d0) Ow[(long)orow * ldo + d0 * 32 + r32] = (bf16_t)(cvtpk(o[d0][r] * rli[r], 0.f) & 0xffffu); }
  __syncthreads();
#undef SLOAD
#undef SWRITE
#undef SWAIT
#undef RESC
}
#undef SBAR

template <int DQK, int DV, bool QNORM>
__device__ __forceinline__ void attn_unit_naive(const bf16_t* Qb, int ldq, const bf16_t* Kh, int ldk, const bf16_t* Vh, int ldv, bf16_t* Ob, int ldo, int seq, float scale, const float* qgain, char* lds) {
  const int tid = threadIdx.x; float* ql = (float*)lds;
  if (tid < 256) {
    float ssq = 0.f;
    for (int d = 0; d < DQK; ++d) { const float v = pg8::bf2f(Qb[(long)tid * ldq + d]); ssq += v * v; }
    const float rs = QNORM ? 1.0f / sqrtf(ssq * (1.0f / DQK) + 1e-6f) : 1.f;
    for (int d = 0; d < DQK; ++d) { float v = pg8::bf2f(Qb[(long)tid * ldq + d]); if (QNORM) v = pg8::bf2f((bf16_t)(cvtpk(v * rs * qgain[d], 0.f) & 0xffffu)); ql[d * 256 + tid] = v; }
    float m = -1e30f, l = 0.f; float o[DV];
#pragma unroll
    for (int d = 0; d < DV; ++d) o[d] = 0.f;
    for (int k = 0; k < seq; ++k) { float s = 0.f;
      for (int d = 0; d < DQK; ++d) s += ql[d * 256 + tid] * pg8::bf2f(Kh[(long)k * ldk + d]);
      s *= scale; const float mn = fmaxf(m, s), al = __expf(m - mn), p = __expf(s - mn); l = l * al + p; m = mn;
#pragma unroll
      for (int d = 0; d < DV; ++d) o[d] = o[d] * al + p * pg8::bf2f(Vh[(long)k * ldv + d]); }
    const float il = 1.0f / l;
#pragma unroll
    for (int d = 0; d < DV; ++d) Ob[(long)tid * ldo + d] = (bf16_t)(cvtpk(o[d] * il, 0.f) & 0xffffu);
  }
  __syncthreads();
}
}

using pg8::bf16_t; using pg8::f32x4; using pg8::u32x4; using pg8::u32x2; using pg8::bf16x8; using pg8::bf2f; using pg8::bflo; using pg8::bfhi; using pg8::cvt_pk_bf16;
#define LAS __attribute__((address_space(3)))
constexpr int NBATCH = 2, SEQ = 8192, T = NBATCH * SEQ, DM = 1024, MEMLEN = 256, TM = NBATCH * MEMLEN;
constexpr int PROJ_LD = 1536, IN_COLS = 1440, DFF = 2816, DFF2 = 5632;
constexpr int NTHR = 512, NWAVES = 8;
constexpr float EPS = 1e-6f;
constexpr size_t MiB = 1u << 20;
constexpr size_t WS_SS = 1 * MiB, WS_WIN = 2 * MiB, WS_WUQ = 5 * MiB, WS_WUKV = 5 * MiB + 512 * 1024, WS_WG = 6 * MiB, WS_WOUT = 7 * MiB, WS_WMQ = 9 * MiB, WS_WMKV = 10 * MiB,
                 WS_WMO = 12 * MiB, WS_WUP = 13 * MiB, WS_WDN = 24 * MiB, WS_MEMN = 30 * MiB, WS_MEMKV = 31 * MiB, WS_XB = 32 * MiB, WS_KN = 32 * MiB, WS_AGG = 56 * MiB,
                 WS_PROJ = 64 * MiB, WS_CQ = 112 * MiB, WS_CKV = 120 * MiB, WS_XC = 124 * MiB, WS_QRAW = 156 * MiB, WS_KVRAW = 180 * MiB, WS_QN = 112 * MiB, WS_MLA = 136 * MiB,
                 WS_AMIX = 156 * MiB, WS_QMEM = 112 * MiB, WS_OMEM = 128 * MiB, WS_GU = 64 * MiB, WS_HID = 152 * MiB, WS_END = 240 * MiB;
constexpr int LDS_BYTES = 147456, LDSCTL_OFF = 131072, MISC_OFF = LDSCTL_OFF + 320;
constexpr size_t WS_BAR = 65536, BAR_ZERO_BYTES = 16384;

struct Args { const void* in[33]; float* out; unsigned char* ws; int ph_lo, ph_hi; };

struct Ctx {
    LAS unsigned char* lds; char* ldsg;
    int tid, lane, wave, bid, G;
};
#define WSP(type, off) ((type*)(args.ws + (off)))

#define XB_TMO      128
#define XB_XCNT(j)  (256  + 64 * (j))
#define XB_XSUB(j)  (1280 + 64 * (j))
#define XB_XGEN(j)  (2304 + 64 * (j))
#define XB_TOP      3328
#define XB_TOPGEN   3392
#define XCD_BAR_WORDS 3456
#define XB_SPIN_CAP (1u << 18)

__device__ __forceinline__ unsigned xb_ld(unsigned* p)              { return __hip_atomic_load(p, __ATOMIC_RELAXED, __HIP_MEMORY_SCOPE_AGENT); }
__device__ __forceinline__ unsigned xb_add(unsigned* p, unsigned v) { return __hip_atomic_fetch_add(p, v, __ATOMIC_RELAXED, __HIP_MEMORY_SCOPE_AGENT); }
__device__ __forceinline__ unsigned xb_xcc_id() { return (unsigned)__builtin_amdgcn_s_getreg((3 << 11) | 20) & 0xFu; }
#define XB_SPIN(cond, bar) do { unsigned _sp = 0; while (cond) { __builtin_amdgcn_s_sleep(1); \
    if ((++_sp & 255u) == 0u) { if (xb_ld(&(bar)[XB_TMO])) break; if (_sp > XB_SPIN_CAP) { atomicAdd(&(bar)[XB_TMO], 1u); break; } } } } while (0)

struct XcdBarrier {
    unsigned* bar; unsigned x;
    volatile LAS unsigned* st;
};

__device__ __forceinline__ XcdBarrier xcd_barrier_post(unsigned* bar, volatile LAS unsigned* st) {
    XcdBarrier b; b.bar = bar; b.x = xb_xcc_id(); b.st = st;
    if (threadIdx.x == 0) (void)xb_add(&bar[XB_XCNT(b.x)], 1u);
    return b;
}
__device__ __forceinline__ void xcd_barrier_complete(unsigned* bar, unsigned x, unsigned& nloc, unsigned& nx) {
    const unsigned G = gridDim.x * gridDim.y * gridDim.z;
    unsigned sum, cnt, mine, sp = 0u;
    for (;;) {
        sum = 0u; cnt = 0u; mine = 0u;
#pragma unroll
        for (unsigned j = 0; j < 16; ++j) { const unsigned c = xb_ld(&bar[XB_XCNT(j)]); sum += c; cnt += (c > 0u) ? 1u : 0u; mine = (j == x) ? c : mine; }
        if (sum == G) break;
        __builtin_amdgcn_s_sleep(1);
        if ((++sp & 255u) == 0u) { if (xb_ld(&bar[XB_TMO])) break; if (sp > XB_SPIN_CAP) { atomicAdd(&bar[XB_TMO], 1u); break; } }
    }
    nloc = mine > 0u ? mine : 1u; nx = cnt > 0u ? cnt : 1u;
}

__device__ __forceinline__ void xcd_barrier(const XcdBarrier& b) {
    asm volatile("s_waitcnt vmcnt(0)" ::: "memory");
    __syncthreads();
    if (threadIdx.x == 0) {
        unsigned* bar = b.bar;
        __builtin_amdgcn_s_waitcnt(0);
        unsigned nloc = b.st[0], nx = b.st[1];
        if (nloc == 0u) { xcd_barrier_complete(bar, b.x, nloc, nx); b.st[0] = nloc; b.st[1] = nx; }
        const unsigned old = xb_add(&bar[XB_XSUB(b.x)], 1u);
        const unsigned gen = old / nloc;
        if (old + 1u == (gen + 1u) * nloc) {
            __builtin_amdgcn_fence(__ATOMIC_RELEASE, "agent");
            asm volatile("s_waitcnt vmcnt(0)" ::: "memory");
            const unsigned og = xb_add(&bar[XB_TOP], 1u);
            const unsigned tg = og / nx;
            if (og + 1u == (tg + 1u) * nx) xb_add(&bar[XB_TOPGEN], 1u);
            else XB_SPIN(xb_ld(&bar[XB_TOPGEN]) == tg, bar);
            __builtin_amdgcn_fence(__ATOMIC_ACQUIRE, "agent");
            xb_add(&bar[XB_XGEN(b.x)], 1u);
            asm volatile("s_waitcnt vmcnt(0)" ::: "memory");
        } else {
            XB_SPIN(xb_ld(&bar[XB_XGEN(b.x)]) == gen, bar);
            __builtin_amdgcn_fence(__ATOMIC_ACQUIRE, "agent");
            asm volatile("s_waitcnt vmcnt(0)" ::: "memory");
        }
    }
    __syncthreads();
}


__device__ __forceinline__ float wave_sum(float v) {
#pragma unroll
    for (int o = 1; o < 64; o <<= 1) v += __shfl_xor(v, o);
    return v;
}
__device__ __forceinline__ u32x4 pack8(const float* v) { u32x4 w; w.x = cvt_pk_bf16(v[0], v[1]); w.y = cvt_pk_bf16(v[2], v[3]); w.z = cvt_pk_bf16(v[4], v[5]); w.w = cvt_pk_bf16(v[6], v[7]); return w; }
__device__ __forceinline__ void unpack8(const u32x4 w, float* v) { v[0] = bflo(w.x); v[1] = bfhi(w.x); v[2] = bflo(w.y); v[3] = bfhi(w.y); v[4] = bflo(w.z); v[5] = bfhi(w.z); v[6] = bflo(w.w); v[7] = bfhi(w.w); }

__device__ __forceinline__ void p0_transpose_item(const float* W, const float* gain, int K, int N, bf16_t* WT, LAS float* scr, int item, int lane) {
    const int nblk = N / 32, kb = item / nblk, nb = item % nblk, k0 = 64 * kb, n0 = 32 * nb;
#pragma unroll 8
    for (int i = 0; i < 32; ++i) { const int kk = 2 * i + (lane >> 5); float v = W[(size_t)(k0 + kk) * N + n0 + (lane & 31)]; if (gain) v *= gain[k0 + kk]; scr[kk * 33 + (lane & 31)] = v; }
    asm volatile("s_waitcnt lgkmcnt(0)" ::: "memory");
    const int cch = lane & 7;
#pragma unroll
    for (int j = 0; j < 4; ++j) { const int n = (lane >> 3) + 8 * j; const LAS float* s = scr + (8 * cch) * 33 + n;
        u32x4 o; o.x = cvt_pk_bf16(s[0 * 33], s[1 * 33]); o.y = cvt_pk_bf16(s[2 * 33], s[3 * 33]); o.z = cvt_pk_bf16(s[4 * 33], s[5 * 33]); o.w = cvt_pk_bf16(s[6 * 33], s[7 * 33]);
        *(u32x4*)(WT + (size_t)(n0 + n) * K + k0 + 8 * cch) = o; }
    asm volatile("s_waitcnt lgkmcnt(0)" ::: "memory");
}
__device__ __forceinline__ void norm_row_1024(const float* xrow, const float* gain, bf16_t* orow, int lane) {
    const f32x4* xr = (const f32x4*)xrow + lane; const f32x4* gr = (const f32x4*)gain + lane;
    f32x4 v[4]; float s = 0.f;
#pragma unroll
    for (int j = 0; j < 4; ++j) { v[j] = xr[64 * j]; s += (v[j][0] * v[j][0] + v[j][1] * v[j][1]) + (v[j][2] * v[j][2] + v[j][3] * v[j][3]); }
    const float rs = 1.0f / sqrtf(wave_sum(s) * (1.0f / 1024.0f) + EPS);
#pragma unroll
    for (int j = 0; j < 4; ++j) { const f32x4 g = gr[64 * j]; u32x2 w; w.x = cvt_pk_bf16(v[j][0] * rs * g[0], v[j][1] * rs * g[1]); w.y = cvt_pk_bf16(v[j][2] * rs * g[2], v[j][3] * rs * g[3]);
        *((u32x2*)orow + lane + 64 * j) = w; }
}
__device__ __forceinline__ void phase0(Ctx& c, const Args& args) {
    LAS float* scr = (LAS float*)(c.lds + c.wave * 16384);
    const int gw = c.bid * NWAVES + c.wave, NGW = c.G * NWAVES;
    constexpr int I_IN = 16 * 45, I_UQ = 4 * 24, I_UKV = 2 * 32, I_OUT = 16 * 32, I_MQ = 16 * 16, I_MKV = 16 * 32, I_MO = 8 * 32, I_UP = 16 * 176, I_DN = 44 * 32;
    constexpr int NITEMS = I_IN + I_UQ + I_UKV + I_OUT + I_MQ + I_MKV + I_MO + I_UP + I_DN;
    for (int it = gw; it < NITEMS; it += NGW) {
        int r = it;
        if (r < I_IN) { p0_transpose_item(((const float*)args.in[4]), nullptr, 1024, IN_COLS, WSP(bf16_t, WS_WIN), scr, r, c.lane); continue; } r -= I_IN;
        if (r < I_UQ) { p0_transpose_item(((const float*)args.in[13]), nullptr, 256, 768, WSP(bf16_t, WS_WUQ), scr, r, c.lane); continue; } r -= I_UQ;
        if (r < I_UKV) { p0_transpose_item(((const float*)args.in[15]), nullptr, 128, 1024, WSP(bf16_t, WS_WUKV), scr, r, c.lane); continue; } r -= I_UKV;
        if (r < I_OUT) { p0_transpose_item(((const float*)args.in[20]), nullptr, 1024, 1024, WSP(bf16_t, WS_WOUT), scr, r, c.lane); continue; } r -= I_OUT;
        if (r < I_MQ) { p0_transpose_item(((const float*)args.in[23]), ((const float*)args.in[21]), 1024, 512, WSP(bf16_t, WS_WMQ), scr, r, c.lane); continue; } r -= I_MQ;
        if (r < I_MKV) { p0_transpose_item(((const float*)args.in[24]), nullptr, 1024, 1024, WSP(bf16_t, WS_WMKV), scr, r, c.lane); continue; } r -= I_MKV;
        if (r < I_MO) { p0_transpose_item(((const float*)args.in[27]), nullptr, 512, 1024, WSP(bf16_t, WS_WMO), scr, r, c.lane); continue; } r -= I_MO;
        if (r < I_UP) { p0_transpose_item(((const float*)args.in[29]), ((const float*)args.in[28]), 1024, DFF2, WSP(bf16_t, WS_WUP), scr, r, c.lane); continue; } r -= I_UP;
        p0_transpose_item(((const float*)args.in[32]), nullptr, DFF, 1024, WSP(bf16_t, WS_WDN), scr, r, c.lane);
    }
    const int gt = c.bid * NTHR + c.tid, NGT = c.G * NTHR;
    for (int i = gt; i < (PROJ_LD - IN_COLS) * 1024 / 8; i += NGT) *((u32x4*)(WSP(bf16_t, WS_WIN) + (size_t)IN_COLS * 1024) + i) = (u32x4){0u, 0u, 0u, 0u};
    for (int i = gt; i < 8 * 256 * 128; i += NGT) {
        const int k = i & 127, n = (i >> 7) & 255, grp = i >> 15, d = grp >> 2, png = grp & 3;
        const int gate = n >> 7, cl = n & 127, blk_n = cl >> 6, dout = cl & 63, blk_k = k >> 6, cin = k & 63;
        float v = 0.f;
        if (blk_n == blk_k) { const float* W = gate ? ((const float*)args.in[9]) : ((const float*)args.in[7]); v = W[((size_t)(d * 8 + png * 2 + blk_n) * 64 + cin) * 64 + dout]; }
        WSP(bf16_t, WS_WG)[i] = (bf16_t)(cvt_pk_bf16(v, 0.f) & 0xffffu);
    }
    for (int i = gt; i < 1024; i += NGT) WSP(float, 0)[i] = -8.0f * log1pf(expf(-((const float*)args.in[11])[i]));
    for (int m = gw; m < T + TM; m += NGW) {
        if (m < T) norm_row_1024(((const float*)args.in[0]) + (size_t)m * DM, ((const float*)args.in[3]), WSP(bf16_t, WS_XB) + (size_t)m * DM, c.lane);
        else norm_row_1024(((const float*)args.in[1]) + (size_t)(m - T) * DM, ((const float*)args.in[22]), WSP(bf16_t, WS_MEMN) + (size_t)(m - T) * DM, c.lane);
    }
}

__device__ __forceinline__ void phase2(Ctx& c, const Args& args) {
    const int gw = c.bid * NWAVES + c.wave, NGW = c.G * NWAVES, lane = c.lane;
    const bf16_t* proj = WSP(bf16_t, WS_PROJ);
    for (int row = gw; row < T + TM; row += NGW) {
        if (row >= T) {
            bf16_t* kp = WSP(bf16_t, WS_MEMKV) + (size_t)(row - T) * 1024 + lane * 8; float v[8]; unpack8(*(const u32x4*)kp, v);
            float s = 0.f;
#pragma unroll
            for (int e = 0; e < 8; ++e) s += v[e] * v[e];
            s += __shfl_xor(s, 1); s += __shfl_xor(s, 2); s += __shfl_xor(s, 4); s += __shfl_xor(s, 8);
            const float rs = 1.0f / sqrtf(s * (1.0f / 128.0f) + EPS);
#pragma unroll
            for (int e = 0; e < 8; ++e) v[e] *= rs * ((const float*)args.in[26])[(lane & 15) * 8 + e];
            *(u32x4*)kp = pack8(v);
            continue;
        }
        const bf16_t* pr = proj + (size_t)row * PROJ_LD;
        {
            const u32x2 w = *(const u32x2*)(pr + 1024 + lane * 4); float v[4] = {bflo(w.x), bfhi(w.x), bflo(w.y), bfhi(w.y)};
            const float rs = 1.0f / sqrtf(wave_sum((v[0] * v[0] + v[1] * v[1]) + (v[2] * v[2] + v[3] * v[3])) * (1.0f / 256.0f) + EPS);
            const f32x4 g = *(const f32x4*)(((const float*)args.in[12]) + lane * 4); u32x2 o; o.x = cvt_pk_bf16(v[0] * rs * g[0], v[1] * rs * g[1]); o.y = cvt_pk_bf16(v[2] * rs * g[2], v[3] * rs * g[3]);
            *(u32x2*)(WSP(bf16_t, WS_CQ) + (size_t)row * 256 + lane * 4) = o;
        }
        {
            const unsigned w = *(const unsigned*)(pr + 1280 + lane * 2); const float v0 = bflo(w), v1 = bfhi(w);
            const float rs = 1.0f / sqrtf(wave_sum(v0 * v0 + v1 * v1) * (1.0f / 128.0f) + EPS);
            *(unsigned*)(WSP(bf16_t, WS_CKV) + (size_t)row * 128 + lane * 2) = cvt_pk_bf16(v0 * rs * ((const float*)args.in[14])[lane * 2], v1 * rs * ((const float*)args.in[14])[lane * 2 + 1]);
        }
        {
            const int t = row & (SEQ - 1), ch = lane * 8;
            float xs[7][8];
#pragma unroll
            for (int dt = -3; dt <= 3; ++dt) { const int tt = t + dt;
                if (tt >= 0 && tt < SEQ) unpack8(*(const u32x4*)(pr + (long)dt * PROJ_LD + ch), xs[dt + 3]);
                else {
#pragma unroll
                    for (int e = 0; e < 8; ++e) xs[dt + 3][e] = 0.f; } }
            float of[8], ob[8];
#pragma unroll
            for (int e = 0; e < 8; ++e) { of[e] = ((const float*)args.in[6])[ch + e]; ob[e] = ((const float*)args.in[6])[512 + ch + e]; }
#pragma unroll
            for (int k = 0; k < 4; ++k)
#pragma unroll
                for (int e = 0; e < 8; ++e) { of[e] += ((const float*)args.in[5])[(0 * 4 + k) * 512 + ch + e] * xs[k][e]; ob[e] += ((const float*)args.in[5])[(1 * 4 + k) * 512 + ch + e] * xs[3 + k][e]; }
            *(u32x4*)(WSP(bf16_t, WS_XC) + (size_t)row * 512 + ch) = pack8(of);
            *(u32x4*)(WSP(bf16_t, WS_XC) + ((size_t)T + row) * 512 + ch) = pack8(ob);
        }
    }
}

__device__ __forceinline__ void phase4(Ctx& c, const Args& args) {
    const int gw = c.bid * NWAVES + c.wave, NGW = c.G * NWAVES, lane = c.lane, h = lane >> 3, sub = lane & 7;
    const bf16_t* proj = WSP(bf16_t, WS_PROJ); const bf16_t* qraw = WSP(bf16_t, WS_QRAW); const bf16_t* kvraw = WSP(bf16_t, WS_KVRAW);
    bf16_t* Qn = WSP(bf16_t, WS_QN); bf16_t* Kn = WSP(bf16_t, WS_KN);
    for (int row = gw; row < T; row += NGW) {
        const float posf = (float)((const int*)args.in[2])[row]; float cs[2], sn[2];
#pragma unroll
        for (int jj = 0; jj < 2; ++jj) { const int j = 2 * sub + jj; const float inv = exp2f(-(float)j * 0.8304820237218406f);
            const float ang = posf * inv; const double rev = (double)ang * 0.15915494309189535; const float fr = (float)(rev - rint(rev));
            cs[jj] = __builtin_amdgcn_cosf(fr); sn[jj] = __builtin_amdgcn_sinf(fr); }
#pragma unroll
        for (int which = 0; which < 2; ++which) {
            const bf16_t* np = which ? kvraw + (size_t)row * 1024 + h * 128 + sub * 8 : qraw + (size_t)row * 768 + h * 96 + sub * 8;
            const bf16_t* rp = which ? proj + (size_t)row * PROJ_LD + 1408 + 2 * sub : qraw + (size_t)row * 768 + h * 96 + 64 + 2 * sub;
            const float* gain = which ? ((const float*)args.in[17]) : ((const float*)args.in[16]);
            float v[8]; unpack8(*(const u32x4*)np, v); const unsigned r1 = *(const unsigned*)rp, r2 = *(const unsigned*)(rp + 16);
            float t1[2] = {bflo(r1), bfhi(r1)}, t2[2] = {bflo(r2), bfhi(r2)};
            float s = (t1[0] * t1[0] + t1[1] * t1[1]) + (t2[0] * t2[0] + t2[1] * t2[1]);
#pragma unroll
            for (int e = 0; e < 8; ++e) s += v[e] * v[e];
            s += __shfl_xor(s, 1); s += __shfl_xor(s, 2); s += __shfl_xor(s, 4);
            const float rs = 1.0f / sqrtf(s * (1.0f / 96.0f) + EPS);
#pragma unroll
            for (int e = 0; e < 8; ++e) v[e] *= rs * gain[sub * 8 + e];
#pragma unroll
            for (int jj = 0; jj < 2; ++jj) { t1[jj] *= rs * gain[64 + 2 * sub + jj]; t2[jj] *= rs * gain[80 + 2 * sub + jj]; }
            float o1[2], o2[2];
#pragma unroll
            for (int jj = 0; jj < 2; ++jj) { o1[jj] = t1[jj] * cs[jj] - t2[jj] * sn[jj]; o2[jj] = t1[jj] * sn[jj] + t2[jj] * cs[jj]; }
            bf16_t* op = (which ? Kn : Qn) + (size_t)row * 768 + h * 96;
            *(u32x4*)(op + sub * 8) = pack8(v);
            *(unsigned*)(op + 64 + 2 * sub) = cvt_pk_bf16(o1[0], o1[1]);
            *(unsigned*)(op + 80 + 2 * sub) = cvt_pk_bf16(o2[0], o2[1]);
        }
    }
    const unsigned* Gt = (const unsigned*)args.out; float2* agg = WSP(float2, WS_AGG);
    for (int it = c.bid; it < 512; it += c.G) {
        const int d = it >> 8, chunk = it & 255; const unsigned* gp = Gt + ((size_t)d * T + (size_t)chunk * 64) * 512 + c.tid;
        float sl = 0.f, bv = 0.f;
#pragma unroll 16
        for (int i = 0; i < 64; ++i) { const int tt = d ? 63 - i : i; const unsigned w = gp[(size_t)tt * 512]; const float la = bflo(w); sl += la; bv = __expf(la) * bv + bfhi(w); }
        agg[(size_t)it * 512 + c.tid] = make_float2(sl, bv);
    }
}

__device__ __forceinline__ float gelu_tanh(float y) { const float u = 0.7978845608028654f * (y + 0.044715f * y * y * y); const float th = 1.0f - 2.0f / (__expf(2.0f * u) + 1.0f); return 0.5f * y * (1.0f + th); }
__device__ __forceinline__ void phase6(Ctx& c, const Args& args) {
    const unsigned* Gt = (const unsigned*)args.out; const float2* agg = WSP(float2, WS_AGG); const bf16_t* proj = WSP(bf16_t, WS_PROJ);
    LAS float* hl = (LAS float*)c.lds;
    bf16_t* amix = WSP(bf16_t, WS_AMIX); const bf16_t* mla = WSP(bf16_t, WS_MLA);
    const int ch = c.tid;
    for (int chunk = c.bid; chunk < 256; chunk += c.G) {
        const int b = chunk >> 7, cc = chunk & 127;
        float cf = 0.f, cb = 0.f;
#pragma unroll 8
        for (int q = 0; q < cc; ++q) { const float2 a = agg[((size_t)b * 128 + q) * 512 + ch]; cf = __expf(a.x) * cf + a.y; }
#pragma unroll 8
        for (int q = 127; q > cc; --q) { const float2 a = agg[((size_t)256 + b * 128 + q) * 512 + ch]; cb = __expf(a.x) * cb + a.y; }
        const size_t row0 = (size_t)chunk * 64;
        { const unsigned* gp = Gt + row0 * 512 + ch; float hcur = cf;
#pragma unroll 16
          for (int i = 0; i < 64; ++i) { const unsigned w = gp[(size_t)i * 512]; hcur = __expf(bflo(w)) * hcur + bfhi(w); hl[i * 512 + ch] = hcur; } }
        { const unsigned* gp = Gt + ((size_t)T + row0) * 512 + ch; const bf16_t* yp = proj + row0 * PROJ_LD + 512 + ch; float hcur = cb;
#pragma unroll 16
          for (int i = 63; i >= 0; --i) { const unsigned w = gp[(size_t)i * 512]; hcur = __expf(bflo(w)) * hcur + bfhi(w); const float y = bf2f(yp[(size_t)i * PROJ_LD]);
              hl[i * 512 + ch] = (hl[i * 512 + ch] + hcur) * gelu_tanh(y); } }
        __syncthreads();
#pragma unroll
        for (int rr = 0; rr < 8; ++rr) { const int r = c.wave * 8 + rr; const size_t row = row0 + r;
            float v[8]; { const LAS f32x4* p = (const LAS f32x4*)(hl + r * 512 + c.lane * 8); const f32x4 a = p[0], bq = p[1]; v[0] = a[0]; v[1] = a[1]; v[2] = a[2]; v[3] = a[3]; v[4] = bq[0]; v[5] = bq[1]; v[6] = bq[2]; v[7] = bq[3]; }
            float s = 0.f;
#pragma unroll
            for (int e = 0; e < 8; ++e) s += v[e] * v[e];
            float rs = 1.0f / sqrtf(wave_sum(s) * (1.0f / 512.0f) + EPS);
#pragma unroll
            for (int e = 0; e < 8; ++e) v[e] *= rs * ((const float*)args.in[18])[c.lane * 8 + e];
            *(u32x4*)(amix + row * 1024 + c.lane * 8) = pack8(v);
            unpack8(*(const u32x4*)(mla + row * 512 + c.lane * 8), v); s = 0.f;
#pragma unroll
            for (int e = 0; e < 8; ++e) s += v[e] * v[e];
            rs = 1.0f / sqrtf(wave_sum(s) * (1.0f / 512.0f) + EPS);
#pragma unroll
            for (int e = 0; e < 8; ++e) v[e] *= rs * ((const float*)args.in[19])[c.lane * 8 + e];
            *(u32x4*)(amix + row * 1024 + 512 + c.lane * 8) = pack8(v);
        }
        __syncthreads();
    }
}

typedef float f32x2 __attribute__((ext_vector_type(2)));
__device__ __forceinline__ void unpack8v(const u32x4 w, f32x2* v) { v[0] = (f32x2){bflo(w.x), bfhi(w.x)}; v[1] = (f32x2){bflo(w.y), bfhi(w.y)}; v[2] = (f32x2){bflo(w.z), bfhi(w.z)}; v[3] = (f32x2){bflo(w.w), bfhi(w.w)}; }
__device__ __forceinline__ void phase12(Ctx& c, const Args& args, int bsel) {
    const bf16_t* __restrict__ gu = WSP(bf16_t, WS_GU); bf16_t* __restrict__ hid = WSP(bf16_t, WS_HID) + (size_t)bsel * SEQ * DFF;
    const float* __restrict__ cw = ((const float*)args.in[30]); const float* __restrict__ cb = ((const float*)args.in[31]);
    if (c.tid >= DFF / 8) return;
    const int j = c.tid * 8;
    f32x2 wg[3][4], wu[3][4], bg[4], bu[4];
#pragma unroll
    for (int e = 0; e < 4; ++e) { bg[e] = *(const f32x2*)(cb + j + 2 * e); bu[e] = *(const f32x2*)(cb + DFF + j + 2 * e);
#pragma unroll
        for (int k = 0; k < 3; ++k) { wg[k][e] = *(const f32x2*)(cw + (size_t)k * DFF2 + j + 2 * e); wu[k][e] = *(const f32x2*)(cw + (size_t)k * DFF2 + DFF + j + 2 * e); } }
    for (int chunk = c.bid; chunk < SEQ / 32; chunk += c.G) {
        const int t0 = chunk * 32;
        u32x4 rg[4], ru[4];
        const u32x4 z4 = (u32x4){0u, 0u, 0u, 0u};
#define P12_LOAD(s, k) do { const int tt_ = t0 - 1 + (s); if (tt_ >= 0 && tt_ < SEQ && (s) < 34) { rg[k] = *(const u32x4*)(gu + (size_t)tt_ * DFF2 + j); ru[k] = *(const u32x4*)(gu + (size_t)tt_ * DFF2 + DFF + j); } else { rg[k] = z4; ru[k] = z4; } } while (0)
#pragma unroll
        for (int k = 0; k < 4; ++k) P12_LOAD(k, k);
        f32x2 wing[3][4], winu[3][4];
#pragma unroll 1
        for (int s0 = 0; s0 < 36; s0 += 12) {
#pragma unroll
            for (int k = 0; k < 12; ++k) { const int s = s0 + k; constexpr int dummy = 0; (void)dummy;
                const int sn = k % 3, sq = (k + 2) % 3, sp = (k + 1) % 3;
                unpack8v(rg[k & 3], wing[sn]); unpack8v(ru[k & 3], winu[sn]);
                P12_LOAD(s + 4, k & 3);
                if (s >= 2 && s < 34) { u32x4 o; unsigned ow[4];
#pragma unroll
                    for (int e = 0; e < 4; ++e) { const f32x2 G = bg[e] + wg[0][e] * wing[sp][e] + wg[1][e] * wing[sq][e] + wg[2][e] * wing[sn][e]; const f32x2 U = bu[e] + wu[0][e] * winu[sp][e] + wu[1][e] * winu[sq][e] + wu[2][e] * winu[sn][e];
                        const f32x2 a = G * (-1.4426950408889634f); f32x2 d; d.x = __builtin_amdgcn_exp2f(a.x); d.y = __builtin_amdgcn_exp2f(a.y); d = d + 1.0f;
                        f32x2 r; r.x = __builtin_amdgcn_rcpf(d.x); r.y = __builtin_amdgcn_rcpf(d.y); const f32x2 h = G * r * U; ow[e] = cvt_pk_bf16(h.x, h.y); }
                    o.x = ow[0]; o.y = ow[1]; o.z = ow[2]; o.w = ow[3];
                    *(u32x4*)(hid + (size_t)(t0 + s - 2) * DFF + j) = o; } }
        }
#undef P12_LOAD
    }
}

template <class Epi, class Sched> __device__ __forceinline__ void run_gemm(Ctx& c, const pg8::Gemm g, const Sched& S, const Epi& E) {
#if FAST_GEMM
    pg8::gemm_phase<Epi, Sched, true, true>(c.lds, g, S, E);
#else
    pg8::gemm_naive<Epi, Sched>(g, S, E);
#endif
}
__device__ __forceinline__ pg8::Sched2 sched1(Ctx& c, const void* A, const void* B, int nM, int nN, int lda, int ldb) {
    pg8::Sched2 s; s.a = pg8::Job{(const char*)A, (const char*)B, nM, nN}; s.b = pg8::Job{nullptr, nullptr, 0, 0}; s.G = c.G; s.c = c.bid; s.lda = lda; s.ldb = ldb; return s;
}
template <int DQK, int DV, bool QNORM> __device__ __forceinline__ void run_attn(Ctx& c, const bf16_t* Qb, int ldq, const bf16_t* Kh, int ldk, const bf16_t* Vh, int ldv, bf16_t* Ob, int ldo, int seq, float scale, const float* qg) {
#if FAST_ATTN
    att::attn_unit<DQK, DV, QNORM>(Qb, ldq, Kh, ldk, Vh, ldv, Ob, ldo, seq, scale, qg, c.ldsg);
#else
    att::attn_unit_naive<DQK, DV, QNORM>(Qb, ldq, Kh, ldk, Vh, ldv, Ob, ldo, seq, scale, qg, c.ldsg);
#endif
}

__device__ __forceinline__ void ph1(Ctx& c, const Args& args) {
    pg8::Sched2 S; S.a = pg8::Job{(const char*)WSP(bf16_t, WS_XB), (const char*)WSP(bf16_t, WS_WIN), T / 256, PROJ_LD / 256};
    S.b = pg8::Job{(const char*)WSP(bf16_t, WS_MEMN), (const char*)WSP(bf16_t, WS_WMKV), TM / 256, 4}; S.G = c.G; S.c = c.bid; S.lda = 1024; S.ldb = 1024;
    pg8::EpiBf<false> E{WSP(bf16_t, WS_PROJ), PROJ_LD, WSP(bf16_t, WS_MEMKV), 1024, nullptr};
    run_gemm(c, pg8::Gemm{1024, 1024, 1024}, S, E);
}
__device__ __forceinline__ void ph3(Ctx& c, const Args& args) {
    { pg8::Sched2 S = sched1(c, WSP(bf16_t, WS_CQ), WSP(bf16_t, WS_WUQ), T / 256, 3, 256, 256); pg8::EpiBf<false> E{WSP(bf16_t, WS_QRAW), 768, nullptr, 0, nullptr}; run_gemm(c, pg8::Gemm{256, 256, 256}, S, E); }
    { pg8::Sched2 S = sched1(c, WSP(bf16_t, WS_CKV), WSP(bf16_t, WS_WUKV), T / 256, 4, 128, 128); pg8::EpiBf<false> E{WSP(bf16_t, WS_KVRAW), 1024, nullptr, 0, nullptr}; run_gemm(c, pg8::Gemm{128, 128, 128}, S, E); }
    { pg8::GateOrder S{(const char*)WSP(bf16_t, WS_XC), (const char*)WSP(bf16_t, WS_WG), (size_t)T * 512 * 2, c.G, c.bid};
      pg8::EpiGates E{WSP(bf16_t, WS_XC), ((const float*)args.in[8]), ((const float*)args.in[10]), WSP(float, 0), (unsigned*)args.out, T}; run_gemm(c, pg8::Gemm{128, 512, 128}, S, E); }
}
__device__ __forceinline__ void ph5(Ctx& c, const Args& args) {
    for (int L = c.bid; L < 512; L += c.G) { const int bh = (L >> 8) * 8 + (L & 7), qb = (L & 255) >> 3; const int b = bh >> 3, h = bh & 7;
        run_attn<96, 64, false>(c, WSP(bf16_t, WS_QN) + ((size_t)b * SEQ + qb * 256) * 768 + h * 96, 768, WSP(bf16_t, WS_KN) + (size_t)b * SEQ * 768 + h * 96, 768,
                                WSP(bf16_t, WS_KVRAW) + (size_t)b * SEQ * 1024 + h * 128 + 64, 1024, WSP(bf16_t, WS_MLA) + ((size_t)b * SEQ + qb * 256) * 512 + h * 64, 512, SEQ, 0.10206207261596575f, nullptr); }
}
__device__ __forceinline__ void ph7(Ctx& c, const Args& args) {
    pg8::Sched2 S = sched1(c, WSP(bf16_t, WS_AMIX), WSP(bf16_t, WS_WOUT), T / 256, 4, 1024, 1024); pg8::EpiResid<true> E{((const float*)args.in[0]), args.out, WSP(bf16_t, WS_XB), WSP(float, WS_SS)};
    run_gemm(c, pg8::Gemm{1024, 1024, 1024}, S, E);
}
__device__ __forceinline__ void ph8(Ctx& c, const Args& args) {
    pg8::Sched2 S = sched1(c, WSP(bf16_t, WS_XB), WSP(bf16_t, WS_WMQ), T / 256, 2, 1024, 1024); pg8::EpiBf<true> E{WSP(bf16_t, WS_QMEM), 512, nullptr, 0, WSP(float, WS_SS)};
    run_gemm(c, pg8::Gemm{1024, 1024, 1024}, S, E);
}
__device__ __forceinline__ void ph9(Ctx& c, const Args& args) {
    for (int L = c.bid; L < 256; L += c.G) { const int rb = L >> 2, h = L & 3, b = rb >> 5;
        run_attn<128, 128, true>(c, WSP(bf16_t, WS_QMEM) + (size_t)rb * 256 * 512 + h * 128, 512, WSP(bf16_t, WS_MEMKV) + (size_t)b * MEMLEN * 1024 + h * 128, 1024,
                                 WSP(bf16_t, WS_MEMKV) + (size_t)b * MEMLEN * 1024 + 512 + h * 128, 1024, WSP(bf16_t, WS_OMEM) + (size_t)rb * 256 * 512 + h * 128, 512, MEMLEN, 0.08838834764831845f, ((const float*)args.in[25])); }
}
__device__ __forceinline__ void ph10(Ctx& c, const Args& args) {
    pg8::Sched2 S = sched1(c, WSP(bf16_t, WS_OMEM), WSP(bf16_t, WS_WMO), T / 256, 4, 512, 512); pg8::EpiResid<true> E{args.out, args.out, WSP(bf16_t, WS_XB), WSP(float, WS_SS)};
    run_gemm(c, pg8::Gemm{512, 512, 512}, S, E);
}
__device__ __forceinline__ void ph11(Ctx& c, const Args& args, int bsel) {
    pg8::Sched2 S = sched1(c, WSP(bf16_t, WS_XB) + (size_t)bsel * SEQ * 1024, WSP(bf16_t, WS_WUP), SEQ / 256, DFF2 / 256, 1024, 1024);
    pg8::EpiBf<true> E{WSP(bf16_t, WS_GU), DFF2, nullptr, 0, WSP(float, WS_SS) + (size_t)bsel * SEQ * 16};
    run_gemm(c, pg8::Gemm{1024, 1024, 1024}, S, E);
}
__device__ __forceinline__ void ph15(Ctx& c, const Args& args) {
    pg8::Sched2 S = sched1(c, WSP(bf16_t, WS_HID), WSP(bf16_t, WS_WDN), T / 256, 4, DFF, DFF); pg8::EpiResid<false> E{args.out, args.out, nullptr, nullptr};
    run_gemm(c, pg8::Gemm{DFF, DFF, DFF}, S, E);
}

constexpr int N_PHASES = 16;
#ifndef PH_MASK
#define PH_MASK 0xFFFF
#endif
#ifndef DUP_MASK
#define DUP_MASK 0
#endif
#ifndef EXTRA_SYNCS
#define EXTRA_SYNCS 0
#endif
__global__ void __launch_bounds__(NTHR) fwd_kernel(Args args) {
    extern __shared__ __attribute__((aligned(16))) unsigned char lds_raw[];
    cg::grid_group grid = cg::this_grid();
    Ctx c;
    c.lds = (LAS unsigned char*)lds_raw; c.ldsg = (char*)lds_raw;
    c.tid = threadIdx.x; c.lane = c.tid & 63; c.wave = __builtin_amdgcn_readfirstlane(c.tid >> 6); c.bid = blockIdx.x; c.G = gridDim.x;
    for (int u = c.tid; u < (LDS_BYTES - LDSCTL_OFF) / 4; u += NTHR) ((LAS unsigned*)(c.lds + LDSCTL_OFF))[u] = 0u;
    __syncthreads();
    XcdBarrier bar = xcd_barrier_post((unsigned*)(args.ws + WS_BAR), (volatile LAS unsigned*)(c.lds + MISC_OFF) + 8);
    const int lo = args.ph_lo, hi = args.ph_hi;
#define IN(k) (((PH_MASK >> (k)) & 1) && lo <= (k) && (k) < hi)
#define DUPQ(k) (((DUP_MASK >> (k)) & 1) && IN(k))
#define SEAM(k) do { if (IN(k) && IN((k) + 1)) { if ((k) == 0) grid.sync(); else xcd_barrier(bar); } } while (0)
#define PH(k, call) do { if (IN(k)) { call; } if (DUPQ(k)) { grid.sync(); call; } } while (0)
    PH(0, phase0(c, args)); SEAM(0);
#pragma unroll 1
    for (int es_ = 0; es_ < EXTRA_SYNCS; ++es_) grid.sync();
    PH(1, ph1(c, args)); SEAM(1);
    PH(2, phase2(c, args)); SEAM(2);
    PH(3, ph3(c, args)); SEAM(3);
    PH(4, phase4(c, args)); SEAM(4);
    PH(5, ph5(c, args)); SEAM(5);
    PH(6, phase6(c, args)); SEAM(6);
    PH(7, ph7(c, args)); SEAM(7);
    PH(8, ph8(c, args)); SEAM(8);
    PH(9, ph9(c, args)); SEAM(9);
    PH(10, ph10(c, args)); SEAM(10);
    PH(11, ph11(c, args, 0)); SEAM(11);
    PH(12, phase12(c, args, 0)); SEAM(12);
    PH(13, ph11(c, args, 1)); SEAM(13);
    PH(14, phase12(c, args, 1)); SEAM(14);
    PH(15, ph15(c, args));
#undef IN
#undef SEAM
}

#ifndef N_LAUNCHES
#define N_LAUNCHES 1
#endif
extern "C" void kernel_launch(void* const* d_in, const int* in_sizes, int n_in, void* d_out, int out_size, void* d_ws, size_t ws_size, hipStream_t stream) {
    static int grid = 0;
    if (grid == 0) {
        if (n_in != 33 || in_sizes[0] != T * DM || out_size != T * DM || ws_size < WS_END) { fprintf(stderr, "kernel_launch: unexpected shapes (n_in %d, in0 %d, out %d, ws %zu)\n", n_in, n_in > 0 ? in_sizes[0] : -1, out_size, ws_size); grid = -1; return; }
        int dev = 0, cus = 0, per_cu = 0;
        if (hipGetDevice(&dev) != hipSuccess || hipDeviceGetAttribute(&cus, hipDeviceAttributeMultiprocessorCount, dev) != hipSuccess) { grid = -1; return; }
        if (hipFuncSetAttribute((const void*)fwd_kernel, hipFuncAttributeMaxDynamicSharedMemorySize, LDS_BYTES) != hipSuccess) { fprintf(stderr, "kernel_launch: hipFuncSetAttribute failed\n"); grid = -1; return; }
        if (hipOccupancyMaxActiveBlocksPerMultiprocessor(&per_cu, (const void*)fwd_kernel, NTHR, LDS_BYTES) != hipSuccess || per_cu < 1) { fprintf(stderr, "kernel_launch: occupancy query says %d\n", per_cu); per_cu = 1; }
        (void)hipGetLastError();
        if (per_cu > 1) per_cu = 1;
        grid = cus * per_cu;
    }
    if (grid < 0) return;
    if (hipMemsetAsync((char*)d_ws + WS_BAR, 0, BAR_ZERO_BYTES, stream) != hipSuccess) { fprintf(stderr, "kernel_launch: hipMemsetAsync failed\n"); return; }
    Args a{};
    for (int i = 0; i < 33; ++i) a.in[i] = d_in[i];
    a.out = (float*)d_out; a.ws = (unsigned char*)d_ws;
#if N_LAUNCHES == 1
    a.ph_lo = 0; a.ph_hi = N_PHASES;
    void* kargs[] = {&a};
    const hipError_t e = hipLaunchCooperativeKernel((const void*)fwd_kernel, dim3(grid), dim3(NTHR), kargs, LDS_BYTES, stream);
    if (e != hipSuccess) fprintf(stderr, "kernel_launch: cooperative launch failed: %s (grid %d)\n", hipGetErrorString(e), grid);
#else
    for (int p = 0; p < N_PHASES; ++p) { a.ph_lo = p; a.ph_hi = p + 1; hipLaunchKernelGGL(fwd_kernel, dim3(grid), dim3(NTHR), LDS_BYTES, stream, a); }
#endif
}
```

```cpp
#include <hip/hip_runtime.h>
#include <hip/hip_cooperative_groups.h>
#include <cstdio>
#include <cstdint>
namespace cg = cooperative_groups;

#ifndef FAST_GEMM
#define FAST_GEMM 1
#endif
#ifndef FAST_ATTN
#define FAST_ATTN 1
#endif

namespace pg8 {
#define PG8_LAS __attribute__((address_space(3)))
typedef unsigned short bf16_t;
typedef short bf16x8 __attribute__((ext_vector_type(8)));
typedef float f32x4 __attribute__((ext_vector_type(4)));
typedef unsigned u32x4 __attribute__((ext_vector_type(4)));
constexpr int BM = 256, BK = 64, HALF = 128, HTB = HALF * BK * 2  , STAGE_BYTES = 8 * HTB, NXCD = 8, WGM = 8;

__host__ __device__ __forceinline__ int lds_byte(int r, int c) { const int st = (r >> 4) * 2 + (c >> 5), rr = r & 15, cc = c & 31, ob = rr * 64 + cc * 2; return st * 1024 + (ob ^ (((ob >> 9) & 1) << 5)); }
__host__ __device__ __forceinline__ void stage_rc(int b, int& R, int& C) { const int st = b / 1024, sb = b % 1024, swz = sb ^ (((sb >> 9) & 1) << 5); R = (st >> 1) * 16 + swz / 64; C = (st & 1) * 32 + (swz % 64) / 2; }
__host__ __device__ __forceinline__ int perm32(int rho) { const int n = rho >> 4, i = rho & 15; return 8 * (i >> 2) + 4 * n + (i & 3); }

typedef unsigned u32x2 __attribute__((ext_vector_type(2)));
struct Unit { int pm, pn, job; const char* A; const char* B; };
struct Gemm { int K, lda, ldb; };

template <class Epi, class Sched, bool ALIGN_EPI = false, bool SP2 = false>
__device__ __forceinline__ void gemm_phase(PG8_LAS unsigned char* lds, const Gemm g, const Sched& S, const Epi& E) {
    const int tid = threadIdx.x, wid = __builtin_amdgcn_readfirstlane(tid >> 6), lane = tid & 63, wr = wid >> 2, wc = wid & 3, fr = lane & 15, fq = lane >> 4;
    int Kopq = g.K; asm volatile("" : "+s"(Kopq));
    const int K = Kopq, nt = K / BK;
    unsigned voffA[2], voffB[2];
#pragma unroll
    for (int i = 0; i < 2; ++i) { int R, C; stage_rc(tid * 16 + i * 8192, R, C); const int Rb = Epi::PERM ? ((R & ~31) + perm32(R & 31)) : R;
        voffA[i] = (unsigned)(R * g.lda + C) * 2u; voffB[i] = (unsigned)(Rb * g.ldb + C) * 2u; }
    const size_t kstep = (size_t)(BK * 2);
    const size_t hstepA = (size_t)HALF * g.lda * 2, hstepB = (size_t)HALF * g.ldb * 2;
    const unsigned ldsw = (unsigned)wid * 1024u;
    const int aoff = lds_byte(wr * 64 + fr, fq * 8), boff = lds_byte(wc * 32 + fr, fq * 8);
#define PG8_SA(b, h) (((b) * 2 + (h)) * HTB)
#define PG8_SB(b, h) ((4 + (b) * 2 + (h)) * HTB)
#define PG8_STAGE(bufoff, gbase, voff) do { _Pragma("unroll") for (int _i = 0; _i < 2; ++_i) \
        __builtin_amdgcn_global_load_lds((const unsigned*)((const char*)(gbase) + (voff)[_i]), (PG8_LAS unsigned*)(lds + (bufoff) + ldsw + _i * 8192), 16, 0, 0); } while (0)
#define PG8_LDA(dst, b, h) do { _Pragma("unroll") for (int m = 0; m < 4; ++m) _Pragma("unroll") for (int k = 0; k < 2; ++k) dst[m][k] = *(const PG8_LAS bf16x8*)(lds + PG8_SA(b, h) + aoff + m * 2048 + k * 1024); } while (0)
#define PG8_LDB(dst, b, h) do { _Pragma("unroll") for (int n = 0; n < 2; ++n) _Pragma("unroll") for (int k = 0; k < 2; ++k) dst[n][k] = *(const PG8_LAS bf16x8*)(lds + PG8_SB(b, h) + boff + n * 2048 + k * 1024); } while (0)
#define PG8_MMA(ai, bj, At, Bt) do { __builtin_amdgcn_s_setprio(1); _Pragma("unroll") for (int m = 0; m < 4; ++m) _Pragma("unroll") for (int n = 0; n < 2; ++n) _Pragma("unroll") for (int k = 0; k < 2; ++k) \
        acc[ai][bj][m][n] = __builtin_amdgcn_mfma_f32_16x16x32_bf16(Bt[n][k], At[m][k], acc[ai][bj][m][n], 0, 0, 0); __builtin_amdgcn_s_setprio(0); } while (0)
#define PG8_WAIT_V(n) asm volatile("s_waitcnt vmcnt(" #n ")" ::: "memory")
#define PG8_WAIT_L(n) asm volatile("s_waitcnt lgkmcnt(" #n ")" ::: "memory")
#define PG8_BAR __builtin_amdgcn_s_barrier()
#define PG8_SCHED __builtin_amdgcn_sched_barrier(0)
    Unit cur, nxt; int ui = 0;
    if (!S.next(0, cur)) return;
    f32x4 acc[2][2][4][2];
#pragma unroll
    for (int a = 0; a < 2; ++a)
#pragma unroll
        for (int b = 0; b < 2; ++b)
#pragma unroll
            for (int m = 0; m < 4; ++m)
#pragma unroll
                for (int n = 0; n < 2; ++n) acc[a][b][m][n] = (f32x4){0.f, 0.f, 0.f, 0.f};
    bf16x8 At[4][2], B0[2][2], B1[2][2];
    const char* cA = cur.A; const char* cB = cur.B;
    S.a_ready(cur);
    if constexpr (SP2) {
        PG8_STAGE(PG8_SB(0, 0), cB, voffB); PG8_STAGE(PG8_SB(0, 1), cB + hstepB, voffB); PG8_STAGE(PG8_SA(0, 0), cA, voffA); PG8_STAGE(PG8_SA(0, 1), cA + hstepA, voffA);
        if (wr == 1) PG8_BAR;
        PG8_WAIT_V(2); PG8_BAR;
        PG8_STAGE(PG8_SB(1, 0), cB + kstep, voffB); PG8_STAGE(PG8_SA(1, 0), cA + kstep, voffA); PG8_STAGE(PG8_SB(1, 1), cB + hstepB + kstep, voffB);
        PG8_WAIT_V(6); PG8_BAR;
    } else {
        PG8_STAGE(PG8_SB(0, 0), cB, voffB); PG8_STAGE(PG8_SA(0, 0), cA, voffA); PG8_STAGE(PG8_SB(0, 1), cB + hstepB, voffB); PG8_STAGE(PG8_SA(0, 1), cA + hstepA, voffA);
        if (wr == 1) PG8_BAR;
        PG8_WAIT_V(4); PG8_BAR;
        PG8_STAGE(PG8_SB(1, 0), cB + kstep, voffB); PG8_STAGE(PG8_SA(1, 0), cA + kstep, voffA); PG8_STAGE(PG8_SB(1, 1), cB + hstepB + kstep, voffB);
        PG8_WAIT_V(6); PG8_BAR;
    }
    for (;;) {
        const bool has_next = S.next(ui + 1, nxt);
        const char* nA = has_next ? nxt.A : cA; const char* nB = has_next ? nxt.B : cB;
        for (int t = 0; t < nt; t += 2) {
            const bool last = (t == nt - 2);
            const char* a1 = cA + (size_t)(t + 1) * kstep;
            const char* a2 = last ? nA : cA + (size_t)(t + 2) * kstep; const char* b2 = last ? nB : cB + (size_t)(t + 2) * kstep;
            const char* a3 = a2 + kstep; const char* b3 = b2 + kstep;
            if (last && has_next) S.a_ready(nxt);
            if constexpr (SP2) {
            PG8_LDB(B0, 0, 0); PG8_LDB(B1, 0, 1); PG8_SCHED; PG8_LDA(At, 0, 0); PG8_STAGE(PG8_SA(1, 1), a1 + hstepA, voffA);
            PG8_WAIT_V(8); PG8_WAIT_L(0); PG8_BAR; PG8_MMA(0, 0, At, B0); PG8_MMA(0, 1, At, B1); PG8_BAR; PG8_SCHED;
            PG8_LDA(At, 0, 1); PG8_STAGE(PG8_SB(0, 0), b2, voffB); PG8_STAGE(PG8_SB(0, 1), b2 + hstepB, voffB); PG8_STAGE(PG8_SA(0, 0), a2, voffA);
            PG8_WAIT_V(8); PG8_WAIT_L(0); PG8_BAR; PG8_MMA(1, 0, At, B0); PG8_MMA(1, 1, At, B1); PG8_BAR; PG8_SCHED;
            PG8_LDB(B0, 1, 0); PG8_LDB(B1, 1, 1); PG8_SCHED; PG8_LDA(At, 1, 0); PG8_STAGE(PG8_SA(0, 1), a2 + hstepA, voffA);
            PG8_WAIT_V(8); PG8_WAIT_L(0); PG8_BAR; PG8_MMA(0, 0, At, B0); PG8_MMA(0, 1, At, B1); PG8_BAR; PG8_SCHED;
            PG8_LDA(At, 1, 1); PG8_STAGE(PG8_SB(1, 0), b3, voffB); PG8_STAGE(PG8_SB(1, 1), b3 + hstepB, voffB); PG8_STAGE(PG8_SA(1, 0), a3, voffA);
            PG8_WAIT_V(8); PG8_WAIT_L(0); PG8_BAR; PG8_MMA(1, 0, At, B0); PG8_MMA(1, 1, At, B1); PG8_BAR; PG8_SCHED;
            } else {
            PG8_LDB(B0, 0, 0); PG8_SCHED; PG8_LDA(At, 0, 0); PG8_STAGE(PG8_SA(1, 1), a1 + hstepA, voffA);
            PG8_WAIT_L(8); PG8_BAR; PG8_WAIT_L(0); PG8_MMA(0, 0, At, B0); PG8_BAR; PG8_SCHED;
            PG8_LDB(B1, 0, 1); PG8_STAGE(PG8_SB(0, 0), b2, voffB);
            PG8_BAR; PG8_WAIT_L(0); PG8_MMA(0, 1, At, B1); PG8_BAR;
            PG8_LDA(At, 0, 1); PG8_STAGE(PG8_SA(0, 0), a2, voffA);
            PG8_BAR; PG8_WAIT_L(0); PG8_MMA(1, 0, At, B0); PG8_BAR; PG8_SCHED;
            PG8_STAGE(PG8_SB(0, 1), b2 + hstepB, voffB);
            PG8_WAIT_V(6); PG8_BAR; PG8_MMA(1, 1, At, B1); PG8_BAR;
            PG8_LDB(B0, 1, 0); PG8_SCHED; PG8_LDA(At, 1, 0); PG8_STAGE(PG8_SA(0, 1), a2 + hstepA, voffA);
            PG8_WAIT_L(8); PG8_BAR; PG8_WAIT_L(0); PG8_MMA(0, 0, At, B0); PG8_BAR; PG8_SCHED;
            PG8_LDB(B1, 1, 1); PG8_STAGE(PG8_SB(1, 0), b3, voffB);
            PG8_BAR; PG8_WAIT_L(0); PG8_MMA(0, 1, At, B1); PG8_BAR;
            PG8_LDA(At, 1, 1); PG8_STAGE(PG8_SA(1, 0), a3, voffA);
            PG8_BAR; PG8_WAIT_L(0); PG8_MMA(1, 0, At, B0); PG8_BAR; PG8_SCHED;
            PG8_STAGE(PG8_SB(1, 1), b3 + hstepB, voffB);
            PG8_WAIT_V(6); PG8_BAR; PG8_MMA(1, 1, At, B1); PG8_BAR;
            }
        }
        if constexpr (ALIGN_EPI) { if (wr == 0) PG8_BAR; }
        if constexpr (!Epi::AFTER_DRAIN) { E(acc, cur, wr, wc, fr, fq); S.done(cur); }
        if (!has_next) break;
#pragma unroll
        for (int a = 0; a < 2; ++a)
#pragma unroll
            for (int b = 0; b < 2; ++b)
#pragma unroll
                for (int m = 0; m < 4; ++m)
#pragma unroll
                    for (int n = 0; n < 2; ++n) acc[a][b][m][n] = (f32x4){0.f, 0.f, 0.f, 0.f};
        cur = nxt; cA = nA; cB = nB; ++ui;
        if constexpr (ALIGN_EPI) { if (wr == 1) PG8_BAR; }
    }
    PG8_WAIT_V(0);
    if constexpr (!ALIGN_EPI) { if (wr == 0) PG8_BAR; }
    PG8_BAR;
    if constexpr (Epi::AFTER_DRAIN) { E.fused(acc, cur, wr, wc, fr, fq, lds, wid, lane); S.done(cur); }
#undef PG8_SA
#undef PG8_SB
#undef PG8_STAGE
#undef PG8_LDA
#undef PG8_LDB
#undef PG8_MMA
#undef PG8_WAIT_V
#undef PG8_WAIT_L
#undef PG8_BAR
#undef PG8_SCHED
}

__device__ __forceinline__ float bf2f(bf16_t v) { return __uint_as_float((unsigned)v << 16); }
__device__ __forceinline__ float bflo(unsigned w) { return __uint_as_float(w << 16); }
__device__ __forceinline__ float bfhi(unsigned w) { return __uint_as_float(w & 0xffff0000u); }
__device__ __forceinline__ unsigned cvt_pk_bf16(float lo, float hi) { unsigned r; asm volatile("v_cvt_pk_bf16_f32 %0, %1, %2" : "=v"(r) : "v"(lo), "v"(hi)); return r; }

template <class Epi, class Sched>
__device__ __forceinline__ void gemm_naive(const Gemm g, const Sched& S, const Epi& E) {
    const int tid = threadIdx.x, wid = tid >> 6, lane = tid & 63, wr = wid >> 2, wc = wid & 3, fr = lane & 15, fq = lane >> 4;
    Unit u;
    for (int i = 0; S.next(i, u); ++i) {
        f32x4 acc[2][2][4][2];
#pragma unroll
        for (int ai = 0; ai < 2; ++ai)
#pragma unroll
            for (int bj = 0; bj < 2; ++bj)
#pragma unroll
                for (int m = 0; m < 4; ++m)
#pragma unroll
                    for (int n = 0; n < 2; ++n) {
                        const bf16_t* a = (const bf16_t*)u.A + (size_t)(ai * 128 + wr * 64 + m * 16 + fr) * g.lda;
                        const bf16_t* b = (const bf16_t*)u.B + (size_t)(bj * 128 + wc * 32 + n * 16 + 4 * fq) * g.ldb;
                        float s0 = 0.f, s1 = 0.f, s2 = 0.f, s3 = 0.f;
                        for (int k = 0; k < g.K; k += 8) {
                            const bf16x8 av = *(const bf16x8*)(a + k), b0 = *(const bf16x8*)(b + k), b1 = *(const bf16x8*)(b + g.ldb + k), b2 = *(const bf16x8*)(b + 2 * g.ldb + k), b3 = *(const bf16x8*)(b + 3 * g.ldb + k);
#pragma unroll
                            for (int e = 0; e < 8; ++e) { const float x = bf2f((bf16_t)av[e]); s0 += x * bf2f((bf16_t)b0[e]); s1 += x * bf2f((bf16_t)b1[e]); s2 += x * bf2f((bf16_t)b2[e]); s3 += x * bf2f((bf16_t)b3[e]); }
                        }
                        acc[ai][bj][m][n] = (f32x4){s0, s1, s2, s3};
                    }
        E(acc, u, wr, wc, fr, fq);
    }
}

struct Job { const char* A; const char* B; int nM, nN; };
struct Sched2 {
    Job a, b; int G, c, lda, ldb;
    __device__ __forceinline__ bool next(int i, Unit& u) const {
        int L = i * G + c; const int na = a.nM * a.nN, nb = b.nM * b.nN;
        if (L < na) { u.job = 0; u.pm = L % a.nM; u.pn = L / a.nM; u.A = a.A + (size_t)u.pm * 256 * lda * 2; u.B = a.B + (size_t)u.pn * 256 * ldb * 2; return true; }
        L -= na;
        if (L < nb) { u.job = 1; u.pm = L % b.nM; u.pn = L / b.nM; u.A = b.A + (size_t)u.pm * 256 * lda * 2; u.B = b.B + (size_t)u.pn * 256 * ldb * 2; return true; }
        return false;
    }
    __device__ __forceinline__ void a_ready(const Unit&) const {}
    __device__ __forceinline__ void done(const Unit&) const {}
};
struct GateOrder {
    const char* xc; const char* wg; size_t dstride; int G, c;
    __device__ __forceinline__ bool next(int i, Unit& u) const {
        const int L = i * G + c; if (L >= 512) return false;
        const int grp = L >> 6, pm = L & 63, d = grp >> 2, png = grp & 3;
        u.job = d; u.pm = pm; u.pn = png; u.A = xc + (size_t)d * dstride + ((size_t)pm * 256 * 512 + png * 128) * 2; u.B = wg + (size_t)grp * 256 * 128 * 2; return true;
    }
    __device__ __forceinline__ void a_ready(const Unit&) const {}
    __device__ __forceinline__ void done(const Unit&) const {}
};

__device__ __forceinline__ float rowscale16(const float* ss, int row) {
    const f32x4* p = (const f32x4*)(ss + (size_t)row * 16); const f32x4 a = p[0], b = p[1], c = p[2], d = p[3];
    const float s = ((a[0] + a[1]) + (a[2] + a[3])) + ((b[0] + b[1]) + (b[2] + b[3])) + ((c[0] + c[1]) + (c[2] + c[3])) + ((d[0] + d[1]) + (d[2] + d[3]));
    return 1.0f / sqrtf(s * (1.0f / 1024.0f) + 1e-6f);
}
template <bool ROWSCALE> struct EpiBf {
    static constexpr bool PERM = false, AFTER_DRAIN = false;
    bf16_t* O0; int ld0; bf16_t* O1; int ld1; const float* ss;
    __device__ __forceinline__ void operator()(const f32x4 (&acc)[2][2][4][2], const Unit& u, int wr, int wc, int fr, int fq) const {
        bf16_t* O = u.job ? O1 : O0; const int ldc = u.job ? ld1 : ld0;
        const int row0 = u.pm * 256 + wr * 64 + fr, col0 = u.pn * 256 + wc * 32 + 4 * fq;
#pragma unroll
        for (int ai = 0; ai < 2; ++ai)
#pragma unroll
            for (int m = 0; m < 4; ++m) { const int row = row0 + ai * 128 + m * 16; float rs = 1.f; if (ROWSCALE) rs = rowscale16(ss, row);
                bf16_t* rowp = O + (size_t)row * ldc + col0;
#pragma unroll
                for (int bj = 0; bj < 2; ++bj)
#pragma unroll
                    for (int n = 0; n < 2; ++n) { const f32x4 v = acc[ai][bj][m][n] * rs; u32x2 w; w.x = cvt_pk_bf16(v[0], v[1]); w.y = cvt_pk_bf16(v[2], v[3]); *(u32x2*)(rowp + bj * 128 + n * 16) = w; } }
    }
};
template <bool STATS> struct EpiResid {
    static constexpr bool PERM = false, AFTER_DRAIN = false;
    const float* base; float* out; bf16_t* xb; float* ss;
    __device__ __forceinline__ void operator()(const f32x4 (&acc)[2][2][4][2], const Unit& u, int wr, int wc, int fr, int fq) const {
        const int row0 = u.pm * 256 + wr * 64 + fr, col0 = u.pn * 256 + wc * 32 + 4 * fq;
#pragma unroll
        for (int ai = 0; ai < 2; ++ai)
#pragma unroll
            for (int m = 0; m < 4; ++m) { const int row = row0 + ai * 128 + m * 16; const size_t off = (size_t)row * 1024 + col0; float s = 0.f;
#pragma unroll
                for (int bj = 0; bj < 2; ++bj)
#pragma unroll
                    for (int n = 0; n < 2; ++n) { const size_t o2 = off + bj * 128 + n * 16; const f32x4 v = *(const f32x4*)(base + o2) + acc[ai][bj][m][n]; *(f32x4*)(out + o2) = v;
                        if (STATS) { s += (v[0] * v[0] + v[1] * v[1]) + (v[2] * v[2] + v[3] * v[3]); u32x2 w; w.x = cvt_pk_bf16(v[0], v[1]); w.y = cvt_pk_bf16(v[2], v[3]); *(u32x2*)(xb + o2) = w; } }
                if (STATS) { s += __shfl_xor(s, 16); s += __shfl_xor(s, 32); if (fq == 0) ss[(size_t)row * 16 + u.pn * 4 + wc] = s; } }
    }
};
struct EpiGates {
    static constexpr bool PERM = false, AFTER_DRAIN = false;
    const bf16_t* xc; const float* b_a; const float* b_i; const float* c8t; unsigned* G; int T;
    __device__ __forceinline__ void operator()(const f32x4 (&acc)[2][2][4][2], const Unit& u, int wr, int wc, int fr, int fq) const {
        const int d = u.job, row0 = u.pm * 256 + wr * 64 + fr, ch0 = u.pn * 128 + wc * 32 + 4 * fq;
#pragma unroll
        for (int n = 0; n < 2; ++n) { const int ch = d * 512 + ch0 + n * 16; const f32x4 ba = *(const f32x4*)(b_a + ch), bi = *(const f32x4*)(b_i + ch), c8 = *(const f32x4*)(c8t + ch);
#pragma unroll
            for (int ai = 0; ai < 2; ++ai)
#pragma unroll
                for (int m = 0; m < 4; ++m) { const int row = row0 + ai * 128 + m * 16;
                    const size_t off = ((size_t)d * T + row) * 512 + ch0 + n * 16; const u32x2 xw = *(const u32x2*)(xc + off);
                    const float xv[4] = {bflo(xw.x), bfhi(xw.x), bflo(xw.y), bfhi(xw.y)}; const f32x4 pa = acc[ai][0][m][n] + ba, pi = acc[ai][1][m][n] + bi; u32x4 o;
#pragma unroll
                    for (int e = 0; e < 4; ++e) { const float r = 1.0f / (1.0f + __expf(-pa[e])), ig = 1.0f / (1.0f + __expf(-pi[e])); const float la = r * c8[e];
                        const float x2 = 2.0f * la; const float om = (x2 > -0.02f) ? -(x2 + 0.5f * x2 * x2 + x2 * x2 * x2 * (1.0f / 6.0f)) : 1.0f - __expf(x2);
                        o[e] = cvt_pk_bf16(la, sqrtf(fmaxf(om, 0.f)) * ig * xv[e]); }
                    *(u32x4*)(G + off) = o; asm volatile("" ::: "memory"); } }
    }
};
}

namespace att {
using pg8::bf16_t;
using bf16x8 = __attribute__((ext_vector_type(8))) short;
using s16x4  = __attribute__((ext_vector_type(4))) short;
using f32x16 = __attribute__((ext_vector_type(16))) float;
using u32x4  = __attribute__((ext_vector_type(4))) unsigned;
constexpr int NW = 8, QBLK = 32, KVBLK = 64;
constexpr size_t SHM_V = KVBLK * 128 * 2, SHM_K = KVBLK * 128 * 2, SHM_ATTN = 2 * SHM_V + 2 * SHM_K + NW * 64 * 4;
constexpr float THR = 8.f;
#define KSWZ(row, colB) ((row) * 256 + ((colB) ^ (((row) & 7) << 4)))
#define SBAR() __builtin_amdgcn_sched_barrier(0)
__device__ __forceinline__ int crow(int r, int hi) { return (r & 3) + 8 * (r >> 2) + 4 * hi; }
__device__ __forceinline__ unsigned cvtpk(float lo, float hi) { unsigned r; asm volatile("v_cvt_pk_bf16_f32 %0, %1, %2" : "=v"(r) : "v"(lo), "v"(hi)); return r; }
template <bool FIXED> __device__ __forceinline__ void partialSM(f32x16& p0, f32x16& p1, float& m_reg, float& mn, float& alpha, float C, float thr_raw) {
  if constexpr (FIXED) {
    alpha = 1.f;
#pragma unroll
    for (int r = 0; r < 16; ++r) p0[r] = __builtin_amdgcn_exp2f(p0[r]);
    return; }
  float pmax = p0[0];
#pragma unroll
  for (int r = 1; r < 16; ++r) pmax = fmaxf(pmax, p0[r]);
#pragma unroll
  for (int r = 0; r < 16; ++r) pmax = fmaxf(pmax, p1[r]);
  { auto rr = __builtin_amdgcn_permlane32_swap(__float_as_uint(pmax), __float_as_uint(pmax), false, false);
    pmax = fmaxf(__uint_as_float(rr[0]), __uint_as_float(rr[1])); }
  if (__builtin_expect(__all(pmax - m_reg <= thr_raw), 1)) { mn = m_reg; alpha = 1.f; }
  else { mn = fmaxf(m_reg, pmax); alpha = __builtin_amdgcn_exp2f((m_reg - mn) * C); m_reg = mn; }
  const float mnC = -mn * C;
#pragma unroll
  for (int r = 0; r < 16; ++r) p0[r] = fmaf(p0[r], C, mnC);
#pragma unroll
  for (int r = 0; r < 16; ++r) p1[r] = fmaf(p1[r], C, mnC);
#pragma unroll
  for (int r = 0; r < 16; ++r) p0[r] = __builtin_amdgcn_exp2f(p0[r]);
}
__device__ __forceinline__ void finishSM(f32x16& p0, f32x16& p1, float alpha, float& l_reg, bf16x8& pa0, bf16x8& pa1, bf16x8& pa2, bf16x8& pa3) {
#pragma unroll
  for (int r = 0; r < 16; ++r) p1[r] = __builtin_amdgcn_exp2f(p1[r]);
  float ps = 0;
#pragma unroll
  for (int r = 0; r < 16; ++r) ps += p0[r];
#pragma unroll
  for (int r = 0; r < 16; ++r) ps += p1[r];
  { auto rr = __builtin_amdgcn_permlane32_swap(__float_as_uint(ps), __float_as_uint(ps), false, false);
    ps = __uint_as_float(rr[0]) + __uint_as_float(rr[1]); }
  l_reg = l_reg * alpha + ps;
#define PK4(P, BASE, OUT) do { unsigned a0 = cvtpk(P[BASE + 0], P[BASE + 1]), a1 = cvtpk(P[BASE + 2], P[BASE + 3]);   \
    unsigned b0 = cvtpk(P[BASE + 4], P[BASE + 5]), b1 = cvtpk(P[BASE + 6], P[BASE + 7]);                              \
    auto r0 = __builtin_amdgcn_permlane32_swap(a0, b0, false, false); auto r1 = __builtin_amdgcn_permlane32_swap(a1, b1, false, false); \
    u32x4 w = {r0[0], r1[0], r0[1], r1[1]}; OUT = *reinterpret_cast<bf16x8*>(&w); } while (0)
  PK4(p0, 0, pa0); PK4(p0, 8, pa1); PK4(p1, 0, pa2); PK4(p1, 8, pa3);
#undef PK4
}
template <int DQK> __device__ __forceinline__ void qkt(f32x16& p0, f32x16& p1, const bf16_t* Ks, const bf16x8* qr, int r32, int hi) {
  p0 = f32x16{}; p1 = f32x16{};
#pragma unroll
  for (int d0 = 0; d0 < DQK / 16; ++d0) { const int cb = (d0 * 16 + hi * 8) * 2;
    const bf16x8 b0 = *reinterpret_cast<const bf16x8*>((const char*)Ks + KSWZ(r32, cb));
    const bf16x8 b1 = *reinterpret_cast<const bf16x8*>((const char*)Ks + KSWZ(32 + r32, cb));
    p0 = __builtin_amdgcn_mfma_f32_32x32x16_bf16(b0, qr[d0], p0, 0, 0, 0);
    p1 = __builtin_amdgcn_mfma_f32_32x32x16_bf16(b1, qr[d0], p1, 0, 0, 0); }
}
__device__ __forceinline__ int v_st(int k, int c) { const int kk = (k & ~0xC) | ((k & 4) << 1) | ((k & 8) >> 1); return ((kk >> 3) * 4 + (c >> 5)) * 512 + ((kk & 7) * 32 + (c & 31)) * 2; }
__device__ __forceinline__ int v_rd_base(int lane) { return ((lane & 3) << 3) | (((lane >> 2) & 3) << 6) | (((lane >> 4) & 1) << 5) | (((lane >> 5) & 1) << 8); }
constexpr int v_rd_off(int d0, int ks, int half) { return d0 * 512 + ks * 4096 + half * 2048; }
template <int OFF> __device__ __forceinline__ s16x4 tr_read(int vb) {
  s16x4 r; asm volatile("ds_read_b64_tr_b16 %0, %1 offset:%2" : "=&v"(r) : "v"(vb), "i"(OFF) : "memory"); return r;
}
template <int D0> __device__ __forceinline__ void pv_one(f32x16& od, int vb, bf16x8 pa0, bf16x8 pa1, bf16x8 pa2, bf16x8 pa3) {
  const s16x4 l0 = tr_read<v_rd_off(D0, 0, 0)>(vb), h0 = tr_read<v_rd_off(D0, 0, 1)>(vb), l1 = tr_read<v_rd_off(D0, 1, 0)>(vb), h1 = tr_read<v_rd_off(D0, 1, 1)>(vb);
  const s16x4 l2 = tr_read<v_rd_off(D0, 2, 0)>(vb), h2 = tr_read<v_rd_off(D0, 2, 1)>(vb), l3 = tr_read<v_rd_off(D0, 3, 0)>(vb), h3 = tr_read<v_rd_off(D0, 3, 1)>(vb);
  asm volatile("s_waitcnt lgkmcnt(0)" ::: "memory"); SBAR();
#define PK(L, H) (bf16x8){L[0], L[1], L[2], L[3], H[0], H[1], H[2], H[3]}
  od = __builtin_amdgcn_mfma_f32_32x32x16_bf16(pa0, PK(l0, h0), od, 0, 0, 0);
  od = __builtin_amdgcn_mfma_f32_32x32x16_bf16(pa1, PK(l1, h1), od, 0, 0, 0);
  od = __builtin_amdgcn_mfma_f32_32x32x16_bf16(pa2, PK(l2, h2), od, 0, 0, 0);
  od = __builtin_amdgcn_mfma_f32_32x32x16_bf16(pa3, PK(l3, h3), od, 0, 0, 0);
#undef PK
}
template <int DV> __device__ __forceinline__ void pv_all(f32x16* o, int vb, bf16x8 pa0, bf16x8 pa1, bf16x8 pa2, bf16x8 pa3) {
  pv_one<0>(o[0], vb, pa0, pa1, pa2, pa3); pv_one<1>(o[1], vb, pa0, pa1, pa2, pa3);
  if constexpr (DV == 128) { pv_one<2>(o[2], vb, pa0, pa1, pa2, pa3); pv_one<3>(o[3], vb, pa0, pa1, pa2, pa3); }
}

template <int DQK, int DV, bool QNORM, bool FIXED>
__device__ __forceinline__ void attn_unit(const bf16_t* __restrict__ Qb, int ldq, const bf16_t* __restrict__ Kh, int ldk, const bf16_t* __restrict__ Vh, int ldv,
                                          bf16_t* __restrict__ Ob, int ldo, int seq, float scale, const float* __restrict__ qgain, char* lds) {
  const int tid = threadIdx.x, wid = tid >> 6, lane = tid & 63, r32 = lane & 31, hi = lane >> 5;
  const float C = 1.0f, thr_raw = THR * 1.4426950408889634f;
  bf16_t* V_lds = (bf16_t*)lds; bf16_t* K_lds = (bf16_t*)(lds + 2 * SHM_V);
  float* ws = (float*)(lds + 2 * SHM_V + 2 * SHM_K) + wid * 64; float* li_l = ws; float* al_l = ws + 32;
  float m_reg = -1e30f, l_reg = 0; f32x16 o[DV / 32]; bf16x8 qr[DQK / 16];
#pragma unroll
  for (int d = 0; d < DV / 32; ++d) o[d] = f32x16{};
  const bf16_t* Qw = Qb + (long)(wid * QBLK + r32) * ldq + hi * 8;
#pragma unroll
  for (int d0 = 0; d0 < DQK / 16; ++d0) qr[d0] = *reinterpret_cast<const bf16x8*>(Qw + d0 * 16);
  if constexpr (QNORM) {
    float ssq = 0.f;
#pragma unroll
    for (int d0 = 0; d0 < DQK / 16; ++d0)
#pragma unroll
      for (int e = 0; e < 8; ++e) { const float v = pg8::bf2f((bf16_t)qr[d0][e]); ssq += v * v; }
    ssq += __shfl_xor(ssq, 32);
    const float rs = scale * 1.4426950408889634f / sqrtf(ssq * (1.0f / DQK) + 1e-6f);
#pragma unroll
    for (int d0 = 0; d0 < DQK / 16; ++d0) { float v[8];
#pragma unroll
      for (int e = 0; e < 8; ++e) v[e] = pg8::bf2f((bf16_t)qr[d0][e]) * rs * qgain[d0 * 16 + hi * 8 + e];
      u32x4 w = {cvtpk(v[0], v[1]), cvtpk(v[2], v[3]), cvtpk(v[4], v[5]), cvtpk(v[6], v[7])}; qr[d0] = *reinterpret_cast<bf16x8*>(&w); }
  }
  const int sr = tid >> 4, sc = (tid & 15) * 8, vst0 = v_st(sr, sc), vst1 = v_st(32 + sr, sc);
  const bool kact = sc < DQK, vact = sc < DV;
  const int vb0 = (int)(uintptr_t)V_lds + v_rd_base(lane);
  bf16x8 svs0[2], svs1[2], sks0[2], sks1[2];
#define SLOAD(i, k0) do { if (vact) { svs0[i] = *(const bf16x8*)(&Vh[(long)((k0) + sr) * ldv + sc]); svs1[i] = *(const bf16x8*)(&Vh[(long)((k0) + 32 + sr) * ldv + sc]); } \
    if (kact) { sks0[i] = *(const bf16x8*)(&Kh[(long)((k0) + sr) * ldk + sc]); sks1[i] = *(const bf16x8*)(&Kh[(long)((k0) + 32 + sr) * ldk + sc]); } } while (0)
#define SWRITE(b, i) do { if (vact) { *(bf16x8*)((char*)V_lds + (b) * SHM_V + vst0) = svs0[i]; *(bf16x8*)((char*)V_lds + (b) * SHM_V + vst1) = svs1[i]; } \
    if (kact) { const int kc = sc * 2; *(bf16x8*)((char*)K_lds + (b) * SHM_K + KSWZ(sr, kc)) = sks0[i]; *(bf16x8*)((char*)K_lds + (b) * SHM_K + KSWZ(32 + sr, kc)) = sks1[i]; } } while (0)
#define SWAIT() asm volatile("s_waitcnt vmcnt(4)" ::: "memory")
#define RESC(a) do { if (!FIXED && __any((a) < 1.f)) { if (hi == 0) al_l[r32] = (a); asm volatile("s_waitcnt lgkmcnt(0)" ::: "memory"); \
    _Pragma("unroll") for (int d = 0; d < DV / 32; ++d) _Pragma("unroll") for (int r = 0; r < 16; ++r) o[d][r] *= al_l[crow(r, hi)]; } } while (0)
  f32x16 pA0, pA1, pB0, pB1; float mnA, mnB, alA, alB; bf16x8 pa0, pa1, pa2, pa3; const int NT = seq / KVBLK;
  constexpr int SE = 0, SO = 1;
  SLOAD(SE, 0); asm volatile("s_waitcnt vmcnt(0)" ::: "memory"); SWRITE(0, SE); __syncthreads();
  qkt<DQK>(pA0, pA1, K_lds, qr, r32, hi); partialSM<FIXED>(pA0, pA1, m_reg, mnA, alA, C, thr_raw);
  SLOAD(SO, KVBLK); if (2 < NT) SLOAD(SE, 2 * KVBLK);
  SWAIT(); SWRITE(1, SO); __syncthreads();
  for (int j = 1; j + 1 < NT; j += 2) {
    SBAR(); qkt<DQK>(pB0, pB1, (bf16_t*)((char*)K_lds + SHM_K), qr, r32, hi);
    finishSM(pA0, pA1, alA, l_reg, pa0, pa1, pa2, pa3); SBAR();
    SLOAD(SO, (j + 2) * KVBLK); SBAR();
    pv_all<DV>(o, vb0, pa0, pa1, pa2, pa3); partialSM<FIXED>(pB0, pB1, m_reg, mnB, alB, C, thr_raw);
    __syncthreads(); SWAIT(); SWRITE(0, SE);
    RESC(alB); __syncthreads();
    SBAR(); qkt<DQK>(pA0, pA1, K_lds, qr, r32, hi);
    finishSM(pB0, pB1, alB, l_reg, pa0, pa1, pa2, pa3); SBAR();
    if (j + 3 < NT) SLOAD(SE, (j + 3) * KVBLK); SBAR();
    pv_all<DV>(o, vb0 + (int)SHM_V, pa0, pa1, pa2, pa3); partialSM<FIXED>(pA0, pA1, m_reg, mnA, alA, C, thr_raw);
    __syncthreads(); SWAIT(); SWRITE(1, SO);
    RESC(alA); __syncthreads();
  }
  SBAR(); qkt<DQK>(pB0, pB1, (bf16_t*)((char*)K_lds + SHM_K), qr, r32, hi);
  finishSM(pA0, pA1, alA, l_reg, pa0, pa1, pa2, pa3); SBAR();
  pv_all<DV>(o, vb0, pa0, pa1, pa2, pa3); partialSM<FIXED>(pB0, pB1, m_reg, mnB, alB, C, thr_raw);
  __syncthreads(); RESC(alB);
  finishSM(pB0, pB1, alB, l_reg, pa0, pa1, pa2, pa3); SBAR();
  pv_all<DV>(o, vb0 + (int)SHM_V, pa0, pa1, pa2, pa3);
  if (hi == 0) li_l[r32] = l_reg; asm volatile("s_waitcnt lgkmcnt(0)" ::: "memory");
  float rli[16];
#pragma unroll
  for (int r = 0; r < 16; ++r) rli[r] = __builtin_amdgcn_rcpf(li_l[crow(r, hi)]);
  bf16_t* Ow = Ob + (long)(wid * QBLK) * ldo;
#pragma unroll
  for (int r = 0; r < 16; ++r) { const int orow = crow(r, hi);
#pragma unroll
    for (int d0 = 0; d0 < DV / 32; ++d0) Ow[(long)orow * ldo + d0 * 32 + r32] = (bf16_t)(cvtpk(o[d0][r] * rli[r], 0.f) & 0xffffu); }
  __syncthreads();
#undef SLOAD
#undef SWRITE
#undef SWAIT
#undef RESC
}
#undef SBAR

template <int DQK, int DV, bool QNORM>
__device__ __forceinline__ void attn_unit_naive(const bf16_t* Qb, int ldq, const bf16_t* Kh, int ldk, const bf16_t* Vh, int ldv, bf16_t* Ob, int ldo, int seq, float scale, const float* qgain, char* lds) {
  const int tid = threadIdx.x; float* ql = (float*)lds;
  if (tid < 256) {
    float ssq = 0.f;
    for (int d = 0; d < DQK; ++d) { const float v = pg8::bf2f(Qb[(long)tid * ldq + d]); ssq += v * v; }
    const float rs = QNORM ? 1.0f / sqrtf(ssq * (1.0f / DQK) + 1e-6f) : 1.f;
    for (int d = 0; d < DQK; ++d) { float v = pg8::bf2f(Qb[(long)tid * ldq + d]); if (QNORM) v = pg8::bf2f((bf16_t)(cvtpk(v * rs * qgain[d], 0.f) & 0xffffu)); ql[d * 256 + tid] = v; }
    float m = -1e30f, l = 0.f; float o[DV];
#pragma unroll
    for (int d = 0; d < DV; ++d) o[d] = 0.f;
    for (int k = 0; k < seq; ++k) { float s = 0.f;
      for (int d = 0; d < DQK; ++d) s += ql[d * 256 + tid] * pg8::bf2f(Kh[(long)k * ldk + d]);
      s *= scale; const float mn = fmaxf(m, s), al = __expf(m - mn), p = __expf(s - mn); l = l * al + p; m = mn;
#pragma unroll
      for (int d = 0; d < DV; ++d) o[d] = o[d] * al + p * pg8::bf2f(Vh[(long)k * ldv + d]); }
    const float il = 1.0f / l;
#pragma unroll
    for (int d = 0; d < DV; ++d) Ob[(long)tid * ldo + d] = (bf16_t)(cvtpk(o[d] * il, 0.f) & 0xffffu);
  }
  __syncthreads();
}
}

using pg8::bf16_t; using pg8::f32x4; using pg8::u32x4; using pg8::u32x2; using pg8::bf16x8; using pg8::bf2f; using pg8::bflo; using pg8::bfhi; using pg8::cvt_pk_bf16;
#define LAS __attribute__((address_space(3)))
constexpr int NBATCH = 2, SEQ = 8192, T = NBATCH * SEQ, DM = 1024, MEMLEN = 256, TM = NBATCH * MEMLEN;
constexpr int PROJ_LD = 1536, IN_COLS = 1440, DFF = 2816, DFF2 = 5632;
constexpr int NTHR = 512, NWAVES = 8;
constexpr float EPS = 1e-6f;
constexpr size_t MiB = 1u << 20;
constexpr size_t WS_SS = 1 * MiB, WS_WIN = 2 * MiB, WS_WUQ = 5 * MiB, WS_WUKV = 5 * MiB + 512 * 1024, WS_WG = 6 * MiB, WS_WOUT = 7 * MiB, WS_WMQ = 9 * MiB, WS_WMKV = 10 * MiB,
                 WS_WMO = 12 * MiB, WS_WUP = 13 * MiB, WS_WDN = 24 * MiB, WS_MEMN = 30 * MiB, WS_MEMKV = 31 * MiB, WS_XB = 32 * MiB, WS_KN = 32 * MiB, WS_AGG = 56 * MiB,
                 WS_PROJ = 64 * MiB, WS_CQ = 112 * MiB, WS_CKV = 120 * MiB, WS_XC = 124 * MiB, WS_QRAW = 156 * MiB, WS_KVRAW = 180 * MiB, WS_QN = 112 * MiB, WS_MLA = 136 * MiB,
                 WS_AMIX = 156 * MiB, WS_QMEM = 112 * MiB, WS_OMEM = 128 * MiB, WS_GU = 64 * MiB, WS_HID = 152 * MiB, WS_END = 240 * MiB;
constexpr int LDS_BYTES = 147456, LDSCTL_OFF = 131072, MISC_OFF = LDSCTL_OFF + 320;
constexpr size_t WS_BAR = 65536, BAR_ZERO_BYTES = 16384;

struct Args { const void* in[33]; float* out; unsigned char* ws; int ph_lo, ph_hi; };

struct Ctx {
    LAS unsigned char* lds; char* ldsg;
    int tid, lane, wave, bid, G;
};
#define WSP(type, off) ((type*)(args.ws + (off)))

#define XB_TMO      128
#define XB_XCNT(j)  (256  + 64 * (j))
#define XB_XSUB(j)  (1280 + 64 * (j))
#define XB_XGEN(j)  (2304 + 64 * (j))
#define XB_TOP      3328
#define XB_TOPGEN   3392
#define XCD_BAR_WORDS 3456
#define XB_SPIN_CAP (1u << 18)

__device__ __forceinline__ unsigned xb_ld(unsigned* p)              { return __hip_atomic_load(p, __ATOMIC_RELAXED, __HIP_MEMORY_SCOPE_AGENT); }
__device__ __forceinline__ unsigned xb_add(unsigned* p, unsigned v) { return __hip_atomic_fetch_add(p, v, __ATOMIC_RELAXED, __HIP_MEMORY_SCOPE_AGENT); }
__device__ __forceinline__ unsigned xb_xcc_id() { return (unsigned)__builtin_amdgcn_s_getreg((3 << 11) | 20) & 0xFu; }
#define XB_SPIN(cond, bar) do { unsigned _sp = 0; while (cond) { __builtin_amdgcn_s_sleep(1); \
    if ((++_sp & 255u) == 0u) { if (xb_ld(&(bar)[XB_TMO])) break; if (_sp > XB_SPIN_CAP) { atomicAdd(&(bar)[XB_TMO], 1u); break; } } } } while (0)

struct XcdBarrier {
    unsigned* bar; unsigned x;
    volatile LAS unsigned* st;
};

__device__ __forceinline__ XcdBarrier xcd_barrier_post(unsigned* bar, volatile LAS unsigned* st) {
    XcdBarrier b; b.bar = bar; b.x = xb_xcc_id(); b.st = st;
    if (threadIdx.x == 0) (void)xb_add(&bar[XB_XCNT(b.x)], 1u);
    return b;
}
__device__ __forceinline__ void xcd_barrier_complete(unsigned* bar, unsigned x, unsigned& nloc, unsigned& nx) {
    const unsigned G = gridDim.x * gridDim.y * gridDim.z;
    unsigned sum, cnt, mine, sp = 0u;
    for (;;) {
        sum = 0u; cnt = 0u; mine = 0u;
#pragma unroll
        for (unsigned j = 0; j < 16; ++j) { const unsigned c = xb_ld(&bar[XB_XCNT(j)]); sum += c; cnt += (c > 0u) ? 1u : 0u; mine = (j == x) ? c : mine; }
        if (sum == G) break;
        __builtin_amdgcn_s_sleep(1);
        if ((++sp & 255u) == 0u) { if (xb_ld(&bar[XB_TMO])) break; if (sp > XB_SPIN_CAP) { atomicAdd(&bar[XB_TMO], 1u); break; } }
    }
    nloc = mine > 0u ? mine : 1u; nx = cnt > 0u ? cnt : 1u;
}

__device__ __forceinline__ void xcd_barrier(const XcdBarrier& b) {
    asm volatile("s_waitcnt vmcnt(0)" ::: "memory");
    __syncthreads();
    if (threadIdx.x == 0) {
        unsigned* bar = b.bar;
        __builtin_amdgcn_s_waitcnt(0);
        unsigned nloc = b.st[0], nx = b.st[1];
        if (nloc == 0u) { xcd_barrier_complete(bar, b.x, nloc, nx); b.st[0] = nloc; b.st[1] = nx; }
        const unsigned old = xb_add(&bar[XB_XSUB(b.x)], 1u);
        const unsigned gen = old / nloc;
        if (old + 1u == (gen + 1u) * nloc) {
            __builtin_amdgcn_fence(__ATOMIC_RELEASE, "agent");
            asm volatile("s_waitcnt vmcnt(0)" ::: "memory");
            const unsigned og = xb_add(&bar[XB_TOP], 1u);
            const unsigned tg = og / nx;
            if (og + 1u == (tg + 1u) * nx) xb_add(&bar[XB_TOPGEN], 1u);
            else XB_SPIN(xb_ld(&bar[XB_TOPGEN]) == tg, bar);
            __builtin_amdgcn_fence(__ATOMIC_ACQUIRE, "agent");
            xb_add(&bar[XB_XGEN(b.x)], 1u);
            asm volatile("s_waitcnt vmcnt(0)" ::: "memory");
        } else {
            XB_SPIN(xb_ld(&bar[XB_XGEN(b.x)]) == gen, bar);
            __builtin_amdgcn_fence(__ATOMIC_ACQUIRE, "agent");
            asm volatile("s_waitcnt vmcnt(0)" ::: "memory");
        }
    }
    __syncthreads();
}


__device__ __forceinline__ float wave_sum(float v) {
#pragma unroll
    for (int o = 1; o < 64; o <<= 1) v += __shfl_xor(v, o);
    return v;
}
__device__ __forceinline__ u32x4 pack8(const float* v) { u32x4 w; w.x = cvt_pk_bf16(v[0], v[1]); w.y = cvt_pk_bf16(v[2], v[3]); w.z = cvt_pk_bf16(v[4], v[5]); w.w = cvt_pk_bf16(v[6], v[7]); return w; }
__device__ __forceinline__ void unpack8(const u32x4 w, float* v) { v[0] = bflo(w.x); v[1] = bfhi(w.x); v[2] = bflo(w.y); v[3] = bfhi(w.y); v[4] = bflo(w.z); v[5] = bfhi(w.z); v[6] = bflo(w.w); v[7] = bfhi(w.w); }

__device__ __forceinline__ void p0_transpose_item(const float* W, const float* gain, int K, int N, bf16_t* WT, LAS float* scr, int item, int lane) {
    const int nblk = N / 32, kb = item / nblk, nb = item % nblk, k0 = 64 * kb, n0 = 32 * nb;
#pragma unroll 8
    for (int i = 0; i < 32; ++i) { const int kk = 2 * i + (lane >> 5); float v = W[(size_t)(k0 + kk) * N + n0 + (lane & 31)]; if (gain) v *= gain[k0 + kk]; scr[kk * 33 + (lane & 31)] = v; }
    asm volatile("s_waitcnt lgkmcnt(0)" ::: "memory");
    const int cch = lane & 7;
#pragma unroll
    for (int j = 0; j < 4; ++j) { const int n = (lane >> 3) + 8 * j; const LAS float* s = scr + (8 * cch) * 33 + n;
        u32x4 o; o.x = cvt_pk_bf16(s[0 * 33], s[1 * 33]); o.y = cvt_pk_bf16(s[2 * 33], s[3 * 33]); o.z = cvt_pk_bf16(s[4 * 33], s[5 * 33]); o.w = cvt_pk_bf16(s[6 * 33], s[7 * 33]);
        *(u32x4*)(WT + (size_t)(n0 + n) * K + k0 + 8 * cch) = o; }
    asm volatile("s_waitcnt lgkmcnt(0)" ::: "memory");
}
__device__ __forceinline__ void norm_row_1024(const float* xrow, const float* gain, bf16_t* orow, int lane) {
    const f32x4* xr = (const f32x4*)xrow + lane; const f32x4* gr = (const f32x4*)gain + lane;
    f32x4 v[4]; float s = 0.f;
#pragma unroll
    for (int j = 0; j < 4; ++j) { v[j] = xr[64 * j]; s += (v[j][0] * v[j][0] + v[j][1] * v[j][1]) + (v[j][2] * v[j][2] + v[j][3] * v[j][3]); }
    const float rs = 1.0f / sqrtf(wave_sum(s) * (1.0f / 1024.0f) + EPS);
#pragma unroll
    for (int j = 0; j < 4; ++j) { const f32x4 g = gr[64 * j]; u32x2 w; w.x = cvt_pk_bf16(v[j][0] * rs * g[0], v[j][1] * rs * g[1]); w.y = cvt_pk_bf16(v[j][2] * rs * g[2], v[j][3] * rs * g[3]);
        *((u32x2*)orow + lane + 64 * j) = w; }
}
__device__ __forceinline__ void phase0(Ctx& c, const Args& args) {
    LAS float* scr = (LAS float*)(c.lds + c.wave * 16384);
    const int gw = c.bid * NWAVES + c.wave, NGW = c.G * NWAVES;
    constexpr int I_IN = 16 * 45, I_UQ = 4 * 24, I_UKV = 2 * 32, I_OUT = 16 * 32, I_MQ = 16 * 16, I_MKV = 16 * 32, I_MO = 8 * 32, I_UP = 16 * 176, I_DN = 44 * 32;
    constexpr int NITEMS = I_IN + I_UQ + I_UKV + I_OUT + I_MQ + I_MKV + I_MO + I_UP + I_DN;
    for (int it = gw; it < NITEMS; it += NGW) {
        int r = it;
        if (r < I_IN) { p0_transpose_item(((const float*)args.in[4]), nullptr, 1024, IN_COLS, WSP(bf16_t, WS_WIN), scr, r, c.lane); continue; } r -= I_IN;
        if (r < I_UQ) { p0_transpose_item(((const float*)args.in[13]), nullptr, 256, 768, WSP(bf16_t, WS_WUQ), scr, r, c.lane); continue; } r -= I_UQ;
        if (r < I_UKV) { p0_transpose_item(((const float*)args.in[15]), nullptr, 128, 1024, WSP(bf16_t, WS_WUKV), scr, r, c.lane); continue; } r -= I_UKV;
        if (r < I_OUT) { p0_transpose_item(((const float*)args.in[20]), nullptr, 1024, 1024, WSP(bf16_t, WS_WOUT), scr, r, c.lane); continue; } r -= I_OUT;
        if (r < I_MQ) { p0_transpose_item(((const float*)args.in[23]), ((const float*)args.in[21]), 1024, 512, WSP(bf16_t, WS_WMQ), scr, r, c.lane); continue; } r -= I_MQ;
        if (r < I_MKV) { p0_transpose_item(((const float*)args.in[24]), nullptr, 1024, 1024, WSP(bf16_t, WS_WMKV), scr, r, c.lane); continue; } r -= I_MKV;
        if (r < I_MO) { p0_transpose_item(((const float*)args.in[27]), nullptr, 512, 1024, WSP(bf16_t, WS_WMO), scr, r, c.lane); continue; } r -= I_MO;
        if (r < I_UP) { p0_transpose_item(((const float*)args.in[29]), ((const float*)args.in[28]), 1024, DFF2, WSP(bf16_t, WS_WUP), scr, r, c.lane); continue; } r -= I_UP;
        p0_transpose_item(((const float*)args.in[32]), nullptr, DFF, 1024, WSP(bf16_t, WS_WDN), scr, r, c.lane);
    }
    const int gt = c.bid * NTHR + c.tid, NGT = c.G * NTHR;
    for (int i = gt; i < (PROJ_LD - IN_COLS) * 1024 / 8; i += NGT) *((u32x4*)(WSP(bf16_t, WS_WIN) + (size_t)IN_COLS * 1024) + i) = (u32x4){0u, 0u, 0u, 0u};
    for (int i = gt; i < 8 * 256 * 128; i += NGT) {
        const int k = i & 127, n = (i >> 7) & 255, grp = i >> 15, d = grp >> 2, png = grp & 3;
        const int gate = n >> 7, cl = n & 127, blk_n = cl >> 6, dout = cl & 63, blk_k = k >> 6, cin = k & 63;
        float v = 0.f;
        if (blk_n == blk_k) { const float* W = gate ? ((const float*)args.in[9]) : ((const float*)args.in[7]); v = W[((size_t)(d * 8 + png * 2 + blk_n) * 64 + cin) * 64 + dout]; }
        WSP(bf16_t, WS_WG)[i] = (bf16_t)(cvt_pk_bf16(v, 0.f) & 0xffffu);
    }
    for (int i = gt; i < 1024; i += NGT) WSP(float, 0)[i] = -8.0f * log1pf(expf(-((const float*)args.in[11])[i]));
    for (int m = gw; m < T + TM; m += NGW) {
        if (m < T) norm_row_1024(((const float*)args.in[0]) + (size_t)m * DM, ((const float*)args.in[3]), WSP(bf16_t, WS_XB) + (size_t)m * DM, c.lane);
        else norm_row_1024(((const float*)args.in[1]) + (size_t)(m - T) * DM, ((const float*)args.in[22]), WSP(bf16_t, WS_MEMN) + (size_t)(m - T) * DM, c.lane);
    }
}

__device__ __forceinline__ void phase2(Ctx& c, const Args& args) {
    const int gw = c.bid * NWAVES + c.wave, NGW = c.G * NWAVES, lane = c.lane;
    const bf16_t* proj = WSP(bf16_t, WS_PROJ);
    for (int row = gw; row < T + TM; row += NGW) {
        if (row >= T) {
            bf16_t* kp = WSP(bf16_t, WS_MEMKV) + (size_t)(row - T) * 1024 + lane * 8; float v[8]; unpack8(*(const u32x4*)kp, v);
            float s = 0.f;
#pragma unroll
            for (int e = 0; e < 8; ++e) s += v[e] * v[e];
            s += __shfl_xor(s, 1); s += __shfl_xor(s, 2); s += __shfl_xor(s, 4); s += __shfl_xor(s, 8);
            const float rs = 1.0f / sqrtf(s * (1.0f / 128.0f) + EPS);
#pragma unroll
            for (int e = 0; e < 8; ++e) v[e] *= rs * ((const float*)args.in[26])[(lane & 15) * 8 + e];
            *(u32x4*)kp = pack8(v);
            continue;
        }
        const bf16_t* pr = proj + (size_t)row * PROJ_LD;
        {
            const u32x2 w = *(const u32x2*)(pr + 1024 + lane * 4); float v[4] = {bflo(w.x), bfhi(w.x), bflo(w.y), bfhi(w.y)};
            const float rs = 1.0f / sqrtf(wave_sum((v[0] * v[0] + v[1] * v[1]) + (v[2] * v[2] + v[3] * v[3])) * (1.0f / 256.0f) + EPS);
            const f32x4 g = *(const f32x4*)(((const float*)args.in[12]) + lane * 4); u32x2 o; o.x = cvt_pk_bf16(v[0] * rs * g[0], v[1] * rs * g[1]); o.y = cvt_pk_bf16(v[2] * rs * g[2], v[3] * rs * g[3]);
            *(u32x2*)(WSP(bf16_t, WS_CQ) + (size_t)row * 256 + lane * 4) = o;
        }
        {
            const unsigned w = *(const unsigned*)(pr + 1280 + lane * 2); const float v0 = bflo(w), v1 = bfhi(w);
            const float rs = 1.0f / sqrtf(wave_sum(v0 * v0 + v1 * v1) * (1.0f / 128.0f) + EPS);
            *(unsigned*)(WSP(bf16_t, WS_CKV) + (size_t)row * 128 + lane * 2) = cvt_pk_bf16(v0 * rs * ((const float*)args.in[14])[lane * 2], v1 * rs * ((const float*)args.in[14])[lane * 2 + 1]);
        }
        {
            const int t = row & (SEQ - 1), ch = lane * 8;
            float xs[7][8];
#pragma unroll
            for (int dt = -3; dt <= 3; ++dt) { const int tt = t + dt;
                if (tt >= 0 && tt < SEQ) unpack8(*(const u32x4*)(pr + (long)dt * PROJ_LD + ch), xs[dt + 3]);
                else {
#pragma unroll
                    for (int e = 0; e < 8; ++e) xs[dt + 3][e] = 0.f; } }
            float of[8], ob[8];
#pragma unroll
            for (int e = 0; e < 8; ++e) { of[e] = ((const float*)args.in[6])[ch + e]; ob[e] = ((const float*)args.in[6])[512 + ch + e]; }
#pragma unroll
            for (int k = 0; k < 4; ++k)
#pragma unroll
                for (int e = 0; e < 8; ++e) { of[e] += ((const float*)args.in[5])[(0 * 4 + k) * 512 + ch + e] * xs[k][e]; ob[e] += ((const float*)args.in[5])[(1 * 4 + k) * 512 + ch + e] * xs[3 + k][e]; }
            *(u32x4*)(WSP(bf16_t, WS_XC) + (size_t)row * 512 + ch) = pack8(of);
            *(u32x4*)(WSP(bf16_t, WS_XC) + ((size_t)T + row) * 512 + ch) = pack8(ob);
        }
    }
}

__device__ __forceinline__ void phase4(Ctx& c, const Args& args) {
    const int gw = c.bid * NWAVES + c.wave, NGW = c.G * NWAVES, lane = c.lane, h = lane >> 3, sub = lane & 7;
    const bf16_t* proj = WSP(bf16_t, WS_PROJ); const bf16_t* qraw = WSP(bf16_t, WS_QRAW); const bf16_t* kvraw = WSP(bf16_t, WS_KVRAW);
    bf16_t* Qn = WSP(bf16_t, WS_QN); bf16_t* Kn = WSP(bf16_t, WS_KN);
    for (int row = gw; row < T; row += NGW) {
        const float posf = (float)((const int*)args.in[2])[row]; float cs[2], sn[2];
#pragma unroll
        for (int jj = 0; jj < 2; ++jj) { const int j = 2 * sub + jj; const float inv = exp2f(-(float)j * 0.8304820237218406f);
            const float ang = posf * inv; const double rev = (double)ang * 0.15915494309189535; const float fr = (float)(rev - rint(rev));
            cs[jj] = __builtin_amdgcn_cosf(fr); sn[jj] = __builtin_amdgcn_sinf(fr); }
#pragma unroll
        for (int which = 0; which < 2; ++which) {
            const bf16_t* np = which ? kvraw + (size_t)row * 1024 + h * 128 + sub * 8 : qraw + (size_t)row * 768 + h * 96 + sub * 8;
            const bf16_t* rp = which ? proj + (size_t)row * PROJ_LD + 1408 + 2 * sub : qraw + (size_t)row * 768 + h * 96 + 64 + 2 * sub;
            const float* gain = which ? ((const float*)args.in[17]) : ((const float*)args.in[16]);
            float v[8]; unpack8(*(const u32x4*)np, v); const unsigned r1 = *(const unsigned*)rp, r2 = *(const unsigned*)(rp + 16);
            float t1[2] = {bflo(r1), bfhi(r1)}, t2[2] = {bflo(r2), bfhi(r2)};
            float s = (t1[0] * t1[0] + t1[1] * t1[1]) + (t2[0] * t2[0] + t2[1] * t2[1]);
#pragma unroll
            for (int e = 0; e < 8; ++e) s += v[e] * v[e];
            s += __shfl_xor(s, 1); s += __shfl_xor(s, 2); s += __shfl_xor(s, 4);
            const float rs = (which ? 1.0f : 0.14724444305f) / sqrtf(s * (1.0f / 96.0f) + EPS);
#pragma unroll
            for (int e = 0; e < 8; ++e) v[e] *= rs * gain[sub * 8 + e];
#pragma unroll
            for (int jj = 0; jj < 2; ++jj) { t1[jj] *= rs * gain[64 + 2 * sub + jj]; t2[jj] *= rs * gain[80 + 2 * sub + jj]; }
            float o1[2], o2[2];
#pragma unroll
            for (int jj = 0; jj < 2; ++jj) { o1[jj] = t1[jj] * cs[jj] - t2[jj] * sn[jj]; o2[jj] = t1[jj] * sn[jj] + t2[jj] * cs[jj]; }
            bf16_t* op = (which ? Kn : Qn) + (size_t)row * 768 + h * 96;
            *(u32x4*)(op + sub * 8) = pack8(v);
            *(unsigned*)(op + 64 + 2 * sub) = cvt_pk_bf16(o1[0], o1[1]);
            *(unsigned*)(op + 80 + 2 * sub) = cvt_pk_bf16(o2[0], o2[1]);
        }
    }
    const unsigned* Gt = (const unsigned*)args.out; float2* agg = WSP(float2, WS_AGG);
    for (int it = c.bid; it < 512; it += c.G) {
        const int d = it >> 8, chunk = it & 255; const unsigned* gp = Gt + ((size_t)d * T + (size_t)chunk * 64) * 512 + c.tid;
        float sl = 0.f, bv = 0.f;
#pragma unroll 16
        for (int i = 0; i < 64; ++i) { const int tt = d ? 63 - i : i; const unsigned w = gp[(size_t)tt * 512]; const float la = bflo(w); sl += la; bv = __expf(la) * bv + bfhi(w); }
        agg[(size_t)it * 512 + c.tid] = make_float2(sl, bv);
    }
}

__device__ __forceinline__ float gelu_tanh(float y) { const float u = 0.7978845608028654f * (y + 0.044715f * y * y * y); const float th = 1.0f - 2.0f / (__expf(2.0f * u) + 1.0f); return 0.5f * y * (1.0f + th); }
__device__ __forceinline__ void phase6(Ctx& c, const Args& args) {
    const unsigned* Gt = (const unsigned*)args.out; const float2* agg = WSP(float2, WS_AGG); const bf16_t* proj = WSP(bf16_t, WS_PROJ);
    LAS float* hl = (LAS float*)c.lds;
    bf16_t* amix = WSP(bf16_t, WS_AMIX); const bf16_t* mla = WSP(bf16_t, WS_MLA);
    const int ch = c.tid;
    for (int chunk = c.bid; chunk < 256; chunk += c.G) {
        const int b = chunk >> 7, cc = chunk & 127;
        float cf = 0.f, cb = 0.f;
#pragma unroll 8
        for (int q = 0; q < cc; ++q) { const float2 a = agg[((size_t)b * 128 + q) * 512 + ch]; cf = __expf(a.x) * cf + a.y; }
#pragma unroll 8
        for (int q = 127; q > cc; --q) { const float2 a = agg[((size_t)256 + b * 128 + q) * 512 + ch]; cb = __expf(a.x) * cb + a.y; }
        const size_t row0 = (size_t)chunk * 64;
        { const unsigned* gp = Gt + row0 * 512 + ch; float hcur = cf;
#pragma unroll 16
          for (int i = 0; i < 64; ++i) { const unsigned w = gp[(size_t)i * 512]; hcur = __expf(bflo(w)) * hcur + bfhi(w); hl[i * 512 + ch] = hcur; } }
        { const unsigned* gp = Gt + ((size_t)T + row0) * 512 + ch; const bf16_t* yp = proj + row0 * PROJ_LD + 512 + ch; float hcur = cb;
#pragma unroll 16
          for (int i = 63; i >= 0; --i) { const unsigned w = gp[(size_t)i * 512]; hcur = __expf(bflo(w)) * hcur + bfhi(w); const float y = bf2f(yp[(size_t)i * PROJ_LD]);
              hl[i * 512 + ch] = (hl[i * 512 + ch] + hcur) * gelu_tanh(y); } }
        __syncthreads();
#pragma unroll
        for (int rr = 0; rr < 8; ++rr) { const int r = c.wave * 8 + rr; const size_t row = row0 + r;
            float v[8]; { const LAS f32x4* p = (const LAS f32x4*)(hl + r * 512 + c.lane * 8); const f32x4 a = p[0], bq = p[1]; v[0] = a[0]; v[1] = a[1]; v[2] = a[2]; v[3] = a[3]; v[4] = bq[0]; v[5] = bq[1]; v[6] = bq[2]; v[7] = bq[3]; }
            float s = 0.f;
#pragma unroll
            for (int e = 0; e < 8; ++e) s += v[e] * v[e];
            float rs = 1.0f / sqrtf(wave_sum(s) * (1.0f / 512.0f) + EPS);
#pragma unroll
            for (int e = 0; e < 8; ++e) v[e] *= rs * ((const float*)args.in[18])[c.lane * 8 + e];
            *(u32x4*)(amix + row * 1024 + c.lane * 8) = pack8(v);
            unpack8(*(const u32x4*)(mla + row * 512 + c.lane * 8), v); s = 0.f;
#pragma unroll
            for (int e = 0; e < 8; ++e) s += v[e] * v[e];
            rs = 1.0f / sqrtf(wave_sum(s) * (1.0f / 512.0f) + EPS);
#pragma unroll
            for (int e = 0; e < 8; ++e) v[e] *= rs * ((const float*)args.in[19])[c.lane * 8 + e];
            *(u32x4*)(amix + row * 1024 + 512 + c.lane * 8) = pack8(v);
        }
        __syncthreads();
    }
}

typedef float f32x2 __attribute__((ext_vector_type(2)));
__device__ __forceinline__ void unpack8v(const u32x4 w, f32x2* v) { v[0] = (f32x2){bflo(w.x), bfhi(w.x)}; v[1] = (f32x2){bflo(w.y), bfhi(w.y)}; v[2] = (f32x2){bflo(w.z), bfhi(w.z)}; v[3] = (f32x2){bflo(w.w), bfhi(w.w)}; }
__device__ __forceinline__ void phase12(Ctx& c, const Args& args, int bsel) {
    const bf16_t* __restrict__ gu = WSP(bf16_t, WS_GU); bf16_t* __restrict__ hid = WSP(bf16_t, WS_HID) + (size_t)bsel * SEQ * DFF;
    const float* __restrict__ cw = ((const float*)args.in[30]); const float* __restrict__ cb = ((const float*)args.in[31]);
    if (c.tid >= DFF / 8) return;
    const int j = c.tid * 8;
    f32x2 wg[3][4], wu[3][4], bg[4], bu[4];
#pragma unroll
    for (int e = 0; e < 4; ++e) { bg[e] = *(const f32x2*)(cb + j + 2 * e); bu[e] = *(const f32x2*)(cb + DFF + j + 2 * e);
#pragma unroll
        for (int k = 0; k < 3; ++k) { wg[k][e] = *(const f32x2*)(cw + (size_t)k * DFF2 + j + 2 * e); wu[k][e] = *(const f32x2*)(cw + (size_t)k * DFF2 + DFF + j + 2 * e); } }
    for (int chunk = c.bid; chunk < SEQ / 32; chunk += c.G) {
        const int t0 = chunk * 32;
        u32x4 rg[4], ru[4];
        const u32x4 z4 = (u32x4){0u, 0u, 0u, 0u};
#define P12_LOAD(s, k) do { const int tt_ = t0 - 1 + (s); if (tt_ >= 0 && tt_ < SEQ && (s) < 34) { rg[k] = *(const u32x4*)(gu + (size_t)tt_ * DFF2 + j); ru[k] = *(const u32x4*)(gu + (size_t)tt_ * DFF2 + DFF + j); } else { rg[k] = z4; ru[k] = z4; } } while (0)
#pragma unroll
        for (int k = 0; k < 4; ++k) P12_LOAD(k, k);
        f32x2 wing[3][4], winu[3][4];
#pragma unroll 1
        for (int s0 = 0; s0 < 36; s0 += 12) {
#pragma unroll
            for (int k = 0; k < 12; ++k) { const int s = s0 + k; constexpr int dummy = 0; (void)dummy;
                const int sn = k % 3, sq = (k + 2) % 3, sp = (k + 1) % 3;
                unpack8v(rg[k & 3], wing[sn]); unpack8v(ru[k & 3], winu[sn]);
                P12_LOAD(s + 4, k & 3);
                if (s >= 2 && s < 34) { u32x4 o; unsigned ow[4];
#pragma unroll
                    for (int e = 0; e < 4; ++e) { const f32x2 G = bg[e] + wg[0][e] * wing[sp][e] + wg[1][e] * wing[sq][e] + wg[2][e] * wing[sn][e]; const f32x2 U = bu[e] + wu[0][e] * winu[sp][e] + wu[1][e] * winu[sq][e] + wu[2][e] * winu[sn][e];
                        const f32x2 a = G * (-1.4426950408889634f); f32x2 d; d.x = __builtin_amdgcn_exp2f(a.x); d.y = __builtin_amdgcn_exp2f(a.y); d = d + 1.0f;
                        f32x2 r; r.x = __builtin_amdgcn_rcpf(d.x); r.y = __builtin_amdgcn_rcpf(d.y); const f32x2 h = G * r * U; ow[e] = cvt_pk_bf16(h.x, h.y); }
                    o.x = ow[0]; o.y = ow[1]; o.z = ow[2]; o.w = ow[3];
                    *(u32x4*)(hid + (size_t)(t0 + s - 2) * DFF + j) = o; } }
        }
#undef P12_LOAD
    }
}

template <class Epi, class Sched> __device__ __forceinline__ void run_gemm(Ctx& c, const pg8::Gemm g, const Sched& S, const Epi& E) {
#if FAST_GEMM
    pg8::gemm_phase<Epi, Sched, true, true>(c.lds, g, S, E);
#else
    pg8::gemm_naive<Epi, Sched>(g, S, E);
#endif
}
__device__ __forceinline__ pg8::Sched2 sched1(Ctx& c, const void* A, const void* B, int nM, int nN, int lda, int ldb) {
    pg8::Sched2 s; s.a = pg8::Job{(const char*)A, (const char*)B, nM, nN}; s.b = pg8::Job{nullptr, nullptr, 0, 0}; s.G = c.G; s.c = c.bid; s.lda = lda; s.ldb = ldb; return s;
}
template <int DQK, int DV, bool QNORM, bool FIXED> __device__ __forceinline__ void run_attn(Ctx& c, const bf16_t* Qb, int ldq, const bf16_t* Kh, int ldk, const bf16_t* Vh, int ldv, bf16_t* Ob, int ldo, int seq, float scale, const float* qg) {
#if FAST_ATTN
    att::attn_unit<DQK, DV, QNORM, FIXED>(Qb, ldq, Kh, ldk, Vh, ldv, Ob, ldo, seq, scale, qg, c.ldsg);
#else
    att::attn_unit_naive<DQK, DV, QNORM>(Qb, ldq, Kh, ldk, Vh, ldv, Ob, ldo, seq, scale, qg, c.ldsg);
#endif
}

__device__ __forceinline__ void ph1(Ctx& c, const Args& args) {
    pg8::Sched2 S; S.a = pg8::Job{(const char*)WSP(bf16_t, WS_XB), (const char*)WSP(bf16_t, WS_WIN), T / 256, PROJ_LD / 256};
    S.b = pg8::Job{(const char*)WSP(bf16_t, WS_MEMN), (const char*)WSP(bf16_t, WS_WMKV), TM / 256, 4}; S.G = c.G; S.c = c.bid; S.lda = 1024; S.ldb = 1024;
    pg8::EpiBf<false> E{WSP(bf16_t, WS_PROJ), PROJ_LD, WSP(bf16_t, WS_MEMKV), 1024, nullptr};
    run_gemm(c, pg8::Gemm{1024, 1024, 1024}, S, E);
}
__device__ __forceinline__ void ph3(Ctx& c, const Args& args) {
    { pg8::Sched2 S = sched1(c, WSP(bf16_t, WS_CQ), WSP(bf16_t, WS_WUQ), T / 256, 3, 256, 256); pg8::EpiBf<false> E{WSP(bf16_t, WS_QRAW), 768, nullptr, 0, nullptr}; run_gemm(c, pg8::Gemm{256, 256, 256}, S, E); }
    { pg8::Sched2 S = sched1(c, WSP(bf16_t, WS_CKV), WSP(bf16_t, WS_WUKV), T / 256, 4, 128, 128); pg8::EpiBf<false> E{WSP(bf16_t, WS_KVRAW), 1024, nullptr, 0, nullptr}; run_gemm(c, pg8::Gemm{128, 128, 128}, S, E); }
    { pg8::GateOrder S{(const char*)WSP(bf16_t, WS_XC), (const char*)WSP(bf16_t, WS_WG), (size_t)T * 512 * 2, c.G, c.bid};
      pg8::EpiGates E{WSP(bf16_t, WS_XC), ((const float*)args.in[8]), ((const float*)args.in[10]), WSP(float, 0), (unsigned*)args.out, T}; run_gemm(c, pg8::Gemm{128, 512, 128}, S, E); }
}
__device__ __forceinline__ void ph5(Ctx& c, const Args& args) {
    float gq = 0.f, gk = 0.f;
    for (int i = c.lane; i < 96; i += 64) { gq = fmaxf(gq, fabsf(((const float*)args.in[16])[i])); gk = fmaxf(gk, fabsf(((const float*)args.in[17])[i])); }
#pragma unroll
    for (int o = 1; o < 64; o <<= 1) { gq = fmaxf(gq, __shfl_xor(gq, o)); gk = fmaxf(gk, __shfl_xor(gk, o)); }
    const bool bounded = __builtin_amdgcn_readfirstlane((int)(9.797958971f * 1.02f * gq * gk * 1.4426950408889634f <= 60.0f)) != 0;
    for (int L = c.bid; L < 512; L += c.G) { const int bh = (L >> 8) * 8 + (L & 7), qb = (L & 255) >> 3; const int b = bh >> 3, h = bh & 7;
        const bf16_t* Qp = WSP(bf16_t, WS_QN) + ((size_t)b * SEQ + qb * 256) * 768 + h * 96; const bf16_t* Kp = WSP(bf16_t, WS_KN) + (size_t)b * SEQ * 768 + h * 96;
        const bf16_t* Vp = WSP(bf16_t, WS_KVRAW) + (size_t)b * SEQ * 1024 + h * 128 + 64; bf16_t* Op = WSP(bf16_t, WS_MLA) + ((size_t)b * SEQ + qb * 256) * 512 + h * 64;
        if (bounded) run_attn<96, 64, false, true>(c, Qp, 768, Kp, 768, Vp, 1024, Op, 512, SEQ, 0.10206207261596575f, nullptr);
        else run_attn<96, 64, false, false>(c, Qp, 768, Kp, 768, Vp, 1024, Op, 512, SEQ, 0.10206207261596575f, nullptr); }
}
__device__ __forceinline__ void ph7(Ctx& c, const Args& args) {
    pg8::Sched2 S = sched1(c, WSP(bf16_t, WS_AMIX), WSP(bf16_t, WS_WOUT), T / 256, 4, 1024, 1024); pg8::EpiResid<true> E{((const float*)args.in[0]), args.out, WSP(bf16_t, WS_XB), WSP(float, WS_SS)};
    run_gemm(c, pg8::Gemm{1024, 1024, 1024}, S, E);
}
__device__ __forceinline__ void ph8(Ctx& c, const Args& args) {
    pg8::Sched2 S = sched1(c, WSP(bf16_t, WS_XB), WSP(bf16_t, WS_WMQ), T / 256, 2, 1024, 1024); pg8::EpiBf<true> E{WSP(bf16_t, WS_QMEM), 512, nullptr, 0, WSP(float, WS_SS)};
    run_gemm(c, pg8::Gemm{1024, 1024, 1024}, S, E);
}
__device__ __forceinline__ void ph9(Ctx& c, const Args& args) {
    for (int L = c.bid; L < 256; L += c.G) { const int rb = L >> 2, h = L & 3, b = rb >> 5;
        run_attn<128, 128, true, false>(c, WSP(bf16_t, WS_QMEM) + (size_t)rb * 256 * 512 + h * 128, 512, WSP(bf16_t, WS_MEMKV) + (size_t)b * MEMLEN * 1024 + h * 128, 1024,
                                 WSP(bf16_t, WS_MEMKV) + (size_t)b * MEMLEN * 1024 + 512 + h * 128, 1024, WSP(bf16_t, WS_OMEM) + (size_t)rb * 256 * 512 + h * 128, 512, MEMLEN, 0.08838834764831845f, ((const float*)args.in[25])); }
}
__device__ __forceinline__ void ph10(Ctx& c, const Args& args) {
    pg8::Sched2 S = sched1(c, WSP(bf16_t, WS_OMEM), WSP(bf16_t, WS_WMO), T / 256, 4, 512, 512); pg8::EpiResid<true> E{args.out, args.out, WSP(bf16_t, WS_XB), WSP(float, WS_SS)};
    run_gemm(c, pg8::Gemm{512, 512, 512}, S, E);
}
__device__ __forceinline__ void ph11(Ctx& c, const Args& args, int bsel) {
    pg8::Sched2 S = sched1(c, WSP(bf16_t, WS_XB) + (size_t)bsel * SEQ * 1024, WSP(bf16_t, WS_WUP), SEQ / 256, DFF2 / 256, 1024, 1024);
    pg8::EpiBf<true> E{WSP(bf16_t, WS_GU), DFF2, nullptr, 0, WSP(float, WS_SS) + (size_t)bsel * SEQ * 16};
    run_gemm(c, pg8::Gemm{1024, 1024, 1024}, S, E);
}
__device__ __forceinline__ void ph15(Ctx& c, const Args& args) {
    pg8::Sched2 S = sched1(c, WSP(bf16_t, WS_HID), WSP(bf16_t, WS_WDN), T / 256, 4, DFF, DFF); pg8::EpiResid<false> E{args.out, args.out, nullptr, nullptr};
    run_gemm(c, pg8::Gemm{DFF, DFF, DFF}, S, E);
}

constexpr int N_PHASES = 16;
#ifndef PH_MASK
#define PH_MASK 0xFFFF
#endif
#ifndef DUP_MASK
#define DUP_MASK 0
#endif
#ifndef EXTRA_SYNCS
#define EXTRA_SYNCS 0
#endif
__global__ void __launch_bounds__(NTHR) fwd_kernel(Args args) {
    extern __shared__ __attribute__((aligned(16))) unsigned char lds_raw[];
    cg::grid_group grid = cg::this_grid();
    Ctx c;
    c.lds = (LAS unsigned char*)lds_raw; c.ldsg = (char*)lds_raw;
    c.tid = threadIdx.x; c.lane = c.tid & 63; c.wave = __builtin_amdgcn_readfirstlane(c.tid >> 6); c.bid = blockIdx.x; c.G = gridDim.x;
    for (int u = c.tid; u < (LDS_BYTES - LDSCTL_OFF) / 4; u += NTHR) ((LAS unsigned*)(c.lds + LDSCTL_OFF))[u] = 0u;
    __syncthreads();
    XcdBarrier bar = xcd_barrier_post((unsigned*)(args.ws + WS_BAR), (volatile LAS unsigned*)(c.lds + MISC_OFF) + 8);
    const int lo = args.ph_lo, hi = args.ph_hi;
#define IN(k) (((PH_MASK >> (k)) & 1) && lo <= (k) && (k) < hi)
#define DUPQ(k) (((DUP_MASK >> (k)) & 1) && IN(k))
#define SEAM(k) do { if (IN(k) && IN((k) + 1)) { if ((k) == 0) grid.sync(); else xcd_barrier(bar); } } while (0)
#define PH(k, call) do { if (IN(k)) { call; } if (DUPQ(k)) { grid.sync(); call; } } while (0)
    PH(0, phase0(c, args)); SEAM(0);
#pragma unroll 1
    for (int es_ = 0; es_ < EXTRA_SYNCS; ++es_) grid.sync();
    PH(1, ph1(c, args)); SEAM(1);
    PH(2, phase2(c, args)); SEAM(2);
    PH(3, ph3(c, args)); SEAM(3);
    PH(4, phase4(c, args)); SEAM(4);
    PH(5, ph5(c, args)); SEAM(5);
    PH(6, phase6(c, args)); SEAM(6);
    PH(7, ph7(c, args)); SEAM(7);
    PH(8, ph8(c, args)); SEAM(8);
    PH(9, ph9(c, args)); SEAM(9);
    PH(10, ph10(c, args)); SEAM(10);
    PH(11, ph11(c, args, 0)); SEAM(11);
    PH(12, phase12(c, args, 0)); SEAM(12);
    PH(13, ph11(c, args, 1)); SEAM(13);
    PH(14, phase12(c, args, 1)); SEAM(14);
    PH(15, ph15(c, args));
#undef IN
#undef SEAM
}

#ifndef N_LAUNCHES
#define N_LAUNCHES 1
#endif
extern "C" void kernel_launch(void* const* d_in, const int* in_sizes, int n_in, void* d_out, int out_size, void* d_ws, size_t ws_size, hipStream_t stream) {
    static int grid = 0;
    if (grid == 0) {
        if (n_in != 33 || in_sizes[0] != T * DM || out_size != T * DM || ws_size < WS_END) { fprintf(stderr, "kernel_launch: unexpected shapes (n_in %d, in0 %d, out %d, ws %zu)\n", n_in, n_in > 0 ? in_sizes[0] : -1, out_size, ws_size); grid = -1; return; }
        int dev = 0, cus = 0, per_cu = 0;
        if (hipGetDevice(&dev) != hipSuccess || hipDeviceGetAttribute(&cus, hipDeviceAttributeMultiprocessorCount, dev) != hipSuccess) { grid = -1; return; }
        if (hipFuncSetAttribute((const void*)fwd_kernel, hipFuncAttributeMaxDynamicSharedMemorySize, LDS_BYTES) != hipSuccess) { fprintf(stderr, "kernel_launch: hipFuncSetAttribute failed\n"); grid = -1; return; }
        if (hipOccupancyMaxActiveBlocksPerMultiprocessor(&per_cu, (const void*)fwd_kernel, NTHR, LDS_BYTES) != hipSuccess || per_cu < 1) { fprintf(stderr, "kernel_launch: occupancy query says %d\n", per_cu); per_cu = 1; }
        (void)hipGetLastError();
        if (per_cu > 1) per_cu = 1;
        grid = cus * per_cu;
    }
    if (grid < 0) return;
    if (hipMemsetAsync((char*)d_ws + WS_BAR, 0, BAR_ZERO_BYTES, stream) != hipSuccess) { fprintf(stderr, "kernel_launch: hipMemsetAsync failed\n"); return; }
    Args a{};
    for (int i = 0; i < 33; ++i) a.in[i] = d_in[i];
    a.out = (float*)d_out; a.ws = (unsigned char*)d_ws;
#if N_LAUNCHES == 1
    a.ph_lo = 0; a.ph_hi = N_PHASES;
    void* kargs[] = {&a};
    const hipError_t e = hipLaunchCooperativeKernel((const void*)fwd_kernel, dim3(grid), dim3(NTHR), kargs, LDS_BYTES, stream);
    if (e != hipSuccess) fprintf(stderr, "kernel_launch: cooperative launch failed: %s (grid %d)\n", hipGetErrorString(e), grid);
#else
    for (int p = 0; p < N_PHASES; ++p) { a.ph_lo = p; a.ph_hi = p + 1; hipLaunchKernelGGL(fwd_kernel, dim3(grid), dim3(NTHR), LDS_BYTES, stream, a); }
#endif
}
```

```cpp
#include <hip/hip_runtime.h>
#include <hip/hip_cooperative_groups.h>
#include <cstdio>
#include <cstdint>
namespace cg = cooperative_groups;

#ifndef FAST_GEMM
#define FAST_GEMM 1
#endif
#ifndef FAST_ATTN
#define FAST_ATTN 1
#endif

namespace pg8 {
#define PG8_LAS __attribute__((address_space(3)))
typedef unsigned short bf16_t;
typedef short bf16x8 __attribute__((ext_vector_type(8)));
typedef float f32x4 __attribute__((ext_vector_type(4)));
typedef unsigned u32x4 __attribute__((ext_vector_type(4)));
constexpr int BM = 256, BK = 64, HALF = 128, HTB = HALF * BK * 2  , STAGE_BYTES = 8 * HTB, NXCD = 8, WGM = 8;

__host__ __device__ __forceinline__ int lds_byte(int r, int c) { const int st = (r >> 4) * 2 + (c >> 5), rr = r & 15, cc = c & 31, ob = rr * 64 + cc * 2; return st * 1024 + (ob ^ (((ob >> 9) & 1) << 5)); }
__host__ __device__ __forceinline__ void stage_rc(int b, int& R, int& C) { const int st = b / 1024, sb = b % 1024, swz = sb ^ (((sb >> 9) & 1) << 5); R = (st >> 1) * 16 + swz / 64; C = (st & 1) * 32 + (swz % 64) / 2; }
__host__ __device__ __forceinline__ int perm32(int rho) { const int n = rho >> 4, i = rho & 15; return 8 * (i >> 2) + 4 * n + (i & 3); }

typedef unsigned u32x2 __attribute__((ext_vector_type(2)));
struct Unit { int pm, pn, job; const char* A; const char* B; };
struct Gemm { int K, lda, ldb; };

template <class Epi, class Sched, bool ALIGN_EPI = false, bool SP2 = false>
__device__ __forceinline__ void gemm_phase(PG8_LAS unsigned char* lds, const Gemm g, const Sched& S, const Epi& E) {
    const int tid = threadIdx.x, wid = __builtin_amdgcn_readfirstlane(tid >> 6), lane = tid & 63, wr = wid >> 2, wc = wid & 3, fr = lane & 15, fq = lane >> 4;
    int Kopq = g.K; asm volatile("" : "+s"(Kopq));
    const int K = Kopq, nt = K / BK;
    unsigned voffA[2], voffB[2];
#pragma unroll
    for (int i = 0; i < 2; ++i) { int R, C; stage_rc(tid * 16 + i * 8192, R, C); const int Rb = Epi::PERM ? ((R & ~31) + perm32(R & 31)) : R;
        voffA[i] = (unsigned)(R * g.lda + C) * 2u; voffB[i] = (unsigned)(Rb * g.ldb + C) * 2u; }
    const size_t kstep = (size_t)(BK * 2);
    const size_t hstepA = (size_t)HALF * g.lda * 2, hstepB = (size_t)HALF * g.ldb * 2;
    const unsigned ldsw = (unsigned)wid * 1024u;
    const int aoff = lds_byte(wr * 64 + fr, fq * 8), boff = lds_byte(wc * 32 + fr, fq * 8);
#define PG8_SA(b, h) (((b) * 2 + (h)) * HTB)
#define PG8_SB(b, h) ((4 + (b) * 2 + (h)) * HTB)
#define PG8_STAGE(bufoff, gbase, voff) do { _Pragma("unroll") for (int _i = 0; _i < 2; ++_i) \
        __builtin_amdgcn_global_load_lds((const unsigned*)((const char*)(gbase) + (voff)[_i]), (PG8_LAS unsigned*)(lds + (bufoff) + ldsw + _i * 8192), 16, 0, 0); } while (0)
#define PG8_LDA(dst, b, h) do { _Pragma("unroll") for (int m = 0; m < 4; ++m) _Pragma("unroll") for (int k = 0; k < 2; ++k) dst[m][k] = *(const PG8_LAS bf16x8*)(lds + PG8_SA(b, h) + aoff + m * 2048 + k * 1024); } while (0)
#define PG8_LDB(dst, b, h) do { _Pragma("unroll") for (int n = 0; n < 2; ++n) _Pragma("unroll") for (int k = 0; k < 2; ++k) dst[n][k] = *(const PG8_LAS bf16x8*)(lds + PG8_SB(b, h) + boff + n * 2048 + k * 1024); } while (0)
#define PG8_MMA(ai, bj, At, Bt) do { __builtin_amdgcn_s_setprio(1); _Pragma("unroll") for (int m = 0; m < 4; ++m) _Pragma("unroll") for (int n = 0; n < 2; ++n) _Pragma("unroll") for (int k = 0; k < 2; ++k) \
        acc[ai][bj][m][n] = __builtin_amdgcn_mfma_f32_16x16x32_bf16(Bt[n][k], At[m][k], acc[ai][bj][m][n], 0, 0, 0); __builtin_amdgcn_s_setprio(0); } while (0)
#define PG8_WAIT_V(n) asm volatile("s_waitcnt vmcnt(" #n ")" ::: "memory")
#define PG8_WAIT_L(n) asm volatile("s_waitcnt lgkmcnt(" #n ")" ::: "memory")
#define PG8_BAR __builtin_amdgcn_s_barrier()
#define PG8_SCHED __builtin_amdgcn_sched_barrier(0)
    Unit cur, nxt; int ui = 0;
    if (!S.next(0, cur)) return;
    f32x4 acc[2][2][4][2];
#pragma unroll
    for (int a = 0; a < 2; ++a)
#pragma unroll
        for (int b = 0; b < 2; ++b)
#pragma unroll
            for (int m = 0; m < 4; ++m)
#pragma unroll
                for (int n = 0; n < 2; ++n) acc[a][b][m][n] = (f32x4){0.f, 0.f, 0.f, 0.f};
    bf16x8 At[4][2], B0[2][2], B1[2][2];
    const char* cA = cur.A; const char* cB = cur.B;
    S.a_ready(cur);
    if constexpr (SP2) {
        PG8_STAGE(PG8_SB(0, 0), cB, voffB); PG8_STAGE(PG8_SB(0, 1), cB + hstepB, voffB); PG8_STAGE(PG8_SA(0, 0), cA, voffA); PG8_STAGE(PG8_SA(0, 1), cA + hstepA, voffA);
        if (wr == 1) PG8_BAR;
        PG8_WAIT_V(2); PG8_BAR;
        PG8_STAGE(PG8_SB(1, 0), cB + kstep, voffB); PG8_STAGE(PG8_SA(1, 0), cA + kstep, voffA); PG8_STAGE(PG8_SB(1, 1), cB + hstepB + kstep, voffB);
        PG8_WAIT_V(6); PG8_BAR;
    } else {
        PG8_STAGE(PG8_SB(0, 0), cB, voffB); PG8_STAGE(PG8_SA(0, 0), cA, voffA); PG8_STAGE(PG8_SB(0, 1), cB + hstepB, voffB); PG8_STAGE(PG8_SA(0, 1), cA + hstepA, voffA);
        if (wr == 1) PG8_BAR;
        PG8_WAIT_V(4); PG8_BAR;
        PG8_STAGE(PG8_SB(1, 0), cB + kstep, voffB); PG8_STAGE(PG8_SA(1, 0), cA + kstep, voffA); PG8_STAGE(PG8_SB(1, 1), cB + hstepB + kstep, voffB);
        PG8_WAIT_V(6); PG8_BAR;
    }
    for (;;) {
        const bool has_next = S.next(ui + 1, nxt);
        const char* nA = has_next ? nxt.A : cA; const char* nB = has_next ? nxt.B : cB;
        for (int t = 0; t < nt; t += 2) {
            const bool last = (t == nt - 2);
            const char* a1 = cA + (size_t)(t + 1) * kstep;
            const char* a2 = last ? nA : cA + (size_t)(t + 2) * kstep; const char* b2 = last ? nB : cB + (size_t)(t + 2) * kstep;
            const char* a3 = a2 + kstep; const char* b3 = b2 + kstep;
            if (last && has_next) S.a_ready(nxt);
            if constexpr (SP2) {
            PG8_LDB(B0, 0, 0); PG8_LDB(B1, 0, 1); PG8_SCHED; PG8_LDA(At, 0, 0); PG8_STAGE(PG8_SA(1, 1), a1 + hstepA, voffA);
            PG8_WAIT_V(8); PG8_WAIT_L(0); PG8_BAR; PG8_MMA(0, 0, At, B0); PG8_MMA(0, 1, At, B1); PG8_BAR; PG8_SCHED;
            PG8_LDA(At, 0, 1); PG8_STAGE(PG8_SB(0, 0), b2, voffB); PG8_STAGE(PG8_SB(0, 1), b2 + hstepB, voffB); PG8_STAGE(PG8_SA(0, 0), a2, voffA);
            PG8_WAIT_V(8); PG8_WAIT_L(0); PG8_BAR; PG8_MMA(1, 0, At, B0); PG8_MMA(1, 1, At, B1); PG8_BAR; PG8_SCHED;
            PG8_LDB(B0, 1, 0); PG8_LDB(B1, 1, 1); PG8_SCHED; PG8_LDA(At, 1, 0); PG8_STAGE(PG8_SA(0, 1), a2 + hstepA, voffA);
            PG8_WAIT_V(8); PG8_WAIT_L(0); PG8_BAR; PG8_MMA(0, 0, At, B0); PG8_MMA(0, 1, At, B1); PG8_BAR; PG8_SCHED;
            PG8_LDA(At, 1, 1); PG8_STAGE(PG8_SB(1, 0), b3, voffB); PG8_STAGE(PG8_SB(1, 1), b3 + hstepB, voffB); PG8_STAGE(PG8_SA(1, 0), a3, voffA);
            PG8_WAIT_V(8); PG8_WAIT_L(0); PG8_BAR; PG8_MMA(1, 0, At, B0); PG8_MMA(1, 1, At, B1); PG8_BAR; PG8_SCHED;
            } else {
            PG8_LDB(B0, 0, 0); PG8_SCHED; PG8_LDA(At, 0, 0); PG8_STAGE(PG8_SA(1, 1), a1 + hstepA, voffA);
            PG8_WAIT_L(8); PG8_BAR; PG8_WAIT_L(0); PG8_MMA(0, 0, At, B0); PG8_BAR; PG8_SCHED;
            PG8_LDB(B1, 0, 1); PG8_STAGE(PG8_SB(0, 0), b2, voffB);
            PG8_BAR; PG8_WAIT_L(0); PG8_MMA(0, 1, At, B1); PG8_BAR;
            PG8_LDA(At, 0, 1); PG8_STAGE(PG8_SA(0, 0), a2, voffA);
            PG8_BAR; PG8_WAIT_L(0); PG8_MMA(1, 0, At, B0); PG8_BAR; PG8_SCHED;
            PG8_STAGE(PG8_SB(0, 1), b2 + hstepB, voffB);
            PG8_WAIT_V(6); PG8_BAR; PG8_MMA(1, 1, At, B1); PG8_BAR;
            PG8_LDB(B0, 1, 0); PG8_SCHED; PG8_LDA(At, 1, 0); PG8_STAGE(PG8_SA(0, 1), a2 + hstepA, voffA);
            PG8_WAIT_L(8); PG8_BAR; PG8_WAIT_L(0); PG8_MMA(0, 0, At, B0); PG8_BAR; PG8_SCHED;
            PG8_LDB(B1, 1, 1); PG8_STAGE(PG8_SB(1, 0), b3, voffB);
            PG8_BAR; PG8_WAIT_L(0); PG8_MMA(0, 1, At, B1); PG8_BAR;
            PG8_LDA(At, 1, 1); PG8_STAGE(PG8_SA(1, 0), a3, voffA);
            PG8_BAR; PG8_WAIT_L(0); PG8_MMA(1, 0, At, B0); PG8_BAR; PG8_SCHED;
            PG8_STAGE(PG8_SB(1, 1), b3 + hstepB, voffB);
            PG8_WAIT_V(6); PG8_BAR; PG8_MMA(1, 1, At, B1); PG8_BAR;
            }
        }
        if constexpr (ALIGN_EPI) { if (wr == 0) PG8_BAR; }
        if constexpr (!Epi::AFTER_DRAIN) { E(acc, cur, wr, wc, fr, fq); S.done(cur); }
        if (!has_next) break;
#pragma unroll
        for (int a = 0; a < 2; ++a)
#pragma unroll
            for (int b = 0; b < 2; ++b)
#pragma unroll
                for (int m = 0; m < 4; ++m)
#pragma unroll
                    for (int n = 0; n < 2; ++n) acc[a][b][m][n] = (f32x4){0.f, 0.f, 0.f, 0.f};
        cur = nxt; cA = nA; cB = nB; ++ui;
        if constexpr (ALIGN_EPI) { if (wr == 1) PG8_BAR; }
    }
    PG8_WAIT_V(0);
    if constexpr (!ALIGN_EPI) { if (wr == 0) PG8_BAR; }
    PG8_BAR;
    if constexpr (Epi::AFTER_DRAIN) { E.fused(acc, cur, wr, wc, fr, fq, lds, wid, lane); S.done(cur); }
#undef PG8_SA
#undef PG8_SB
#undef PG8_STAGE
#undef PG8_LDA
#undef PG8_LDB
#undef PG8_MMA
#undef PG8_WAIT_V
#undef PG8_WAIT_L
#undef PG8_BAR
#undef PG8_SCHED
}

__device__ __forceinline__ float bf2f(bf16_t v) { return __uint_as_float((unsigned)v << 16); }
__device__ __forceinline__ float bflo(unsigned w) { return __uint_as_float(w << 16); }
__device__ __forceinline__ float bfhi(unsigned w) { return __uint_as_float(w & 0xffff0000u); }
__device__ __forceinline__ unsigned cvt_pk_bf16(float lo, float hi) { unsigned r; asm volatile("v_cvt_pk_bf16_f32 %0, %1, %2" : "=v"(r) : "v"(lo), "v"(hi)); return r; }

template <class Epi, class Sched>
__device__ __forceinline__ void gemm_naive(const Gemm g, const Sched& S, const Epi& E) {
    const int tid = threadIdx.x, wid = tid >> 6, lane = tid & 63, wr = wid >> 2, wc = wid & 3, fr = lane & 15, fq = lane >> 4;
    Unit u;
    for (int i = 0; S.next(i, u); ++i) {
        f32x4 acc[2][2][4][2];
#pragma unroll
        for (int ai = 0; ai < 2; ++ai)
#pragma unroll
            for (int bj = 0; bj < 2; ++bj)
#pragma unroll
                for (int m = 0; m < 4; ++m)
#pragma unroll
                    for (int n = 0; n < 2; ++n) {
                        const bf16_t* a = (const bf16_t*)u.A + (size_t)(ai * 128 + wr * 64 + m * 16 + fr) * g.lda;
                        const bf16_t* b = (const bf16_t*)u.B + (size_t)(bj * 128 + wc * 32 + n * 16 + 4 * fq) * g.ldb;
                        float s0 = 0.f, s1 = 0.f, s2 = 0.f, s3 = 0.f;
                        for (int k = 0; k < g.K; k += 8) {
                            const bf16x8 av = *(const bf16x8*)(a + k), b0 = *(const bf16x8*)(b + k), b1 = *(const bf16x8*)(b + g.ldb + k), b2 = *(const bf16x8*)(b + 2 * g.ldb + k), b3 = *(const bf16x8*)(b + 3 * g.ldb + k);
#pragma unroll
                            for (int e = 0; e < 8; ++e) { const float x = bf2f((bf16_t)av[e]); s0 += x * bf2f((bf16_t)b0[e]); s1 += x * bf2f((bf16_t)b1[e]); s2 += x * bf2f((bf16_t)b2[e]); s3 += x * bf2f((bf16_t)b3[e]); }
                        }
                        acc[ai][bj][m][n] = (f32x4){s0, s1, s2, s3};
                    }
        E(acc, u, wr, wc, fr, fq);
    }
}

struct Job { const char* A; const char* B; int nM, nN; };
struct Sched2 {
    Job a, b; int G, c, lda, ldb;
    __device__ __forceinline__ bool next(int i, Unit& u) const {
        int L = i * G + c; const int na = a.nM * a.nN, nb = b.nM * b.nN;
        if (L < na) { u.job = 0; u.pm = L % a.nM; u.pn = L / a.nM; u.A = a.A + (size_t)u.pm * 256 * lda * 2; u.B = a.B + (size_t)u.pn * 256 * ldb * 2; return true; }
        L -= na;
        if (L < nb) { u.job = 1; u.pm = L % b.nM; u.pn = L / b.nM; u.A = b.A + (size_t)u.pm * 256 * lda * 2; u.B = b.B + (size_t)u.pn * 256 * ldb * 2; return true; }
        return false;
    }
    __device__ __forceinline__ void a_ready(const Unit&) const {}
    __device__ __forceinline__ void done(const Unit&) const {}
};
struct GateOrder {
    const char* xc; const char* wg; size_t dstride; int G, c;
    __device__ __forceinline__ bool next(int i, Unit& u) const {
        const int L = i * G + c; if (L >= 512) return false;
        const int grp = L >> 6, pm = L & 63, d = grp >> 2, png = grp & 3;
        u.job = d; u.pm = pm; u.pn = png; u.A = xc + (size_t)d * dstride + ((size_t)pm * 256 * 512 + png * 128) * 2; u.B = wg + (size_t)grp * 256 * 128 * 2; return true;
    }
    __device__ __forceinline__ void a_ready(const Unit&) const {}
    __device__ __forceinline__ void done(const Unit&) const {}
};

__device__ __forceinline__ float rowscale16(const float* ss, int row) {
    const f32x4* p = (const f32x4*)(ss + (size_t)row * 16); const f32x4 a = p[0], b = p[1], c = p[2], d = p[3];
    const float s = ((a[0] + a[1]) + (a[2] + a[3])) + ((b[0] + b[1]) + (b[2] + b[3])) + ((c[0] + c[1]) + (c[2] + c[3])) + ((d[0] + d[1]) + (d[2] + d[3]));
    return 1.0f / sqrtf(s * (1.0f / 1024.0f) + 1e-6f);
}
template <bool ROWSCALE> struct EpiBf {
    static constexpr bool PERM = false, AFTER_DRAIN = false;
    bf16_t* O0; int ld0; bf16_t* O1; int ld1; const float* ss;
    __device__ __forceinline__ void operator()(const f32x4 (&acc)[2][2][4][2], const Unit& u, int wr, int wc, int fr, int fq) const {
        bf16_t* O = u.job ? O1 : O0; const int ldc = u.job ? ld1 : ld0;
        const int row0 = u.pm * 256 + wr * 64 + fr, col0 = u.pn * 256 + wc * 32 + 4 * fq;
#pragma unroll
        for (int ai = 0; ai < 2; ++ai)
#pragma unroll
            for (int m = 0; m < 4; ++m) { const int row = row0 + ai * 128 + m * 16; float rs = 1.f; if (ROWSCALE) rs = rowscale16(ss, row);
                bf16_t* rowp = O + (size_t)row * ldc + col0;
#pragma unroll
                for (int bj = 0; bj < 2; ++bj)
#pragma unroll
                    for (int n = 0; n < 2; ++n) { const f32x4 v = acc[ai][bj][m][n] * rs; u32x2 w; w.x = cvt_pk_bf16(v[0], v[1]); w.y = cvt_pk_bf16(v[2], v[3]); *(u32x2*)(rowp + bj * 128 + n * 16) = w; } }
    }
};
template <bool STATS> struct EpiResid {
    static constexpr bool PERM = false, AFTER_DRAIN = false;
    const float* base; float* out; bf16_t* xb; float* ss;
    __device__ __forceinline__ void operator()(const f32x4 (&acc)[2][2][4][2], const Unit& u, int wr, int wc, int fr, int fq) const {
        const int row0 = u.pm * 256 + wr * 64 + fr, col0 = u.pn * 256 + wc * 32 + 4 * fq;
#pragma unroll
        for (int ai = 0; ai < 2; ++ai)
#pragma unroll
            for (int m = 0; m < 4; ++m) { const int row = row0 + ai * 128 + m * 16; const size_t off = (size_t)row * 1024 + col0; float s = 0.f;
#pragma unroll
                for (int bj = 0; bj < 2; ++bj)
#pragma unroll
                    for (int n = 0; n < 2; ++n) { const size_t o2 = off + bj * 128 + n * 16; const f32x4 v = *(const f32x4*)(base + o2) + acc[ai][bj][m][n]; *(f32x4*)(out + o2) = v;
                        if (STATS) { s += (v[0] * v[0] + v[1] * v[1]) + (v[2] * v[2] + v[3] * v[3]); u32x2 w; w.x = cvt_pk_bf16(v[0], v[1]); w.y = cvt_pk_bf16(v[2], v[3]); *(u32x2*)(xb + o2) = w; } }
                if (STATS) { s += __shfl_xor(s, 16); s += __shfl_xor(s, 32); if (fq == 0) ss[(size_t)row * 16 + u.pn * 4 + wc] = s; } }
    }
};
struct EpiGates {
    static constexpr bool PERM = false, AFTER_DRAIN = false;
    const bf16_t* xc; const float* b_a; const float* b_i; const float* c8t; unsigned* G; int T;
    __device__ __forceinline__ void operator()(const f32x4 (&acc)[2][2][4][2], const Unit& u, int wr, int wc, int fr, int fq) const {
        const int d = u.job, row0 = u.pm * 256 + wr * 64 + fr, ch0 = u.pn * 128 + wc * 32 + 4 * fq;
#pragma unroll
        for (int n = 0; n < 2; ++n) { const int ch = d * 512 + ch0 + n * 16; const f32x4 ba = *(const f32x4*)(b_a + ch), bi = *(const f32x4*)(b_i + ch), c8 = *(const f32x4*)(c8t + ch);
#pragma unroll
            for (int ai = 0; ai < 2; ++ai)
#pragma unroll
                for (int m = 0; m < 4; ++m) { const int row = row0 + ai * 128 + m * 16;
                    const size_t off = ((size_t)d * T + row) * 512 + ch0 + n * 16; const u32x2 xw = *(const u32x2*)(xc + off);
                    const float xv[4] = {bflo(xw.x), bfhi(xw.x), bflo(xw.y), bfhi(xw.y)}; const f32x4 pa = acc[ai][0][m][n] + ba, pi = acc[ai][1][m][n] + bi; u32x4 o;
#pragma unroll
                    for (int e = 0; e < 4; ++e) { const float r = 1.0f / (1.0f + __expf(-pa[e])), ig = 1.0f / (1.0f + __expf(-pi[e])); const float la = r * c8[e];
                        const float x2 = 2.0f * la; const float om = (x2 > -0.02f) ? -(x2 + 0.5f * x2 * x2 + x2 * x2 * x2 * (1.0f / 6.0f)) : 1.0f - __expf(x2);
                        o[e] = cvt_pk_bf16(la, sqrtf(fmaxf(om, 0.f)) * ig * xv[e]); }
                    *(u32x4*)(G + off) = o; asm volatile("" ::: "memory"); } }
    }
};
}

namespace att {
using pg8::bf16_t;
using bf16x8 = __attribute__((ext_vector_type(8))) short;
using s16x4  = __attribute__((ext_vector_type(4))) short;
using f32x16 = __attribute__((ext_vector_type(16))) float;
using u32x4  = __attribute__((ext_vector_type(4))) unsigned;
constexpr int NW = 8, QBLK = 32, KVBLK = 64;
constexpr size_t SHM_V = KVBLK * 128 * 2, SHM_K = KVBLK * 128 * 2, SHM_ATTN = 2 * SHM_V + 2 * SHM_K + NW * 64 * 4;
constexpr float THR = 8.f;
#define KSWZ(row, colB) ((row) * 256 + ((colB) ^ (((row) & 7) << 4)))
#define SBAR() __builtin_amdgcn_sched_barrier(0)
__device__ __forceinline__ int crow(int r, int hi) { return (r & 3) + 8 * (r >> 2) + 4 * hi; }
__device__ __forceinline__ unsigned cvtpk(float lo, float hi) { unsigned r; asm volatile("v_cvt_pk_bf16_f32 %0, %1, %2" : "=v"(r) : "v"(lo), "v"(hi)); return r; }
template <bool FIXED> __device__ __forceinline__ void partialSM(f32x16& p0, f32x16& p1, float& m_reg, float& mn, float& alpha, float C, float thr_raw) {
  if constexpr (FIXED) {
    alpha = 1.f;
#pragma unroll
    for (int r = 0; r < 16; ++r) p0[r] = __builtin_amdgcn_exp2f(p0[r]);
    return; }
  float pmax = p0[0];
#pragma unroll
  for (int r = 1; r < 16; ++r) pmax = fmaxf(pmax, p0[r]);
#pragma unroll
  for (int r = 0; r < 16; ++r) pmax = fmaxf(pmax, p1[r]);
  { auto rr = __builtin_amdgcn_permlane32_swap(__float_as_uint(pmax), __float_as_uint(pmax), false, false);
    pmax = fmaxf(__uint_as_float(rr[0]), __uint_as_float(rr[1])); }
  if (__builtin_expect(__all(pmax - m_reg <= thr_raw), 1)) { mn = m_reg; alpha = 1.f; }
  else { mn = fmaxf(m_reg, pmax); alpha = __builtin_amdgcn_exp2f((m_reg - mn) * C); m_reg = mn; }
  const float mnC = -mn * C;
#pragma unroll
  for (int r = 0; r < 16; ++r) p0[r] = fmaf(p0[r], C, mnC);
#pragma unroll
  for (int r = 0; r < 16; ++r) p1[r] = fmaf(p1[r], C, mnC);
#pragma unroll
  for (int r = 0; r < 16; ++r) p0[r] = __builtin_amdgcn_exp2f(p0[r]);
}
__device__ __forceinline__ void finishSM(f32x16& p0, f32x16& p1, float alpha, float& l_reg, bf16x8& pa0, bf16x8& pa1, bf16x8& pa2, bf16x8& pa3) {
#pragma unroll
  for (int r = 0; r < 16; ++r) p1[r] = __builtin_amdgcn_exp2f(p1[r]);
  float ps = 0;
#pragma unroll
  for (int r = 0; r < 16; ++r) ps += p0[r];
#pragma unroll
  for (int r = 0; r < 16; ++r) ps += p1[r];
  { auto rr = __builtin_amdgcn_permlane32_swap(__float_as_uint(ps), __float_as_uint(ps), false, false);
    ps = __uint_as_float(rr[0]) + __uint_as_float(rr[1]); }
  l_reg = l_reg * alpha + ps;
#define PK4(P, BASE, OUT) do { unsigned a0 = cvtpk(P[BASE + 0], P[BASE + 1]), a1 = cvtpk(P[BASE + 2], P[BASE + 3]);   \
    unsigned b0 = cvtpk(P[BASE + 4], P[BASE + 5]), b1 = cvtpk(P[BASE + 6], P[BASE + 7]);                              \
    auto r0 = __builtin_amdgcn_permlane32_swap(a0, b0, false, false); auto r1 = __builtin_amdgcn_permlane32_swap(a1, b1, false, false); \
    u32x4 w = {r0[0], r1[0], r0[1], r1[1]}; OUT = *reinterpret_cast<bf16x8*>(&w); } while (0)
  PK4(p0, 0, pa0); PK4(p0, 8, pa1); PK4(p1, 0, pa2); PK4(p1, 8, pa3);
#undef PK4
}
template <int DQK> __device__ __forceinline__ void qkt(f32x16& p0, f32x16& p1, const bf16_t* Ks, const bf16x8* qr, int r32, int hi) {
  p0 = f32x16{}; p1 = f32x16{};
#pragma unroll
  for (int d0 = 0; d0 < DQK / 16; ++d0) { const int cb = (d0 * 16 + hi * 8) * 2;
    const bf16x8 b0 = *reinterpret_cast<const bf16x8*>((const char*)Ks + KSWZ(r32, cb));
    const bf16x8 b1 = *reinterpret_cast<const bf16x8*>((const char*)Ks + KSWZ(32 + r32, cb));
    p0 = __builtin_amdgcn_mfma_f32_32x32x16_bf16(b0, qr[d0], p0, 0, 0, 0);
    p1 = __builtin_amdgcn_mfma_f32_32x32x16_bf16(b1, qr[d0], p1, 0, 0, 0); }
}
__device__ __forceinline__ int v_st(int k, int c) { const int kk = (k & ~0xC) | ((k & 4) << 1) | ((k & 8) >> 1); return ((kk >> 3) * 4 + (c >> 5)) * 512 + ((kk & 7) * 32 + (c & 31)) * 2; }
__device__ __forceinline__ int v_rd_base(int lane) { return ((lane & 3) << 3) | (((lane >> 2) & 3) << 6) | (((lane >> 4) & 1) << 5) | (((lane >> 5) & 1) << 8); }
constexpr int v_rd_off(int d0, int ks, int half) { return d0 * 512 + ks * 4096 + half * 2048; }
template <int OFF> __device__ __forceinline__ s16x4 tr_read(int vb) {
  s16x4 r; asm volatile("ds_read_b64_tr_b16 %0, %1 offset:%2" : "=&v"(r) : "v"(vb), "i"(OFF) : "memory"); return r;
}
template <int D0> __device__ __forceinline__ void pv_one(f32x16& od, int vb, bf16x8 pa0, bf16x8 pa1, bf16x8 pa2, bf16x8 pa3) {
  const s16x4 l0 = tr_read<v_rd_off(D0, 0, 0)>(vb), h0 = tr_read<v_rd_off(D0, 0, 1)>(vb), l1 = tr_read<v_rd_off(D0, 1, 0)>(vb), h1 = tr_read<v_rd_off(D0, 1, 1)>(vb);
  const s16x4 l2 = tr_read<v_rd_off(D0, 2, 0)>(vb), h2 = tr_read<v_rd_off(D0, 2, 1)>(vb), l3 = tr_read<v_rd_off(D0, 3, 0)>(vb), h3 = tr_read<v_rd_off(D0, 3, 1)>(vb);
  asm volatile("s_waitcnt lgkmcnt(0)" ::: "memory"); SBAR();
#define PK(L, H) (bf16x8){L[0], L[1], L[2], L[3], H[0], H[1], H[2], H[3]}
  od = __builtin_amdgcn_mfma_f32_32x32x16_bf16(pa0, PK(l0, h0), od, 0, 0, 0);
  od = __builtin_amdgcn_mfma_f32_32x32x16_bf16(pa1, PK(l1, h1), od, 0, 0, 0);
  od = __builtin_amdgcn_mfma_f32_32x32x16_bf16(pa2, PK(l2, h2), od, 0, 0, 0);
  od = __builtin_amdgcn_mfma_f32_32x32x16_bf16(pa3, PK(l3, h3), od, 0, 0, 0);
#undef PK
}
template <int DV> __device__ __forceinline__ void pv_all(f32x16* o, int vb, bf16x8 pa0, bf16x8 pa1, bf16x8 pa2, bf16x8 pa3) {
  pv_one<0>(o[0], vb, pa0, pa1, pa2, pa3); pv_one<1>(o[1], vb, pa0, pa1, pa2, pa3);
  if constexpr (DV == 128) { pv_one<2>(o[2], vb, pa0, pa1, pa2, pa3); pv_one<3>(o[3], vb, pa0, pa1, pa2, pa3); }
}

template <int DQK, int DV, bool QNORM, bool FIXED>
__device__ __forceinline__ void attn_unit(const bf16_t* __restrict__ Qb, int ldq, const bf16_t* __restrict__ Kh, int ldk, const bf16_t* __restrict__ Vh, int ldv,
                                          bf16_t* __restrict__ Ob, int ldo, int seq, float scale, const float* __restrict__ qgain, char* lds) {
  const int tid = threadIdx.x, wid = tid >> 6, lane = tid & 63, r32 = lane & 31, hi = lane >> 5;
  const float C = 1.0f, thr_raw = THR * 1.4426950408889634f;
  bf16_t* V_lds = (bf16_t*)lds; bf16_t* K_lds = (bf16_t*)(lds + 2 * SHM_V);
  float* ws = (float*)(lds + 2 * SHM_V + 2 * SHM_K) + wid * 64; float* li_l = ws; float* al_l = ws + 32;
  float m_reg = -1e30f, l_reg = 0; f32x16 o[DV / 32]; bf16x8 qr[DQK / 16];
#pragma unroll
  for (int d = 0; d < DV / 32; ++d) o[d] = f32x16{};
  const bf16_t* Qw = Qb + (long)(wid * QBLK + r32) * ldq + hi * 8;
#pragma unroll
  for (int d0 = 0; d0 < DQK / 16; ++d0) qr[d0] = *reinterpret_cast<const bf16x8*>(Qw + d0 * 16);
  if constexpr (QNORM) {
    float ssq = 0.f;
#pragma unroll
    for (int d0 = 0; d0 < DQK / 16; ++d0)
#pragma unroll
      for (int e = 0; e < 8; ++e) { const float v = pg8::bf2f((bf16_t)qr[d0][e]); ssq += v * v; }
    ssq += __shfl_xor(ssq, 32);
    const float rs = scale * 1.4426950408889634f / sqrtf(ssq * (1.0f / DQK) + 1e-6f);
#pragma unroll
    for (int d0 = 0; d0 < DQK / 16; ++d0) { float v[8];
#pragma unroll
      for (int e = 0; e < 8; ++e) v[e] = pg8::bf2f((bf16_t)qr[d0][e]) * rs * qgain[d0 * 16 + hi * 8 + e];
      u32x4 w = {cvtpk(v[0], v[1]), cvtpk(v[2], v[3]), cvtpk(v[4], v[5]), cvtpk(v[6], v[7])}; qr[d0] = *reinterpret_cast<bf16x8*>(&w); }
  }
  const int sr = tid >> 4, sc = (tid & 15) * 8, vst0 = v_st(sr, sc), vst1 = v_st(32 + sr, sc);
  const bool kact = sc < DQK, vact = sc < DV;
  const int vb0 = (int)(uintptr_t)V_lds + v_rd_base(lane);
  bf16x8 svs0[2], svs1[2], sks0[2], sks1[2];
#define SLOAD(i, k0) do { if (vact) { svs0[i] = *(const bf16x8*)(&Vh[(long)((k0) + sr) * ldv + sc]); svs1[i] = *(const bf16x8*)(&Vh[(long)((k0) + 32 + sr) * ldv + sc]); } \
    if (kact) { sks0[i] = *(const bf16x8*)(&Kh[(long)((k0) + sr) * ldk + sc]); sks1[i] = *(const bf16x8*)(&Kh[(long)((k0) + 32 + sr) * ldk + sc]); } } while (0)
#define SWRITE(b, i) do { if (vact) { *(bf16x8*)((char*)V_lds + (b) * SHM_V + vst0) = svs0[i]; *(bf16x8*)((char*)V_lds + (b) * SHM_V + vst1) = svs1[i]; } \
    if (kact) { const int kc = sc * 2; *(bf16x8*)((char*)K_lds + (b) * SHM_K + KSWZ(sr, kc)) = sks0[i]; *(bf16x8*)((char*)K_lds + (b) * SHM_K + KSWZ(32 + sr, kc)) = sks1[i]; } } while (0)
#define SWAIT() asm volatile("s_waitcnt vmcnt(4)" ::: "memory")
#define RESC(a) do { if (!FIXED && __any((a) < 1.f)) { if (hi == 0) al_l[r32] = (a); asm volatile("s_waitcnt lgkmcnt(0)" ::: "memory"); \
    _Pragma("unroll") for (int d = 0; d < DV / 32; ++d) _Pragma("unroll") for (int r = 0; r < 16; ++r) o[d][r] *= al_l[crow(r, hi)]; } } while (0)
  f32x16 pA0, pA1, pB0, pB1; float mnA, mnB, alA, alB; bf16x8 pa0, pa1, pa2, pa3; const int NT = seq / KVBLK;
  constexpr int SE = 0, SO = 1;
  SLOAD(SE, 0); asm volatile("s_waitcnt vmcnt(0)" ::: "memory"); SWRITE(0, SE); __syncthreads();
  qkt<DQK>(pA0, pA1, K_lds, qr, r32, hi); partialSM<FIXED>(pA0, pA1, m_reg, mnA, alA, C, thr_raw);
  SLOAD(SO, KVBLK); if (2 < NT) SLOAD(SE, 2 * KVBLK);
  SWAIT(); SWRITE(1, SO); __syncthreads();
  for (int j = 1; j + 1 < NT; j += 2) {
    SBAR(); qkt<DQK>(pB0, pB1, (bf16_t*)((char*)K_lds + SHM_K), qr, r32, hi);
    finishSM(pA0, pA1, alA, l_reg, pa0, pa1, pa2, pa3); SBAR();
    SLOAD(SO, (j + 2) * KVBLK); SBAR();
    pv_all<DV>(o, vb0, pa0, pa1, pa2, pa3); partialSM<FIXED>(pB0, pB1, m_reg, mnB, alB, C, thr_raw);
    __syncthreads(); SWAIT(); SWRITE(0, SE);
    RESC(alB); __syncthreads();
    SBAR(); qkt<DQK>(pA0, pA1, K_lds, qr, r32, hi);
    finishSM(pB0, pB1, alB, l_reg, pa0, pa1, pa2, pa3); SBAR();
    if (j + 3 < NT) SLOAD(SE, (j + 3) * KVBLK); SBAR();
    pv_all<DV>(o, vb0 + (int)SHM_V, pa0, pa1, pa2, pa3); partialSM<FIXED>(pA0, pA1, m_reg, mnA, alA, C, thr_raw);
    __syncthreads(); SWAIT(); SWRITE(1, SO);
    RESC(alA); __syncthreads();
  }
  SBAR(); qkt<DQK>(pB0, pB1, (bf16_t*)((char*)K_lds + SHM_K), qr, r32, hi);
  finishSM(pA0, pA1, alA, l_reg, pa0, pa1, pa2, pa3); SBAR();
  pv_all<DV>(o, vb0, pa0, pa1, pa2, pa3); partialSM<FIXED>(pB0, pB1, m_reg, mnB, alB, C, thr_raw);
  __syncthreads(); RESC(alB);
  finishSM(pB0, pB1, alB, l_reg, pa0, pa1, pa2, pa3); SBAR();
  pv_all<DV>(o, vb0 + (int)SHM_V, pa0, pa1, pa2, pa3);
  if (hi == 0) li_l[r32] = l_reg; asm volatile("s_waitcnt lgkmcnt(0)" ::: "memory");
  float rli[16];
#pragma unroll
  for (int r = 0; r < 16; ++r) rli[r] = __builtin_amdgcn_rcpf(li_l[crow(r, hi)]);
  bf16_t* Ow = Ob + (long)(wid * QBLK) * ldo;
#pragma unroll
  for (int r = 0; r < 16; ++r) { const int orow = crow(r, hi);
#pragma unroll
    for (int d0 = 0; d0 < DV / 32; ++d0) Ow[(long)orow * ldo + d0 * 32 + r32] = (bf16_t)(cvtpk(o[d0][r] * rli[r], 0.f) & 0xffffu); }
  __syncthreads();
#undef SLOAD
#undef SWRITE
#undef SWAIT
#undef RESC
}
#undef SBAR

template <int DQK, int DV, bool QNORM>
__device__ __forceinline__ void attn_unit_naive(const bf16_t* Qb, int ldq, const bf16_t* Kh, int ldk, const bf16_t* Vh, int ldv, bf16_t* Ob, int ldo, int seq, float scale, const float* qgain, char* lds) {
  const int tid = threadIdx.x; float* ql = (float*)lds;
  if (tid < 256) {
    float ssq = 0.f;
    for (int d = 0; d < DQK; ++d) { const float v = pg8::bf2f(Qb[(long)tid * ldq + d]); ssq += v * v; }
    const float rs = QNORM ? 1.0f / sqrtf(ssq * (1.0f / DQK) + 1e-6f) : 1.f;
    for (int d = 0; d < DQK; ++d) { float v = pg8::bf2f(Qb[(long)tid * ldq + d]); if (QNORM) v = pg8::bf2f((bf16_t)(cvtpk(v * rs * qgain[d], 0.f) & 0xffffu)); ql[d * 256 + tid] = v; }
    float m = -1e30f, l = 0.f; float o[DV];
#pragma unroll
    for (int d = 0; d < DV; ++d) o[d] = 0.f;
    for (int k = 0; k < seq; ++k) { float s = 0.f;
      for (int d = 0; d < DQK; ++d) s += ql[d * 256 + tid] * pg8::bf2f(Kh[(long)k * ldk + d]);
      s *= scale; const float mn = fmaxf(m, s), al = __expf(m - mn), p = __expf(s - mn); l = l * al + p; m = mn;
#pragma unroll
      for (int d = 0; d < DV; ++d) o[d] = o[d] * al + p * pg8::bf2f(Vh[(long)k * ldv + d]); }
    const float il = 1.0f / l;
#pragma unroll
    for (int d = 0; d < DV; ++d) Ob[(long)tid * ldo + d] = (bf16_t)(cvtpk(o[d] * il, 0.f) & 0xffffu);
  }
  __syncthreads();
}
}

using pg8::bf16_t; using pg8::f32x4; using pg8::u32x4; using pg8::u32x2; using pg8::bf16x8; using pg8::bf2f; using pg8::bflo; using pg8::bfhi; using pg8::cvt_pk_bf16;
#define LAS __attribute__((address_space(3)))
constexpr int NBATCH = 2, SEQ = 8192, T = NBATCH * SEQ, DM = 1024, MEMLEN = 256, TM = NBATCH * MEMLEN;
constexpr int PROJ_LD = 1536, IN_COLS = 1440, DFF = 2816, DFF2 = 5632;
constexpr int NTHR = 512, NWAVES = 8;
constexpr float EPS = 1e-6f;
constexpr size_t MiB = 1u << 20;
constexpr size_t WS_SS = 1 * MiB, WS_WIN = 2 * MiB, WS_WUQ = 5 * MiB, WS_WUKV = 5 * MiB + 512 * 1024, WS_WG = 6 * MiB, WS_WOUT = 7 * MiB, WS_WMQ = 9 * MiB, WS_WMKV = 10 * MiB,
                 WS_WMO = 12 * MiB, WS_WUP = 13 * MiB, WS_WDN = 24 * MiB, WS_MEMN = 30 * MiB, WS_MEMKV = 31 * MiB, WS_XB = 32 * MiB, WS_KN = 32 * MiB, WS_AGG = 56 * MiB,
                 WS_PROJ = 64 * MiB, WS_CQ = 112 * MiB, WS_CKV = 120 * MiB, WS_XC = 124 * MiB, WS_QRAW = 156 * MiB, WS_KVRAW = 180 * MiB, WS_QN = 112 * MiB, WS_MLA = 136 * MiB,
                 WS_AMIX = 156 * MiB, WS_QMEM = 112 * MiB, WS_OMEM = 128 * MiB, WS_GU = 64 * MiB, WS_HID = 152 * MiB, WS_END = 240 * MiB;
constexpr int LDS_BYTES = 147456, LDSCTL_OFF = 131072, MISC_OFF = LDSCTL_OFF + 320;
constexpr size_t WS_BAR = 65536, BAR_ZERO_BYTES = 16384;

struct Args { const void* in[33]; float* out; unsigned char* ws; int ph_lo, ph_hi; };

struct Ctx {
    LAS unsigned char* lds; char* ldsg;
    int tid, lane, wave, bid, G;
};
#define WSP(type, off) ((type*)(args.ws + (off)))

#define XB_TMO      128
#define XB_XCNT(j)  (256  + 64 * (j))
#define XB_XSUB(j)  (1280 + 64 * (j))
#define XB_XGEN(j)  (2304 + 64 * (j))
#define XB_TOP      3328
#define XB_TOPGEN   3392
#define XCD_BAR_WORDS 3456
#define XB_SPIN_CAP (1u << 18)

__device__ __forceinline__ unsigned xb_ld(unsigned* p)              { return __hip_atomic_load(p, __ATOMIC_RELAXED, __HIP_MEMORY_SCOPE_AGENT); }
__device__ __forceinline__ unsigned xb_add(unsigned* p, unsigned v) { return __hip_atomic_fetch_add(p, v, __ATOMIC_RELAXED, __HIP_MEMORY_SCOPE_AGENT); }
__device__ __forceinline__ unsigned xb_xcc_id() { return (unsigned)__builtin_amdgcn_s_getreg((3 << 11) | 20) & 0xFu; }
#define XB_SPIN(cond, bar) do { unsigned _sp = 0; while (cond) { __builtin_amdgcn_s_sleep(1); \
    if ((++_sp & 255u) == 0u) { if (xb_ld(&(bar)[XB_TMO])) break; if (_sp > XB_SPIN_CAP) { atomicAdd(&(bar)[XB_TMO], 1u); break; } } } } while (0)

struct XcdBarrier {
    unsigned* bar; unsigned x;
    volatile LAS unsigned* st;
};

__device__ __forceinline__ XcdBarrier xcd_barrier_post(unsigned* bar, volatile LAS unsigned* st) {
    XcdBarrier b; b.bar = bar; b.x = xb_xcc_id(); b.st = st;
    if (threadIdx.x == 0) (void)xb_add(&bar[XB_XCNT(b.x)], 1u);
    return b;
}
__device__ __forceinline__ void xcd_barrier_complete(unsigned* bar, unsigned x, unsigned& nloc, unsigned& nx) {
    const unsigned G = gridDim.x * gridDim.y * gridDim.z;
    unsigned sum, cnt, mine, sp = 0u;
    for (;;) {
        sum = 0u; cnt = 0u; mine = 0u;
#pragma unroll
        for (unsigned j = 0; j < 16; ++j) { const unsigned c = xb_ld(&bar[XB_XCNT(j)]); sum += c; cnt += (c > 0u) ? 1u : 0u; mine = (j == x) ? c : mine; }
        if (sum == G) break;
        __builtin_amdgcn_s_sleep(1);
        if ((++sp & 255u) == 0u) { if (xb_ld(&bar[XB_TMO])) break; if (sp > XB_SPIN_CAP) { atomicAdd(&bar[XB_TMO], 1u); break; } }
    }
    nloc = mine > 0u ? mine : 1u; nx = cnt > 0u ? cnt : 1u;
}

__device__ __forceinline__ void xcd_barrier(const XcdBarrier& b) {
    asm volatile("s_waitcnt vmcnt(0)" ::: "memory");
    __syncthreads();
    if (threadIdx.x == 0) {
        unsigned* bar = b.bar;
        __builtin_amdgcn_s_waitcnt(0);
        unsigned nloc = b.st[0], nx = b.st[1];
        if (nloc == 0u) { xcd_barrier_complete(bar, b.x, nloc, nx); b.st[0] = nloc; b.st[1] = nx; }
        const unsigned old = xb_add(&bar[XB_XSUB(b.x)], 1u);
        const unsigned gen = old / nloc;
        if (old + 1u == (gen + 1u) * nloc) {
            __builtin_amdgcn_fence(__ATOMIC_RELEASE, "agent");
            asm volatile("s_waitcnt vmcnt(0)" ::: "memory");
            const unsigned og = xb_add(&bar[XB_TOP], 1u);
            const unsigned tg = og / nx;
            if (og + 1u == (tg + 1u) * nx) xb_add(&bar[XB_TOPGEN], 1u);
            else XB_SPIN(xb_ld(&bar[XB_TOPGEN]) == tg, bar);
            __builtin_amdgcn_fence(__ATOMIC_ACQUIRE, "agent");
            xb_add(&bar[XB_XGEN(b.x)], 1u);
            asm volatile("s_waitcnt vmcnt(0)" ::: "memory");
        } else {
            XB_SPIN(xb_ld(&bar[XB_XGEN(b.x)]) == gen, bar);
            __builtin_amdgcn_fence(__ATOMIC_ACQUIRE, "agent");
            asm volatile("s_waitcnt vmcnt(0)" ::: "memory");
        }
    }
    __syncthreads();
}


__device__ __forceinline__ float wave_sum(float v) {
#pragma unroll
    for (int o = 1; o < 64; o <<= 1) v += __shfl_xor(v, o);
    return v;
}
__device__ __forceinline__ u32x4 pack8(const float* v) { u32x4 w; w.x = cvt_pk_bf16(v[0], v[1]); w.y = cvt_pk_bf16(v[2], v[3]); w.z = cvt_pk_bf16(v[4], v[5]); w.w = cvt_pk_bf16(v[6], v[7]); return w; }
__device__ __forceinline__ void unpack8(const u32x4 w, float* v) { v[0] = bflo(w.x); v[1] = bfhi(w.x); v[2] = bflo(w.y); v[3] = bfhi(w.y); v[4] = bflo(w.z); v[5] = bfhi(w.z); v[6] = bflo(w.w); v[7] = bfhi(w.w); }

__device__ __forceinline__ void p0_transpose_item(const float* W, const float* gain, int K, int N, bf16_t* WT, LAS float* scr, int item, int lane) {
    const int nblk = N / 32, kb = item / nblk, nb = item % nblk, k0 = 64 * kb, n0 = 32 * nb;
#pragma unroll 8
    for (int i = 0; i < 32; ++i) { const int kk = 2 * i + (lane >> 5); float v = W[(size_t)(k0 + kk) * N + n0 + (lane & 31)]; if (gain) v *= gain[k0 + kk]; scr[kk * 33 + (lane & 31)] = v; }
    asm volatile("s_waitcnt lgkmcnt(0)" ::: "memory");
    const int cch = lane & 7;
#pragma unroll
    for (int j = 0; j < 4; ++j) { const int n = (lane >> 3) + 8 * j; const LAS float* s = scr + (8 * cch) * 33 + n;
        u32x4 o; o.x = cvt_pk_bf16(s[0 * 33], s[1 * 33]); o.y = cvt_pk_bf16(s[2 * 33], s[3 * 33]); o.z = cvt_pk_bf16(s[4 * 33], s[5 * 33]); o.w = cvt_pk_bf16(s[6 * 33], s[7 * 33]);
        *(u32x4*)(WT + (size_t)(n0 + n) * K + k0 + 8 * cch) = o; }
    asm volatile("s_waitcnt lgkmcnt(0)" ::: "memory");
}
__device__ __forceinline__ void norm_row_1024(const float* xrow, const float* gain, bf16_t* orow, int lane) {
    const f32x4* xr = (const f32x4*)xrow + lane; const f32x4* gr = (const f32x4*)gain + lane;
    f32x4 v[4]; float s = 0.f;
#pragma unroll
    for (int j = 0; j < 4; ++j) { v[j] = xr[64 * j]; s += (v[j][0] * v[j][0] + v[j][1] * v[j][1]) + (v[j][2] * v[j][2] + v[j][3] * v[j][3]); }
    const float rs = 1.0f / sqrtf(wave_sum(s) * (1.0f / 1024.0f) + EPS);
#pragma unroll
    for (int j = 0; j < 4; ++j) { const f32x4 g = gr[64 * j]; u32x2 w; w.x = cvt_pk_bf16(v[j][0] * rs * g[0], v[j][1] * rs * g[1]); w.y = cvt_pk_bf16(v[j][2] * rs * g[2], v[j][3] * rs * g[3]);
        *((u32x2*)orow + lane + 64 * j) = w; }
}
__device__ __forceinline__ void phase0(Ctx& c, const Args& args) {
    LAS float* scr = (LAS float*)(c.lds + c.wave * 16384);
    const int gw = c.bid * NWAVES + c.wave, NGW = c.G * NWAVES;
    constexpr int I_IN = 16 * 45, I_UQ = 4 * 24, I_UKV = 2 * 32, I_OUT = 16 * 32, I_MQ = 16 * 16, I_MKV = 16 * 32, I_MO = 8 * 32, I_UP = 16 * 176, I_DN = 44 * 32;
    constexpr int NITEMS = I_IN + I_UQ + I_UKV + I_OUT + I_MQ + I_MKV + I_MO + I_UP + I_DN;
    for (int it = gw; it < NITEMS; it += NGW) {
        int r = it;
        if (r < I_IN) { p0_transpose_item(((const float*)args.in[4]), nullptr, 1024, IN_COLS, WSP(bf16_t, WS_WIN), scr, r, c.lane); continue; } r -= I_IN;
        if (r < I_UQ) { p0_transpose_item(((const float*)args.in[13]), nullptr, 256, 768, WSP(bf16_t, WS_WUQ), scr, r, c.lane); continue; } r -= I_UQ;
        if (r < I_UKV) { p0_transpose_item(((const float*)args.in[15]), nullptr, 128, 1024, WSP(bf16_t, WS_WUKV), scr, r, c.lane); continue; } r -= I_UKV;
        if (r < I_OUT) { p0_transpose_item(((const float*)args.in[20]), nullptr, 1024, 1024, WSP(bf16_t, WS_WOUT), scr, r, c.lane); continue; } r -= I_OUT;
        if (r < I_MQ) { p0_transpose_item(((const float*)args.in[23]), ((const float*)args.in[21]), 1024, 512, WSP(bf16_t, WS_WMQ), scr, r, c.lane); continue; } r -= I_MQ;
        if (r < I_MKV) { p0_transpose_item(((const float*)args.in[24]), nullptr, 1024, 1024, WSP(bf16_t, WS_WMKV), scr, r, c.lane); continue; } r -= I_MKV;
        if (r < I_MO) { p0_transpose_item(((const float*)args.in[27]), nullptr, 512, 1024, WSP(bf16_t, WS_WMO), scr, r, c.lane); continue; } r -= I_MO;
        if (r < I_UP) { p0_transpose_item(((const float*)args.in[29]), ((const float*)args.in[28]), 1024, DFF2, WSP(bf16_t, WS_WUP), scr, r, c.lane); continue; } r -= I_UP;
        p0_transpose_item(((const float*)args.in[32]), nullptr, DFF, 1024, WSP(bf16_t, WS_WDN), scr, r, c.lane);
    }
    const int gt = c.bid * NTHR + c.tid, NGT = c.G * NTHR;
    for (int i = gt; i < (PROJ_LD - IN_COLS) * 1024 / 8; i += NGT) *((u32x4*)(WSP(bf16_t, WS_WIN) + (size_t)IN_COLS * 1024) + i) = (u32x4){0u, 0u, 0u, 0u};
    for (int i = gt; i < 8 * 256 * 128; i += NGT) {
        const int k = i & 127, n = (i >> 7) & 255, grp = i >> 15, d = grp >> 2, png = grp & 3;
        const int gate = n >> 7, cl = n & 127, blk_n = cl >> 6, dout = cl & 63, blk_k = k >> 6, cin = k & 63;
        float v = 0.f;
        if (blk_n == blk_k) { const float* W = gate ? ((const float*)args.in[9]) : ((const float*)args.in[7]); v = W[((size_t)(d * 8 + png * 2 + blk_n) * 64 + cin) * 64 + dout]; }
        WSP(bf16_t, WS_WG)[i] = (bf16_t)(cvt_pk_bf16(v, 0.f) & 0xffffu);
    }
    for (int i = gt; i < 1024; i += NGT) WSP(float, 0)[i] = -8.0f * log1pf(expf(-((const float*)args.in[11])[i]));
    for (int m = gw; m < T + TM; m += NGW) {
        if (m < T) norm_row_1024(((const float*)args.in[0]) + (size_t)m * DM, ((const float*)args.in[3]), WSP(bf16_t, WS_XB) + (size_t)m * DM, c.lane);
        else norm_row_1024(((const float*)args.in[1]) + (size_t)(m - T) * DM, ((const float*)args.in[22]), WSP(bf16_t, WS_MEMN) + (size_t)(m - T) * DM, c.lane);
    }
}

__device__ __forceinline__ void phase2(Ctx& c, const Args& args) {
    const int gw = c.bid * NWAVES + c.wave, NGW = c.G * NWAVES, lane = c.lane;
    const bf16_t* proj = WSP(bf16_t, WS_PROJ);
    for (int row = gw; row < T + TM; row += NGW) {
        if (row >= T) {
            bf16_t* kp = WSP(bf16_t, WS_MEMKV) + (size_t)(row - T) * 1024 + lane * 8; float v[8]; unpack8(*(const u32x4*)kp, v);
            float s = 0.f;
#pragma unroll
            for (int e = 0; e < 8; ++e) s += v[e] * v[e];
            s += __shfl_xor(s, 1); s += __shfl_xor(s, 2); s += __shfl_xor(s, 4); s += __shfl_xor(s, 8);
            const float rs = 1.0f / sqrtf(s * (1.0f / 128.0f) + EPS);
#pragma unroll
            for (int e = 0; e < 8; ++e) v[e] *= rs * ((const float*)args.in[26])[(lane & 15) * 8 + e];
            *(u32x4*)kp = pack8(v);
            continue;
        }
        const bf16_t* pr = proj + (size_t)row * PROJ_LD;
        {
            const u32x2 w = *(const u32x2*)(pr + 1024 + lane * 4); float v[4] = {bflo(w.x), bfhi(w.x), bflo(w.y), bfhi(w.y)};
            const float rs = 1.0f / sqrtf(wave_sum((v[0] * v[0] + v[1] * v[1]) + (v[2] * v[2] + v[3] * v[3])) * (1.0f / 256.0f) + EPS);
            const f32x4 g = *(const f32x4*)(((const float*)args.in[12]) + lane * 4); u32x2 o; o.x = cvt_pk_bf16(v[0] * rs * g[0], v[1] * rs * g[1]); o.y = cvt_pk_bf16(v[2] * rs * g[2], v[3] * rs * g[3]);
            *(u32x2*)(WSP(bf16_t, WS_CQ) + (size_t)row * 256 + lane * 4) = o;
        }
        {
            const unsigned w = *(const unsigned*)(pr + 1280 + lane * 2); const float v0 = bflo(w), v1 = bfhi(w);
            const float rs = 1.0f / sqrtf(wave_sum(v0 * v0 + v1 * v1) * (1.0f / 128.0f) + EPS);
            *(unsigned*)(WSP(bf16_t, WS_CKV) + (size_t)row * 128 + lane * 2) = cvt_pk_bf16(v0 * rs * ((const float*)args.in[14])[lane * 2], v1 * rs * ((const float*)args.in[14])[lane * 2 + 1]);
        }
        {
            const int t = row & (SEQ - 1), ch = lane * 8;
            float xs[7][8];
#pragma unroll
            for (int dt = -3; dt <= 3; ++dt) { const int tt = t + dt;
                if (tt >= 0 && tt < SEQ) unpack8(*(const u32x4*)(pr + (long)dt * PROJ_LD + ch), xs[dt + 3]);
                else {
#pragma unroll
                    for (int e = 0; e < 8; ++e) xs[dt + 3][e] = 0.f; } }
            float of[8], ob[8];
#pragma unroll
            for (int e = 0; e < 8; ++e) { of[e] = ((const float*)args.in[6])[ch + e]; ob[e] = ((const float*)args.in[6])[512 + ch + e]; }
#pragma unroll
            for (int k = 0; k < 4; ++k)
#pragma unroll
                for (int e = 0; e < 8; ++e) { of[e] += ((const float*)args.in[5])[(0 * 4 + k) * 512 + ch + e] * xs[k][e]; ob[e] += ((const float*)args.in[5])[(1 * 4 + k) * 512 + ch + e] * xs[3 + k][e]; }
            *(u32x4*)(WSP(bf16_t, WS_XC) + (size_t)row * 512 + ch) = pack8(of);
            *(u32x4*)(WSP(bf16_t, WS_XC) + ((size_t)T + row) * 512 + ch) = pack8(ob);
        }
    }
}

__device__ __forceinline__ void phase4(Ctx& c, const Args& args) {
    const int gw = c.bid * NWAVES + c.wave, NGW = c.G * NWAVES, lane = c.lane, h = lane >> 3, sub = lane & 7;
    const bf16_t* proj = WSP(bf16_t, WS_PROJ); const bf16_t* qraw = WSP(bf16_t, WS_QRAW); const bf16_t* kvraw = WSP(bf16_t, WS_KVRAW);
    bf16_t* Qn = WSP(bf16_t, WS_QN); bf16_t* Kn = WSP(bf16_t, WS_KN);
    for (int row = gw; row < T; row += NGW) {
        const float posf = (float)((const int*)args.in[2])[row]; float cs[2], sn[2];
#pragma unroll
        for (int jj = 0; jj < 2; ++jj) { const int j = 2 * sub + jj; const float inv = exp2f(-(float)j * 0.8304820237218406f);
            const float ang = posf * inv; const double rev = (double)ang * 0.15915494309189535; const float fr = (float)(rev - rint(rev));
            cs[jj] = __builtin_amdgcn_cosf(fr); sn[jj] = __builtin_amdgcn_sinf(fr); }
#pragma unroll
        for (int which = 0; which < 2; ++which) {
            const bf16_t* np = which ? kvraw + (size_t)row * 1024 + h * 128 + sub * 8 : qraw + (size_t)row * 768 + h * 96 + sub * 8;
            const bf16_t* rp = which ? proj + (size_t)row * PROJ_LD + 1408 + 2 * sub : qraw + (size_t)row * 768 + h * 96 + 64 + 2 * sub;
            const float* gain = which ? ((const float*)args.in[17]) : ((const float*)args.in[16]);
            float v[8]; unpack8(*(const u32x4*)np, v); const unsigned r1 = *(const unsigned*)rp, r2 = *(const unsigned*)(rp + 16);
            float t1[2] = {bflo(r1), bfhi(r1)}, t2[2] = {bflo(r2), bfhi(r2)};
            float s = (t1[0] * t1[0] + t1[1] * t1[1]) + (t2[0] * t2[0] + t2[1] * t2[1]);
#pragma unroll
            for (int e = 0; e < 8; ++e) s += v[e] * v[e];
            s += __shfl_xor(s, 1); s += __shfl_xor(s, 2); s += __shfl_xor(s, 4);
            const float rs = (which ? 1.0f : 0.14724444305f) / sqrtf(s * (1.0f / 96.0f) + EPS);
#pragma unroll
            for (int e = 0; e < 8; ++e) v[e] *= rs * gain[sub * 8 + e];
#pragma unroll
            for (int jj = 0; jj < 2; ++jj) { t1[jj] *= rs * gain[64 + 2 * sub + jj]; t2[jj] *= rs * gain[80 + 2 * sub + jj]; }
            float o1[2], o2[2];
#pragma unroll
            for (int jj = 0; jj < 2; ++jj) { o1[jj] = t1[jj] * cs[jj] - t2[jj] * sn[jj]; o2[jj] = t1[jj] * sn[jj] + t2[jj] * cs[jj]; }
            bf16_t* op = (which ? Kn : Qn) + (size_t)row * 768 + h * 96;
            *(u32x4*)(op + sub * 8) = pack8(v);
            *(unsigned*)(op + 64 + 2 * sub) = cvt_pk_bf16(o1[0], o1[1]);
            *(unsigned*)(op + 80 + 2 * sub) = cvt_pk_bf16(o2[0], o2[1]);
        }
    }
    const unsigned* Gt = (const unsigned*)args.out; float2* agg = WSP(float2, WS_AGG);
    for (int it = c.bid; it < 512; it += c.G) {
        const int d = it >> 8, chunk = it & 255; const unsigned* gp = Gt + ((size_t)d * T + (size_t)chunk * 64) * 512 + c.tid;
        float sl = 0.f, bv = 0.f; unsigned wv[64];
#pragma unroll
        for (int i = 0; i < 64; ++i) wv[i] = gp[(size_t)(d ? 63 - i : i) * 512];
#pragma unroll
        for (int i = 0; i < 64; ++i) { const float la = bflo(wv[i]); sl += la; bv = __expf(la) * bv + bfhi(wv[i]); }
        agg[(size_t)it * 512 + c.tid] = make_float2(sl, bv);
    }
}

__device__ __forceinline__ float gelu_tanh(float y) { const float u = 0.7978845608028654f * (y + 0.044715f * y * y * y); const float th = 1.0f - 2.0f / (__expf(2.0f * u) + 1.0f); return 0.5f * y * (1.0f + th); }
__device__ __forceinline__ void phase6(Ctx& c, const Args& args) {
    const unsigned* Gt = (const unsigned*)args.out; const float2* agg = WSP(float2, WS_AGG); const bf16_t* proj = WSP(bf16_t, WS_PROJ);
    LAS float* hl = (LAS float*)c.lds;
    bf16_t* amix = WSP(bf16_t, WS_AMIX); const bf16_t* mla = WSP(bf16_t, WS_MLA);
    const int ch = c.tid;
    for (int chunk = c.bid; chunk < 256; chunk += c.G) {
        const int b = chunk >> 7, cc = chunk & 127;
        float cf = 0.f, cb = 0.f;
#pragma unroll 1
        for (int q0 = 0; q0 < 128; q0 += 32) {
            float2 af[32], ab[32];
#pragma unroll
            for (int k = 0; k < 32; ++k) { af[k] = agg[((size_t)b * 128 + q0 + k) * 512 + ch]; ab[k] = agg[((size_t)256 + b * 128 + 127 - (q0 + k)) * 512 + ch]; }
#pragma unroll
            for (int k = 0; k < 32; ++k) { const int q = q0 + k; if (q < cc) cf = __expf(af[k].x) * cf + af[k].y; if (127 - q > cc) cb = __expf(ab[k].x) * cb + ab[k].y; }
        }
        const size_t row0 = (size_t)chunk * 64;
        { const unsigned* gp = Gt + row0 * 512 + ch; float hcur = cf;
#pragma unroll 1
          for (int i0 = 0; i0 < 64; i0 += 32) { unsigned wv[32];
#pragma unroll
              for (int k = 0; k < 32; ++k) wv[k] = gp[(size_t)(i0 + k) * 512];
#pragma unroll
              for (int k = 0; k < 32; ++k) { hcur = __expf(bflo(wv[k])) * hcur + bfhi(wv[k]); hl[(i0 + k) * 512 + ch] = hcur; } } }
        { const unsigned* gp = Gt + ((size_t)T + row0) * 512 + ch; const bf16_t* yp = proj + row0 * PROJ_LD + 512 + ch; float hcur = cb;
#pragma unroll 1
          for (int i0 = 63; i0 >= 0; i0 -= 32) { unsigned wv[32]; bf16_t yv[32];
#pragma unroll
              for (int k = 0; k < 32; ++k) { wv[k] = gp[(size_t)(i0 - k) * 512]; yv[k] = yp[(size_t)(i0 - k) * PROJ_LD]; }
#pragma unroll
              for (int k = 0; k < 32; ++k) { const int i = i0 - k; hcur = __expf(bflo(wv[k])) * hcur + bfhi(wv[k]); hl[i * 512 + ch] = (hl[i * 512 + ch] + hcur) * gelu_tanh(bf2f(yv[k])); } } }
        __syncthreads();
#pragma unroll
        for (int rr = 0; rr < 8; ++rr) { const int r = c.wave * 8 + rr; const size_t row = row0 + r;
            float v[8]; { const LAS f32x4* p = (const LAS f32x4*)(hl + r * 512 + c.lane * 8); const f32x4 a = p[0], bq = p[1]; v[0] = a[0]; v[1] = a[1]; v[2] = a[2]; v[3] = a[3]; v[4] = bq[0]; v[5] = bq[1]; v[6] = bq[2]; v[7] = bq[3]; }
            float s = 0.f;
#pragma unroll
            for (int e = 0; e < 8; ++e) s += v[e] * v[e];
            float rs = 1.0f / sqrtf(wave_sum(s) * (1.0f / 512.0f) + EPS);
#pragma unroll
            for (int e = 0; e < 8; ++e) v[e] *= rs * ((const float*)args.in[18])[c.lane * 8 + e];
            *(u32x4*)(amix + row * 1024 + c.lane * 8) = pack8(v);
            unpack8(*(const u32x4*)(mla + row * 512 + c.lane * 8), v); s = 0.f;
#pragma unroll
            for (int e = 0; e < 8; ++e) s += v[e] * v[e];
            rs = 1.0f / sqrtf(wave_sum(s) * (1.0f / 512.0f) + EPS);
#pragma unroll
            for (int e = 0; e < 8; ++e) v[e] *= rs * ((const float*)args.in[19])[c.lane * 8 + e];
            *(u32x4*)(amix + row * 1024 + 512 + c.lane * 8) = pack8(v);
        }
        __syncthreads();
    }
}

typedef float f32x2 __attribute__((ext_vector_type(2)));
__device__ __forceinline__ void unpack8v(const u32x4 w, f32x2* v) { v[0] = (f32x2){bflo(w.x), bfhi(w.x)}; v[1] = (f32x2){bflo(w.y), bfhi(w.y)}; v[2] = (f32x2){bflo(w.z), bfhi(w.z)}; v[3] = (f32x2){bflo(w.w), bfhi(w.w)}; }
__device__ __forceinline__ void phase12(Ctx& c, const Args& args, int bsel) {
    const bf16_t* __restrict__ gu = WSP(bf16_t, WS_GU); bf16_t* __restrict__ hid = WSP(bf16_t, WS_HID) + (size_t)bsel * SEQ * DFF;
    const float* __restrict__ cw = ((const float*)args.in[30]); const float* __restrict__ cb = ((const float*)args.in[31]);
    if (c.tid >= DFF / 8) return;
    const int j = c.tid * 8;
    f32x2 wg[3][4], wu[3][4], bg[4], bu[4];
#pragma unroll
    for (int e = 0; e < 4; ++e) { bg[e] = *(const f32x2*)(cb + j + 2 * e); bu[e] = *(const f32x2*)(cb + DFF + j + 2 * e);
#pragma unroll
        for (int k = 0; k < 3; ++k) { wg[k][e] = *(const f32x2*)(cw + (size_t)k * DFF2 + j + 2 * e); wu[k][e] = *(const f32x2*)(cw + (size_t)k * DFF2 + DFF + j + 2 * e); } }
    for (int chunk = c.bid; chunk < SEQ / 32; chunk += c.G) {
        const int t0 = chunk * 32;
        u32x4 rg[4], ru[4];
        const u32x4 z4 = (u32x4){0u, 0u, 0u, 0u};
#define P12_LOAD(s, k) do { const int tt_ = t0 - 1 + (s); if (tt_ >= 0 && tt_ < SEQ && (s) < 34) { rg[k] = *(const u32x4*)(gu + (size_t)tt_ * DFF2 + j); ru[k] = *(const u32x4*)(gu + (size_t)tt_ * DFF2 + DFF + j); } else { rg[k] = z4; ru[k] = z4; } } while (0)
#pragma unroll
        for (int k = 0; k < 4; ++k) P12_LOAD(k, k);
        f32x2 wing[3][4], winu[3][4];
#pragma unroll 1
        for (int s0 = 0; s0 < 36; s0 += 12) {
#pragma unroll
            for (int k = 0; k < 12; ++k) { const int s = s0 + k; constexpr int dummy = 0; (void)dummy;
                const int sn = k % 3, sq = (k + 2) % 3, sp = (k + 1) % 3;
                unpack8v(rg[k & 3], wing[sn]); unpack8v(ru[k & 3], winu[sn]);
                P12_LOAD(s + 4, k & 3);
                if (s >= 2 && s < 34) { u32x4 o; unsigned ow[4];
#pragma unroll
                    for (int e = 0; e < 4; ++e) { const f32x2 G = bg[e] + wg[0][e] * wing[sp][e] + wg[1][e] * wing[sq][e] + wg[2][e] * wing[sn][e]; const f32x2 U = bu[e] + wu[0][e] * winu[sp][e] + wu[1][e] * winu[sq][e] + wu[2][e] * winu[sn][e];
                        const f32x2 a = G * (-1.4426950408889634f); f32x2 d; d.x = __builtin_amdgcn_exp2f(a.x); d.y = __builtin_amdgcn_exp2f(a.y); d = d + 1.0f;
                        f32x2 r; r.x = __builtin_amdgcn_rcpf(d.x); r.y = __builtin_amdgcn_rcpf(d.y); const f32x2 h = G * r * U; ow[e] = cvt_pk_bf16(h.x, h.y); }
                    o.x = ow[0]; o.y = ow[1]; o.z = ow[2]; o.w = ow[3];
                    *(u32x4*)(hid + (size_t)(t0 + s - 2) * DFF + j) = o; } }
        }
#undef P12_LOAD
    }
}

template <class Epi, class Sched> __device__ __forceinline__ void run_gemm(Ctx& c, const pg8::Gemm g, const Sched& S, const Epi& E) {
#if FAST_GEMM
    pg8::gemm_phase<Epi, Sched, true, true>(c.lds, g, S, E);
#else
    pg8::gemm_naive<Epi, Sched>(g, S, E);
#endif
}
__device__ __forceinline__ pg8::Sched2 sched1(Ctx& c, const void* A, const void* B, int nM, int nN, int lda, int ldb) {
    pg8::Sched2 s; s.a = pg8::Job{(const char*)A, (const char*)B, nM, nN}; s.b = pg8::Job{nullptr, nullptr, 0, 0}; s.G = c.G; s.c = c.bid; s.lda = lda; s.ldb = ldb; return s;
}
template <int DQK, int DV, bool QNORM, bool FIXED> __device__ __forceinline__ void run_attn(Ctx& c, const bf16_t* Qb, int ldq, const bf16_t* Kh, int ldk, const bf16_t* Vh, int ldv, bf16_t* Ob, int ldo, int seq, float scale, const float* qg) {
#if FAST_ATTN
    att::attn_unit<DQK, DV, QNORM, FIXED>(Qb, ldq, Kh, ldk, Vh, ldv, Ob, ldo, seq, scale, qg, c.ldsg);
#else
    att::attn_unit_naive<DQK, DV, QNORM>(Qb, ldq, Kh, ldk, Vh, ldv, Ob, ldo, seq, scale, qg, c.ldsg);
#endif
}

__device__ __forceinline__ void ph1(Ctx& c, const Args& args) {
    pg8::Sched2 S; S.a = pg8::Job{(const char*)WSP(bf16_t, WS_XB), (const char*)WSP(bf16_t, WS_WIN), T / 256, PROJ_LD / 256};
    S.b = pg8::Job{(const char*)WSP(bf16_t, WS_MEMN), (const char*)WSP(bf16_t, WS_WMKV), TM / 256, 4}; S.G = c.G; S.c = c.bid; S.lda = 1024; S.ldb = 1024;
    pg8::EpiBf<false> E{WSP(bf16_t, WS_PROJ), PROJ_LD, WSP(bf16_t, WS_MEMKV), 1024, nullptr};
    run_gemm(c, pg8::Gemm{1024, 1024, 1024}, S, E);
}
__device__ __forceinline__ void ph3(Ctx& c, const Args& args) {
    { pg8::Sched2 S = sched1(c, WSP(bf16_t, WS_CQ), WSP(bf16_t, WS_WUQ), T / 256, 3, 256, 256); pg8::EpiBf<false> E{WSP(bf16_t, WS_QRAW), 768, nullptr, 0, nullptr}; run_gemm(c, pg8::Gemm{256, 256, 256}, S, E); }
    { pg8::Sched2 S = sched1(c, WSP(bf16_t, WS_CKV), WSP(bf16_t, WS_WUKV), T / 256, 4, 128, 128); pg8::EpiBf<false> E{WSP(bf16_t, WS_KVRAW), 1024, nullptr, 0, nullptr}; run_gemm(c, pg8::Gemm{128, 128, 128}, S, E); }
    { pg8::GateOrder S{(const char*)WSP(bf16_t, WS_XC), (const char*)WSP(bf16_t, WS_WG), (size_t)T * 512 * 2, c.G, c.bid};
      pg8::EpiGates E{WSP(bf16_t, WS_XC), ((const float*)args.in[8]), ((const float*)args.in[10]), WSP(float, 0), (unsigned*)args.out, T}; run_gemm(c, pg8::Gemm{128, 512, 128}, S, E); }
}
__device__ __forceinline__ void ph5(Ctx& c, const Args& args) {
    float gq = 0.f, gk = 0.f;
    for (int i = c.lane; i < 96; i += 64) { gq = fmaxf(gq, fabsf(((const float*)args.in[16])[i])); gk = fmaxf(gk, fabsf(((const float*)args.in[17])[i])); }
#pragma unroll
    for (int o = 1; o < 64; o <<= 1) { gq = fmaxf(gq, __shfl_xor(gq, o)); gk = fmaxf(gk, __shfl_xor(gk, o)); }
    const bool bounded = __builtin_amdgcn_readfirstlane((int)(9.797958971f * 1.02f * gq * gk * 1.4426950408889634f <= 60.0f)) != 0;
    for (int L = c.bid; L < 512; L += c.G) { const int bh = (L >> 8) * 8 + (L & 7), qb = (L & 255) >> 3; const int b = bh >> 3, h = bh & 7;
        const bf16_t* Qp = WSP(bf16_t, WS_QN) + ((size_t)b * SEQ + qb * 256) * 768 + h * 96; const bf16_t* Kp = WSP(bf16_t, WS_KN) + (size_t)b * SEQ * 768 + h * 96;
        const bf16_t* Vp = WSP(bf16_t, WS_KVRAW) + (size_t)b * SEQ * 1024 + h * 128 + 64; bf16_t* Op = WSP(bf16_t, WS_MLA) + ((size_t)b * SEQ + qb * 256) * 512 + h * 64;
        if (bounded) run_attn<96, 64, false, true>(c, Qp, 768, Kp, 768, Vp, 1024, Op, 512, SEQ, 0.10206207261596575f, nullptr);
        else run_attn<96, 64, false, false>(c, Qp, 768, Kp, 768, Vp, 1024, Op, 512, SEQ, 0.10206207261596575f, nullptr); }
}
__device__ __forceinline__ void ph7(Ctx& c, const Args& args) {
    pg8::Sched2 S = sched1(c, WSP(bf16_t, WS_AMIX), WSP(bf16_t, WS_WOUT), T / 256, 4, 1024, 1024); pg8::EpiResid<true> E{((const float*)args.in[0]), args.out, WSP(bf16_t, WS_XB), WSP(float, WS_SS)};
    run_gemm(c, pg8::Gemm{1024, 1024, 1024}, S, E);
}
__device__ __forceinline__ void ph8(Ctx& c, const Args& args) {
    pg8::Sched2 S = sched1(c, WSP(bf16_t, WS_XB), WSP(bf16_t, WS_WMQ), T / 256, 2, 1024, 1024); pg8::EpiBf<true> E{WSP(bf16_t, WS_QMEM), 512, nullptr, 0, WSP(float, WS_SS)};
    run_gemm(c, pg8::Gemm{1024, 1024, 1024}, S, E);
}
__device__ __forceinline__ void ph9(Ctx& c, const Args& args) {
    for (int L = c.bid; L < 256; L += c.G) { const int rb = L >> 2, h = L & 3, b = rb >> 5;
        run_attn<128, 128, true, false>(c, WSP(bf16_t, WS_QMEM) + (size_t)rb * 256 * 512 + h * 128, 512, WSP(bf16_t, WS_MEMKV) + (size_t)b * MEMLEN * 1024 + h * 128, 1024,
                                 WSP(bf16_t, WS_MEMKV) + (size_t)b * MEMLEN * 1024 + 512 + h * 128, 1024, WSP(bf16_t, WS_OMEM) + (size_t)rb * 256 * 512 + h * 128, 512, MEMLEN, 0.08838834764831845f, ((const float*)args.in[25])); }
}
__device__ __forceinline__ void ph10(Ctx& c, const Args& args) {
    pg8::Sched2 S = sched1(c, WSP(bf16_t, WS_OMEM), WSP(bf16_t, WS_WMO), T / 256, 4, 512, 512); pg8::EpiResid<true> E{args.out, args.out, WSP(bf16_t, WS_XB), WSP(float, WS_SS)};
    run_gemm(c, pg8::Gemm{512, 512, 512}, S, E);
}
__device__ __forceinline__ void ph11(Ctx& c, const Args& args, int bsel) {
    pg8::Sched2 S = sched1(c, WSP(bf16_t, WS_XB) + (size_t)bsel * SEQ * 1024, WSP(bf16_t, WS_WUP), SEQ / 256, DFF2 / 256, 1024, 1024);
    pg8::EpiBf<true> E{WSP(bf16_t, WS_GU), DFF2, nullptr, 0, WSP(float, WS_SS) + (size_t)bsel * SEQ * 16};
    run_gemm(c, pg8::Gemm{1024, 1024, 1024}, S, E);
}
__device__ __forceinline__ void ph15(Ctx& c, const Args& args) {
    pg8::Sched2 S = sched1(c, WSP(bf16_t, WS_HID), WSP(bf16_t, WS_WDN), T / 256, 4, DFF, DFF); pg8::EpiResid<false> E{args.out, args.out, nullptr, nullptr};
    run_gemm(c, pg8::Gemm{DFF, DFF, DFF}, S, E);
}

constexpr int N_PHASES = 16;
#ifndef PH_MASK
#define PH_MASK 0xFFFF
#endif
#ifndef DUP_MASK
#define DUP_MASK 0
#endif
#ifndef EXTRA_SYNCS
#define EXTRA_SYNCS 0
#endif
__global__ void __launch_bounds__(NTHR) fwd_kernel(Args args) {
    extern __shared__ __attribute__((aligned(16))) unsigned char lds_raw[];
    cg::grid_group grid = cg::this_grid();
    Ctx c;
    c.lds = (LAS unsigned char*)lds_raw; c.ldsg = (char*)lds_raw;
    c.tid = threadIdx.x; c.lane = c.tid & 63; c.wave = __builtin_amdgcn_readfirstlane(c.tid >> 6); c.bid = blockIdx.x; c.G = gridDim.x;
    for (int u = c.tid; u < (LDS_BYTES - LDSCTL_OFF) / 4; u += NTHR) ((LAS unsigned*)(c.lds + LDSCTL_OFF))[u] = 0u;
    __syncthreads();
    XcdBarrier bar = xcd_barrier_post((unsigned*)(args.ws + WS_BAR), (volatile LAS unsigned*)(c.lds + MISC_OFF) + 8);
    const int lo = args.ph_lo, hi = args.ph_hi;
    if (lo < 0) grid.sync();
#define IN(k) (((PH_MASK >> (k)) & 1) && lo <= (k) && (k) < hi)
#define DUPQ(k) (((DUP_MASK >> (k)) & 1) && IN(k))
#define SEAM(k) do { if (IN(k) && IN((k) + 1)) xcd_barrier(bar); } while (0)
#define PH(k, call) do { if (IN(k)) { call; } if (DUPQ(k)) { grid.sync(); call; } } while (0)
    PH(0, phase0(c, args)); SEAM(0);
#pragma unroll 1
    for (int es_ = 0; es_ < EXTRA_SYNCS; ++es_) grid.sync();
    PH(1, ph1(c, args)); SEAM(1);
    PH(2, phase2(c, args)); SEAM(2);
    PH(3, ph3(c, args)); SEAM(3);
    PH(4, phase4(c, args)); SEAM(4);
    PH(5, ph5(c, args)); SEAM(5);
    PH(6, phase6(c, args)); SEAM(6);
    PH(7, ph7(c, args)); SEAM(7);
    PH(8, ph8(c, args)); SEAM(8);
    PH(9, ph9(c, args)); SEAM(9);
    PH(10, ph10(c, args)); SEAM(10);
    PH(11, ph11(c, args, 0)); SEAM(11);
    PH(12, phase12(c, args, 0)); SEAM(12);
    PH(13, ph11(c, args, 1)); SEAM(13);
    PH(14, phase12(c, args, 1)); SEAM(14);
    PH(15, ph15(c, args));
#undef IN
#undef SEAM
}

#ifndef N_LAUNCHES
#define N_LAUNCHES 1
#endif
extern "C" void kernel_launch(void* const* d_in, const int* in_sizes, int n_in, void* d_out, int out_size, void* d_ws, size_t ws_size, hipStream_t stream) {
    static int grid = 0;
    if (grid == 0) {
        if (n_in != 33 || in_sizes[0] != T * DM || out_size != T * DM || ws_size < WS_END) { fprintf(stderr, "kernel_launch: unexpected shapes (n_in %d, in0 %d, out %d, ws %zu)\n", n_in, n_in > 0 ? in_sizes[0] : -1, out_size, ws_size); grid = -1; return; }
        int dev = 0, cus = 0, per_cu = 0;
        if (hipGetDevice(&dev) != hipSuccess || hipDeviceGetAttribute(&cus, hipDeviceAttributeMultiprocessorCount, dev) != hipSuccess) { grid = -1; return; }
        if (hipFuncSetAttribute((const void*)fwd_kernel, hipFuncAttributeMaxDynamicSharedMemorySize, LDS_BYTES) != hipSuccess) { fprintf(stderr, "kernel_launch: hipFuncSetAttribute failed\n"); grid = -1; return; }
        if (hipOccupancyMaxActiveBlocksPerMultiprocessor(&per_cu, (const void*)fwd_kernel, NTHR, LDS_BYTES) != hipSuccess || per_cu < 1) { fprintf(stderr, "kernel_launch: occupancy query says %d\n", per_cu); per_cu = 1; }
        (void)hipGetLastError();
        if (per_cu > 1) per_cu = 1;
        grid = cus * per_cu;
    }
    if (grid < 0) return;
    if (hipMemsetAsync((char*)d_ws + WS_BAR, 0, BAR_ZERO_BYTES, stream) != hipSuccess) { fprintf(stderr, "kernel_launch: hipMemsetAsync failed\n"); return; }
    Args a{};
    for (int i = 0; i < 33; ++i) a.in[i] = d_in[i];
    a.out = (float*)d_out; a.ws = (unsigned char*)d_ws;
#if N_LAUNCHES == 1
    a.ph_lo = 0; a.ph_hi = N_PHASES;
    void* kargs[] = {&a};
    const hipError_t e = hipLaunchCooperativeKernel((const void*)fwd_kernel, dim3(grid), dim3(NTHR), kargs, LDS_BYTES, stream);
    if (e != hipSuccess) fprintf(stderr, "kernel_launch: cooperative launch failed: %s (grid %d)\n", hipGetErrorString(e), grid);
#else
    for (int p = 0; p < N_PHASES; ++p) { a.ph_lo = p; a.ph_hi = p + 1; hipLaunchKernelGGL(fwd_kernel, dim3(grid), dim3(NTHR), LDS_BYTES, stream, a); }
#endif
}
```

```cpp
#include <hip/hip_runtime.h>
#include <hip/hip_cooperative_groups.h>
#include <cstdio>
#include <cstdint>
namespace cg = cooperative_groups;

#ifndef FAST_GEMM
#define FAST_GEMM 1
#endif
#ifndef FAST_ATTN
#define FAST_ATTN 1
#endif

namespace pg8 {
#define PG8_LAS __attribute__((address_space(3)))
typedef unsigned short bf16_t;
typedef short bf16x8 __attribute__((ext_vector_type(8)));
typedef float f32x4 __attribute__((ext_vector_type(4)));
typedef unsigned u32x4 __attribute__((ext_vector_type(4)));
constexpr int BM = 256, BK = 64, HALF = 128, HTB = HALF * BK * 2  , STAGE_BYTES = 8 * HTB, NXCD = 8, WGM = 8;

__host__ __device__ __forceinline__ int lds_byte(int r, int c) { const int st = (r >> 4) * 2 + (c >> 5), rr = r & 15, cc = c & 31, ob = rr * 64 + cc * 2; return st * 1024 + (ob ^ (((ob >> 9) & 1) << 5)); }
__host__ __device__ __forceinline__ void stage_rc(int b, int& R, int& C) { const int st = b / 1024, sb = b % 1024, swz = sb ^ (((sb >> 9) & 1) << 5); R = (st >> 1) * 16 + swz / 64; C = (st & 1) * 32 + (swz % 64) / 2; }
__host__ __device__ __forceinline__ int perm32(int rho) { const int n = rho >> 4, i = rho & 15; return 8 * (i >> 2) + 4 * n + (i & 3); }

typedef unsigned u32x2 __attribute__((ext_vector_type(2)));
struct Unit { int pm, pn, job; const char* A; const char* B; };
struct Gemm { int K, lda, ldb; };

template <class Epi, class Sched, bool ALIGN_EPI = false, bool SP2 = false>
__device__ __forceinline__ void gemm_phase(PG8_LAS unsigned char* lds, const Gemm g, const Sched& S, const Epi& E) {
    const int tid = threadIdx.x, wid = __builtin_amdgcn_readfirstlane(tid >> 6), lane = tid & 63, wr = wid >> 2, wc = wid & 3, fr = lane & 15, fq = lane >> 4;
    int Kopq = g.K; asm volatile("" : "+s"(Kopq));
    const int K = Kopq, nt = K / BK;
    unsigned voffA[2], voffB[2];
#pragma unroll
    for (int i = 0; i < 2; ++i) { int R, C; stage_rc(tid * 16 + i * 8192, R, C); const int Rb = Epi::PERM ? ((R & ~31) + perm32(R & 31)) : R;
        const int Ra = Epi::AMAP ? ((R & 64) + 4 * (R & 15) + ((R >> 4) & 3)) : R;
        voffA[i] = (unsigned)(Ra * g.lda + C) * 2u; voffB[i] = (unsigned)(Rb * g.ldb + C) * 2u; }
    const size_t kstep = (size_t)(BK * 2);
    const size_t hstepA = (size_t)HALF * g.lda * 2, hstepB = (size_t)HALF * g.ldb * 2;
    const unsigned ldsw = (unsigned)wid * 1024u;
    const int aoff = lds_byte(wr * 64 + fr, fq * 8), boff = lds_byte(wc * 32 + fr, fq * 8);
#define PG8_SA(b, h) (((b) * 2 + (h)) * HTB)
#define PG8_SB(b, h) ((4 + (b) * 2 + (h)) * HTB)
#define PG8_STAGE(bufoff, gbase, voff) do { _Pragma("unroll") for (int _i = 0; _i < 2; ++_i) \
        __builtin_amdgcn_global_load_lds((const unsigned*)((const char*)(gbase) + (voff)[_i]), (PG8_LAS unsigned*)(lds + (bufoff) + ldsw + _i * 8192), 16, 0, 0); } while (0)
#define PG8_LDA(dst, b, h) do { _Pragma("unroll") for (int m = 0; m < 4; ++m) _Pragma("unroll") for (int k = 0; k < 2; ++k) dst[m][k] = *(const PG8_LAS bf16x8*)(lds + PG8_SA(b, h) + aoff + m * 2048 + k * 1024); } while (0)
#define PG8_LDB(dst, b, h) do { _Pragma("unroll") for (int n = 0; n < 2; ++n) _Pragma("unroll") for (int k = 0; k < 2; ++k) dst[n][k] = *(const PG8_LAS bf16x8*)(lds + PG8_SB(b, h) + boff + n * 2048 + k * 1024); } while (0)
#define PG8_MMA(ai, bj, At, Bt) do { __builtin_amdgcn_s_setprio(1); _Pragma("unroll") for (int m = 0; m < 4; ++m) _Pragma("unroll") for (int n = 0; n < 2; ++n) _Pragma("unroll") for (int k = 0; k < 2; ++k) \
        acc[ai][bj][m][n] = __builtin_amdgcn_mfma_f32_16x16x32_bf16(Bt[n][k], At[m][k], acc[ai][bj][m][n], 0, 0, 0); __builtin_amdgcn_s_setprio(0); } while (0)
#define PG8_WAIT_V(n) asm volatile("s_waitcnt vmcnt(" #n ")" ::: "memory")
#define PG8_WAIT_L(n) asm volatile("s_waitcnt lgkmcnt(" #n ")" ::: "memory")
#define PG8_BAR __builtin_amdgcn_s_barrier()
#define PG8_SCHED __builtin_amdgcn_sched_barrier(0)
    Unit cur, nxt; int ui = 0;
    if (!S.next(0, cur)) return;
    f32x4 acc[2][2][4][2];
#pragma unroll
    for (int a = 0; a < 2; ++a)
#pragma unroll
        for (int b = 0; b < 2; ++b)
#pragma unroll
            for (int m = 0; m < 4; ++m)
#pragma unroll
                for (int n = 0; n < 2; ++n) acc[a][b][m][n] = (f32x4){0.f, 0.f, 0.f, 0.f};
    bf16x8 At[4][2], B0[2][2], B1[2][2];
    const char* cA = cur.A; const char* cB = cur.B;
    S.a_ready(cur);
    if constexpr (SP2) {
        PG8_STAGE(PG8_SB(0, 0), cB, voffB); PG8_STAGE(PG8_SB(0, 1), cB + hstepB, voffB); PG8_STAGE(PG8_SA(0, 0), cA, voffA); PG8_STAGE(PG8_SA(0, 1), cA + hstepA, voffA);
        if (wr == 1) PG8_BAR;
        PG8_WAIT_V(2); PG8_BAR;
        PG8_STAGE(PG8_SB(1, 0), cB + kstep, voffB); PG8_STAGE(PG8_SA(1, 0), cA + kstep, voffA); PG8_STAGE(PG8_SB(1, 1), cB + hstepB + kstep, voffB);
        PG8_WAIT_V(6); PG8_BAR;
    } else {
        PG8_STAGE(PG8_SB(0, 0), cB, voffB); PG8_STAGE(PG8_SA(0, 0), cA, voffA); PG8_STAGE(PG8_SB(0, 1), cB + hstepB, voffB); PG8_STAGE(PG8_SA(0, 1), cA + hstepA, voffA);
        if (wr == 1) PG8_BAR;
        PG8_WAIT_V(4); PG8_BAR;
        PG8_STAGE(PG8_SB(1, 0), cB + kstep, voffB); PG8_STAGE(PG8_SA(1, 0), cA + kstep, voffA); PG8_STAGE(PG8_SB(1, 1), cB + hstepB + kstep, voffB);
        PG8_WAIT_V(6); PG8_BAR;
    }
    for (;;) {
        const bool has_next = S.next(ui + 1, nxt);
        const char* nA = has_next ? nxt.A : cA; const char* nB = has_next ? nxt.B : cB;
        for (int t = 0; t < nt; t += 2) {
            const bool last = (t == nt - 2);
            const char* a1 = cA + (size_t)(t + 1) * kstep;
            const char* a2 = last ? nA : cA + (size_t)(t + 2) * kstep; const char* b2 = last ? nB : cB + (size_t)(t + 2) * kstep;
            const char* a3 = a2 + kstep; const char* b3 = b2 + kstep;
            if (last && has_next) S.a_ready(nxt);
            if constexpr (SP2) {
            PG8_LDB(B0, 0, 0); PG8_LDB(B1, 0, 1); PG8_SCHED; PG8_LDA(At, 0, 0); PG8_STAGE(PG8_SA(1, 1), a1 + hstepA, voffA);
            PG8_WAIT_V(8); PG8_WAIT_L(0); PG8_BAR; PG8_MMA(0, 0, At, B0); PG8_MMA(0, 1, At, B1); PG8_BAR; PG8_SCHED;
            PG8_LDA(At, 0, 1); PG8_STAGE(PG8_SB(0, 0), b2, voffB); PG8_STAGE(PG8_SB(0, 1), b2 + hstepB, voffB); PG8_STAGE(PG8_SA(0, 0), a2, voffA);
            PG8_WAIT_V(8); PG8_WAIT_L(0); PG8_BAR; PG8_MMA(1, 0, At, B0); PG8_MMA(1, 1, At, B1); PG8_BAR; PG8_SCHED;
            PG8_LDB(B0, 1, 0); PG8_LDB(B1, 1, 1); PG8_SCHED; PG8_LDA(At, 1, 0); PG8_STAGE(PG8_SA(0, 1), a2 + hstepA, voffA);
            PG8_WAIT_V(8); PG8_WAIT_L(0); PG8_BAR; PG8_MMA(0, 0, At, B0); PG8_MMA(0, 1, At, B1); PG8_BAR; PG8_SCHED;
            PG8_LDA(At, 1, 1); PG8_STAGE(PG8_SB(1, 0), b3, voffB); PG8_STAGE(PG8_SB(1, 1), b3 + hstepB, voffB); PG8_STAGE(PG8_SA(1, 0), a3, voffA);
            PG8_WAIT_V(8); PG8_WAIT_L(0); PG8_BAR; PG8_MMA(1, 0, At, B0); PG8_MMA(1, 1, At, B1); PG8_BAR; PG8_SCHED;
            } else {
            PG8_LDB(B0, 0, 0); PG8_SCHED; PG8_LDA(At, 0, 0); PG8_STAGE(PG8_SA(1, 1), a1 + hstepA, voffA);
            PG8_WAIT_L(8); PG8_BAR; PG8_WAIT_L(0); PG8_MMA(0, 0, At, B0); PG8_BAR; PG8_SCHED;
            PG8_LDB(B1, 0, 1); PG8_STAGE(PG8_SB(0, 0), b2, voffB);
            PG8_BAR; PG8_WAIT_L(0); PG8_MMA(0, 1, At, B1); PG8_BAR;
            PG8_LDA(At, 0, 1); PG8_STAGE(PG8_SA(0, 0), a2, voffA);
            PG8_BAR; PG8_WAIT_L(0); PG8_MMA(1, 0, At, B0); PG8_BAR; PG8_SCHED;
            PG8_STAGE(PG8_SB(0, 1), b2 + hstepB, voffB);
            PG8_WAIT_V(6); PG8_BAR; PG8_MMA(1, 1, At, B1); PG8_BAR;
            PG8_LDB(B0, 1, 0); PG8_SCHED; PG8_LDA(At, 1, 0); PG8_STAGE(PG8_SA(0, 1), a2 + hstepA, voffA);
            PG8_WAIT_L(8); PG8_BAR; PG8_WAIT_L(0); PG8_MMA(0, 0, At, B0); PG8_BAR; PG8_SCHED;
            PG8_LDB(B1, 1, 1); PG8_STAGE(PG8_SB(1, 0), b3, voffB);
            PG8_BAR; PG8_WAIT_L(0); PG8_MMA(0, 1, At, B1); PG8_BAR;
            PG8_LDA(At, 1, 1); PG8_STAGE(PG8_SA(1, 0), a3, voffA);
            PG8_BAR; PG8_WAIT_L(0); PG8_MMA(1, 0, At, B0); PG8_BAR; PG8_SCHED;
            PG8_STAGE(PG8_SB(1, 1), b3 + hstepB, voffB);
            PG8_WAIT_V(6); PG8_BAR; PG8_MMA(1, 1, At, B1); PG8_BAR;
            }
        }
        if constexpr (ALIGN_EPI) { if (wr == 0) PG8_BAR; }
        if constexpr (!Epi::AFTER_DRAIN) { E(acc, cur, wr, wc, fr, fq); S.done(cur); }
        if (!has_next) break;
#pragma unroll
        for (int a = 0; a < 2; ++a)
#pragma unroll
            for (int b = 0; b < 2; ++b)
#pragma unroll
                for (int m = 0; m < 4; ++m)
#pragma unroll
                    for (int n = 0; n < 2; ++n) acc[a][b][m][n] = (f32x4){0.f, 0.f, 0.f, 0.f};
        cur = nxt; cA = nA; cB = nB; ++ui;
        if constexpr (ALIGN_EPI) { if (wr == 1) PG8_BAR; }
    }
    PG8_WAIT_V(0);
    if constexpr (!ALIGN_EPI) { if (wr == 0) PG8_BAR; }
    PG8_BAR;
    if constexpr (Epi::AFTER_DRAIN) { E.fused(acc, cur, wr, wc, fr, fq, lds, wid, lane); S.done(cur); }
#undef PG8_SA
#undef PG8_SB
#undef PG8_STAGE
#undef PG8_LDA
#undef PG8_LDB
#undef PG8_MMA
#undef PG8_WAIT_V
#undef PG8_WAIT_L
#undef PG8_BAR
#undef PG8_SCHED
}

__device__ __forceinline__ float bf2f(bf16_t v) { return __uint_as_float((unsigned)v << 16); }
__device__ __forceinline__ float bflo(unsigned w) { return __uint_as_float(w << 16); }
__device__ __forceinline__ float bfhi(unsigned w) { return __uint_as_float(w & 0xffff0000u); }
__device__ __forceinline__ unsigned cvt_pk_bf16(float lo, float hi) { unsigned r; asm volatile("v_cvt_pk_bf16_f32 %0, %1, %2" : "=v"(r) : "v"(lo), "v"(hi)); return r; }

template <class Epi, class Sched>
__device__ __forceinline__ void gemm_naive(const Gemm g, const Sched& S, const Epi& E) {
    const int tid = threadIdx.x, wid = tid >> 6, lane = tid & 63, wr = wid >> 2, wc = wid & 3, fr = lane & 15, fq = lane >> 4;
    Unit u;
    for (int i = 0; S.next(i, u); ++i) {
        f32x4 acc[2][2][4][2];
#pragma unroll
        for (int ai = 0; ai < 2; ++ai)
#pragma unroll
            for (int bj = 0; bj < 2; ++bj)
#pragma unroll
                for (int m = 0; m < 4; ++m)
#pragma unroll
                    for (int n = 0; n < 2; ++n) {
                        const bf16_t* a = (const bf16_t*)u.A + (size_t)(ai * 128 + wr * 64 + m * 16 + fr) * g.lda;
                        const bf16_t* b = (const bf16_t*)u.B + (size_t)(bj * 128 + wc * 32 + n * 16 + 4 * fq) * g.ldb;
                        float s0 = 0.f, s1 = 0.f, s2 = 0.f, s3 = 0.f;
                        for (int k = 0; k < g.K; k += 8) {
                            const bf16x8 av = *(const bf16x8*)(a + k), b0 = *(const bf16x8*)(b + k), b1 = *(const bf16x8*)(b + g.ldb + k), b2 = *(const bf16x8*)(b + 2 * g.ldb + k), b3 = *(const bf16x8*)(b + 3 * g.ldb + k);
#pragma unroll
                            for (int e = 0; e < 8; ++e) { const float x = bf2f((bf16_t)av[e]); s0 += x * bf2f((bf16_t)b0[e]); s1 += x * bf2f((bf16_t)b1[e]); s2 += x * bf2f((bf16_t)b2[e]); s3 += x * bf2f((bf16_t)b3[e]); }
                        }
                        acc[ai][bj][m][n] = (f32x4){s0, s1, s2, s3};
                    }
        E(acc, u, wr, wc, fr, fq);
    }
}

struct Job { const char* A; const char* B; int nM, nN; };
struct Sched2 {
    Job a, b; int G, c, lda, ldb;
    __device__ __forceinline__ bool next(int i, Unit& u) const {
        int L = i * G + c; const int na = a.nM * a.nN, nb = b.nM * b.nN;
        if (L < na) { u.job = 0; u.pm = L % a.nM; u.pn = L / a.nM; u.A = a.A + (size_t)u.pm * 256 * lda * 2; u.B = a.B + (size_t)u.pn * 256 * ldb * 2; return true; }
        L -= na;
        if (L < nb) { u.job = 1; u.pm = L % b.nM; u.pn = L / b.nM; u.A = b.A + (size_t)u.pm * 256 * lda * 2; u.B = b.B + (size_t)u.pn * 256 * ldb * 2; return true; }
        return false;
    }
    __device__ __forceinline__ void a_ready(const Unit&) const {}
    __device__ __forceinline__ void done(const Unit&) const {}
};
struct GateOrder {
    const char* xc; const char* wg; size_t dstride; int G, c;
    __device__ __forceinline__ bool next(int i, Unit& u) const {
        const int L = i * G + c; if (L >= 512) return false;
        const int grp = L >> 6, pm = L & 63, d = grp >> 2, png = grp & 3;
        u.job = d; u.pm = pm; u.pn = png; u.A = xc + (size_t)d * dstride + ((size_t)pm * 256 * 512 + png * 128) * 2; u.B = wg + (size_t)grp * 256 * 128 * 2; return true;
    }
    __device__ __forceinline__ void a_ready(const Unit&) const {}
    __device__ __forceinline__ void done(const Unit&) const {}
};

__device__ __forceinline__ float rowscale16(const float* ss, int row) {
    const f32x4* p = (const f32x4*)(ss + (size_t)row * 16); const f32x4 a = p[0], b = p[1], c = p[2], d = p[3];
    const float s = ((a[0] + a[1]) + (a[2] + a[3])) + ((b[0] + b[1]) + (b[2] + b[3])) + ((c[0] + c[1]) + (c[2] + c[3])) + ((d[0] + d[1]) + (d[2] + d[3]));
    return 1.0f / sqrtf(s * (1.0f / 1024.0f) + 1e-6f);
}
template <bool ROWSCALE> struct EpiBf {
    static constexpr bool PERM = true, AFTER_DRAIN = false, AMAP = false;
    bf16_t* O0; int ld0; bf16_t* O1; int ld1; const float* ss; const PG8_LAS float* rsl;
    __device__ __forceinline__ void operator()(const f32x4 (&acc)[2][2][4][2], const Unit& u, int wr, int wc, int fr, int fq) const {
        bf16_t* O = u.job ? O1 : O0; const int ldc = u.job ? ld1 : ld0;
        const int row0 = u.pm * 256 + wr * 64 + fr, col0 = u.pn * 256 + wc * 32 + 8 * fq;
#pragma unroll
        for (int ai = 0; ai < 2; ++ai)
#pragma unroll
            for (int m = 0; m < 4; ++m) { const int row = row0 + ai * 128 + m * 16; float rs = 1.f; if (ROWSCALE) rs = rsl ? rsl[row - u.pm * 256] : rowscale16(ss, row);
                bf16_t* rowp = O + (size_t)row * ldc + col0;
#pragma unroll
                for (int bj = 0; bj < 2; ++bj) { const f32x4 v0 = acc[ai][bj][m][0] * rs, v1 = acc[ai][bj][m][1] * rs; u32x4 w;
                    w.x = cvt_pk_bf16(v0[0], v0[1]); w.y = cvt_pk_bf16(v0[2], v0[3]); w.z = cvt_pk_bf16(v1[0], v1[1]); w.w = cvt_pk_bf16(v1[2], v1[3]); *(u32x4*)(rowp + bj * 128) = w; } }
    }
};
template <bool BASE_F32, bool OUT_F32> struct EpiResid {
    static constexpr bool PERM = true, AFTER_DRAIN = false, AMAP = false;
    const float* basef; const bf16_t* baseb; float* out; bf16_t* xb; float* ss;
    __device__ __forceinline__ void operator()(const f32x4 (&acc)[2][2][4][2], const Unit& u, int wr, int wc, int fr, int fq) const {
        const int row0 = u.pm * 256 + wr * 64 + fr, col0 = u.pn * 256 + wc * 32 + 8 * fq;
#pragma unroll
        for (int ai = 0; ai < 2; ++ai)
#pragma unroll
            for (int m = 0; m < 4; ++m) { const int row = row0 + ai * 128 + m * 16; const size_t off = (size_t)row * 1024 + col0; float s = 0.f;
#pragma unroll
                for (int bj = 0; bj < 2; ++bj) { const size_t o2 = off + bj * 128; f32x4 b0, b1;
                    if (BASE_F32) { b0 = *(const f32x4*)(basef + o2); b1 = *(const f32x4*)(basef + o2 + 4); }
                    else { const u32x4 w = *(const u32x4*)(baseb + o2); b0 = (f32x4){bflo(w.x), bfhi(w.x), bflo(w.y), bfhi(w.y)}; b1 = (f32x4){bflo(w.z), bfhi(w.z), bflo(w.w), bfhi(w.w)}; }
                    const f32x4 v0 = b0 + acc[ai][bj][m][0], v1 = b1 + acc[ai][bj][m][1];
                    if (OUT_F32) { *(f32x4*)(out + o2) = v0; *(f32x4*)(out + o2 + 4) = v1; }
                    else { s += ((v0[0] * v0[0] + v0[1] * v0[1]) + (v0[2] * v0[2] + v0[3] * v0[3])) + ((v1[0] * v1[0] + v1[1] * v1[1]) + (v1[2] * v1[2] + v1[3] * v1[3]));
                        u32x4 w; w.x = cvt_pk_bf16(v0[0], v0[1]); w.y = cvt_pk_bf16(v0[2], v0[3]); w.z = cvt_pk_bf16(v1[0], v1[1]); w.w = cvt_pk_bf16(v1[2], v1[3]); *(u32x4*)(xb + o2) = w; } }
                if (!OUT_F32) { s += __shfl_xor(s, 16); s += __shfl_xor(s, 32); if (fq == 0) ss[(size_t)row * 16 + u.pn * 4 + wc] = s; } }
    }
};
struct EpiGates {
    static constexpr bool PERM = false, AFTER_DRAIN = false, AMAP = false;
    const bf16_t* xc; const float* b_a; const float* b_i; const float* c8t; unsigned* G; int T;
    __device__ __forceinline__ void operator()(const f32x4 (&acc)[2][2][4][2], const Unit& u, int wr, int wc, int fr, int fq) const {
        const int d = u.job, row0 = u.pm * 256 + wr * 64 + fr, ch0 = u.pn * 128 + wc * 32 + 4 * fq;
#pragma unroll
        for (int n = 0; n < 2; ++n) { const int ch = d * 512 + ch0 + n * 16; const f32x4 ba = *(const f32x4*)(b_a + ch), bi = *(const f32x4*)(b_i + ch), c8 = *(const f32x4*)(c8t + ch);
#pragma unroll
            for (int ai = 0; ai < 2; ++ai)
#pragma unroll
                for (int m = 0; m < 4; ++m) { const int row = row0 + ai * 128 + m * 16;
                    const size_t off = ((size_t)d * T + row) * 512 + ch0 + n * 16; const u32x2 xw = *(const u32x2*)(xc + off);
                    const float xv[4] = {bflo(xw.x), bfhi(xw.x), bflo(xw.y), bfhi(xw.y)}; const f32x4 pa = acc[ai][0][m][n] + ba, pi = acc[ai][1][m][n] + bi; u32x4 o;
#pragma unroll
                    for (int e = 0; e < 4; ++e) { const float r = __builtin_amdgcn_rcpf(1.0f + __expf(-pa[e])), ig = __builtin_amdgcn_rcpf(1.0f + __expf(-pi[e])); const float la = r * c8[e];
                        const float x2 = 2.0f * la; const float om = (x2 > -0.02f) ? -(x2 + 0.5f * x2 * x2 + x2 * x2 * x2 * (1.0f / 6.0f)) : 1.0f - __expf(x2);
                        o[e] = cvt_pk_bf16(la, __builtin_amdgcn_sqrtf(fmaxf(om, 0.f)) * ig * xv[e]); }
                    *(u32x4*)(G + off) = o; asm volatile("" ::: "memory"); } }
    }
};
struct FfnOrder {
    const char* xb; const char* wup; int G, c;
    __device__ __forceinline__ bool next(int i, Unit& u) const {
        const int L = i * G + c, x = L & 7, y = L >> 3; if (y >= 182) return false;
        const int U = x * 182 + y; if (U >= 66 * 22) return false;
        if (U < 16 * 88) { const int pmg = U / 88, r = U - pmg * 88; u.pn = r >> 2; u.pm = pmg * 4 + (r & 3); } else { const int r = U - 16 * 88; u.pn = r >> 1; u.pm = 64 + (r & 1); }
        u.job = i; const int b = u.pm / 33, pmb = u.pm - 33 * b;
        u.A = xb + ((long)(b * 8192 + 254 * pmb - 1) * 1024) * 2; u.B = wup + (size_t)u.pn * 256 * 1024 * 2; return true;
    }
    __device__ __forceinline__ void a_ready(const Unit&) const {}
    __device__ __forceinline__ void done(const Unit&) const {}
};
__device__ __forceinline__ float dpp_shr1(float oldv, float src) { return __int_as_float(__builtin_amdgcn_update_dpp(__float_as_int(oldv), __float_as_int(src), 0x111, 0xf, 0xf, false)); }
__device__ __forceinline__ float dpp_shl1(float oldv, float src) { return __int_as_float(__builtin_amdgcn_update_dpp(__float_as_int(oldv), __float_as_int(src), 0x101, 0xf, 0xf, false)); }
struct EpiFfn {
    static constexpr bool PERM = true, AFTER_DRAIN = false, AMAP = true;
    const float* ss; const float* cw; const float* cb; bf16_t* hid; PG8_LAS float* halo; PG8_LAS float* rsl;
    __device__ __forceinline__ void operator()(f32x4 (&acc)[2][2][4][2], const Unit& u, int wr, int wc, int fr, int fq) const {
        const int b = u.pm / 33, pmb = u.pm - 33 * b, ts = 254 * pmb - 1, c8 = wc * 32 + 8 * fq, j = u.pn * 128 + c8;
        const bool edge = (pmb == 0) || (pmb == 32);
        typedef float f32x2w __attribute__((ext_vector_type(2)));
        PG8_LAS float* wl = halo + 2048;
        f32x2w wld; { const int t2 = (int)threadIdx.x * 2, bjw = t2 >> 9, kw = (t2 >> 7) & 3, cwl = t2 & 127; const float* src = (kw < 3 ? cw + (size_t)kw * 5632 : cb) + bjw * 2816 + u.pn * 128 + cwl; wld = *(const f32x2w*)src; }
#pragma unroll
        for (int ai = 0; ai < 2; ++ai)
#pragma unroll
            for (int m = 0; m < 4; ++m) { const int tl = ts + 128 * ai + 64 * wr + 4 * fr + m; const bool in = !edge || ((tl >= 0) && (tl < 8192)); float rs = 0.f; if (u.job < 6) rs = rsl[u.job * 256 + 128 * ai + 64 * wr + 4 * fr + m]; else if (in) rs = rowscale16(ss, b * 8192 + tl);
#pragma unroll
                for (int bj = 0; bj < 2; ++bj)
#pragma unroll
                    for (int n = 0; n < 2; ++n)
#pragma unroll
                        for (int e = 0; e < 4; ++e) acc[ai][bj][m][n][e] = (edge && !in) ? 0.f : acc[ai][bj][m][n][e] * rs; }
#pragma unroll
        for (int ai = 0; ai < 2; ++ai) { const int grp = 2 * ai + wr;
#pragma unroll
            for (int bj = 0; bj < 2; ++bj) {
                if (fr == 0) { PG8_LAS f32x4* p = (PG8_LAS f32x4*)(halo + (grp * 2 + 0) * 256 + bj * 128 + c8); p[0] = acc[ai][bj][0][0]; p[1] = acc[ai][bj][0][1]; }
                if (fr == 15) { PG8_LAS f32x4* p = (PG8_LAS f32x4*)(halo + (grp * 2 + 1) * 256 + bj * 128 + c8); p[0] = acc[ai][bj][3][0]; p[1] = acc[ai][bj][3][1]; } } }
        *(PG8_LAS f32x2w*)(wl + (int)threadIdx.x * 2) = wld;
        asm volatile("s_waitcnt lgkmcnt(0)\n\ts_barrier" ::: "memory");
        f32x4 wgt[2][3][2], bia[2][2];
#pragma unroll
        for (int bj = 0; bj < 2; ++bj) {
#pragma unroll
            for (int n = 0; n < 2; ++n) { bia[bj][n] = *(const PG8_LAS f32x4*)(wl + (bj * 4 + 3) * 128 + c8 + 4 * n);
#pragma unroll
                for (int k = 0; k < 3; ++k) wgt[bj][k][n] = *(const PG8_LAS f32x4*)(wl + (bj * 4 + k) * 128 + c8 + 4 * n); } }
#pragma unroll
        for (int ai = 0; ai < 2; ++ai) { const int grp = 2 * ai + wr;
            u32x4 ow[4];
#pragma unroll
            for (int n = 0; n < 2; ++n) { f32x4 hp[2], hn[2];
#pragma unroll
                for (int bj = 0; bj < 2; ++bj) { hp[bj] = (grp > 0) ? *(const PG8_LAS f32x4*)(halo + ((grp - 1) * 2 + 1) * 256 + bj * 128 + c8 + 4 * n) : (f32x4){0.f, 0.f, 0.f, 0.f};
                    hn[bj] = (grp < 3) ? *(const PG8_LAS f32x4*)(halo + ((grp + 1) * 2 + 0) * 256 + bj * 128 + c8 + 4 * n) : (f32x4){0.f, 0.f, 0.f, 0.f}; }
                float hv[4][4];
#pragma unroll
                for (int e = 0; e < 4; ++e) { float cv[2][4];
#pragma unroll
                    for (int bj = 0; bj < 2; ++bj) { const float x0 = acc[ai][bj][0][n][e], x1 = acc[ai][bj][1][n][e], x2 = acc[ai][bj][2][n][e], x3 = acc[ai][bj][3][n][e];
                        const float pm0 = dpp_shr1(hp[bj][e], x3), nm3 = dpp_shl1(hn[bj][e], x0);
                        const float w0 = wgt[bj][0][n][e], w1 = wgt[bj][1][n][e], w2 = wgt[bj][2][n][e], bb = bia[bj][n][e];
                        cv[bj][0] = bb + w0 * pm0 + w1 * x0 + w2 * x1; cv[bj][1] = bb + w0 * x0 + w1 * x1 + w2 * x2; cv[bj][2] = bb + w0 * x1 + w1 * x2 + w2 * x3; cv[bj][3] = bb + w0 * x2 + w1 * x3 + w2 * nm3; }
#pragma unroll
                    for (int m = 0; m < 4; ++m) { const float G = cv[0][m]; hv[m][e] = G * __builtin_amdgcn_rcpf(1.0f + __builtin_amdgcn_exp2f(-1.4426950408889634f * G)) * cv[1][m]; } }
#pragma unroll
                for (int m = 0; m < 4; ++m) { ow[m][2 * n] = cvt_pk_bf16(hv[m][0], hv[m][1]); ow[m][2 * n + 1] = cvt_pk_bf16(hv[m][2], hv[m][3]); } }
#pragma unroll
            for (int m = 0; m < 4; ++m) { const int tau = 128 * ai + 64 * wr + 4 * fr + m, tl = ts + tau;
                if (tau >= 1 && tau <= 254 && tl < 8192) *(u32x4*)(hid + ((size_t)b * 8192 + tl) * 2816 + j) = ow[m]; } }
    }
};
}

namespace att {
using pg8::bf16_t;
using bf16x8 = __attribute__((ext_vector_type(8))) short;
using s16x4  = __attribute__((ext_vector_type(4))) short;
using f32x16 = __attribute__((ext_vector_type(16))) float;
using u32x4  = __attribute__((ext_vector_type(4))) unsigned;
constexpr int NW = 8, QBLK = 32, KVBLK = 64;
constexpr size_t SHM_V = KVBLK * 128 * 2, SHM_K = KVBLK * 128 * 2, SHM_ATTN = 3 * SHM_V + 3 * SHM_K + NW * 64 * 4;
constexpr float THR = 8.f;
#define KSWZ(row, colB) ((row) * 256 + ((colB) ^ (((row) & 7) << 4)))
#define SBAR() __builtin_amdgcn_sched_barrier(0)
__device__ __forceinline__ int crow(int r, int hi) { return (r & 3) + 8 * (r >> 2) + 4 * hi; }
__device__ __forceinline__ unsigned cvtpk(float lo, float hi) { unsigned r; asm volatile("v_cvt_pk_bf16_f32 %0, %1, %2" : "=v"(r) : "v"(lo), "v"(hi)); return r; }
#ifndef ATT_DUP_EXP
#define ATT_DUP_EXP 0
#endif
#ifndef ATT_DUP_MFMA
#define ATT_DUP_MFMA 0
#endif
template <bool FIXED> __device__ __forceinline__ void partialSM(f32x16& p0, f32x16& p1, float& m_reg, float& mn, float& alpha, float C, float thr_raw) {
  if constexpr (FIXED) {
#if ATT_DUP_EXP
    { f32x16 dmy;
      _Pragma("unroll") for (int r = 0; r < 16; ++r) dmy[r] = __builtin_amdgcn_exp2f(p0[r] + 1.0f) + __builtin_amdgcn_exp2f(p1[r] + 1.0f);
      asm volatile("" :: "v"(dmy)); }
#endif
    alpha = 1.f;
#pragma unroll
    for (int r = 0; r < 16; ++r) p0[r] = __builtin_amdgcn_exp2f(p0[r]);
    return; }
  float pmax = p0[0];
#pragma unroll
  for (int r = 1; r < 16; ++r) pmax = fmaxf(pmax, p0[r]);
#pragma unroll
  for (int r = 0; r < 16; ++r) pmax = fmaxf(pmax, p1[r]);
  { auto rr = __builtin_amdgcn_permlane32_swap(__float_as_uint(pmax), __float_as_uint(pmax), false, false);
    pmax = fmaxf(__uint_as_float(rr[0]), __uint_as_float(rr[1])); }
  if (__builtin_expect(__all(pmax - m_reg <= thr_raw), 1)) { mn = m_reg; alpha = 1.f; }
  else { mn = fmaxf(m_reg, pmax); alpha = __builtin_amdgcn_exp2f((m_reg - mn) * C); m_reg = mn; }
  const float mnC = -mn * C;
#pragma unroll
  for (int r = 0; r < 16; ++r) p0[r] = fmaf(p0[r], C, mnC);
#pragma unroll
  for (int r = 0; r < 16; ++r) p1[r] = fmaf(p1[r], C, mnC);
#pragma unroll
  for (int r = 0; r < 16; ++r) p0[r] = __builtin_amdgcn_exp2f(p0[r]);
}
template <bool SUM> __device__ __forceinline__ void finishSM(f32x16& p0, f32x16& p1, float alpha, float& l_reg, bf16x8& pa0, bf16x8& pa1, bf16x8& pa2, bf16x8& pa3) {
#pragma unroll
  for (int r = 0; r < 16; ++r) p1[r] = __builtin_amdgcn_exp2f(p1[r]);
  if constexpr (SUM) { float ps = 0;
#pragma unroll
    for (int r = 0; r < 16; ++r) ps += p0[r];
#pragma unroll
    for (int r = 0; r < 16; ++r) ps += p1[r];
    { auto rr = __builtin_amdgcn_permlane32_swap(__float_as_uint(ps), __float_as_uint(ps), false, false);
      ps = __uint_as_float(rr[0]) + __uint_as_float(rr[1]); }
    l_reg = l_reg * alpha + ps; }
#define PK4(P, BASE, OUT) do { u32x4 w = {cvtpk(P[BASE + 0], P[BASE + 1]), cvtpk(P[BASE + 2], P[BASE + 3]), cvtpk(P[BASE + 4], P[BASE + 5]), cvtpk(P[BASE + 6], P[BASE + 7])}; OUT = *reinterpret_cast<bf16x8*>(&w); } while (0)
  PK4(p0, 0, pa0); PK4(p0, 8, pa1); PK4(p1, 0, pa2); PK4(p1, 8, pa3);
#undef PK4
}
template <int DQK> __device__ __forceinline__ void qkt(f32x16& p0, f32x16& p1, const bf16_t* Ks, const bf16x8* qr, int r32, int hi) {
  p0 = f32x16{}; p1 = f32x16{};
#if ATT_DUP_MFMA
  f32x16 dm0 = f32x16{}, dm1 = f32x16{};
#endif
#pragma unroll
  for (int d0 = 0; d0 < DQK / 16; ++d0) { const int cb = (d0 * 16 + hi * 8) * 2;
    const bf16x8 b0 = *reinterpret_cast<const bf16x8*>((const char*)Ks + KSWZ(r32, cb));
    const bf16x8 b1 = *reinterpret_cast<const bf16x8*>((const char*)Ks + KSWZ(32 + r32, cb));
    p0 = __builtin_amdgcn_mfma_f32_32x32x16_bf16(b0, qr[d0], p0, 0, 0, 0);
    p1 = __builtin_amdgcn_mfma_f32_32x32x16_bf16(b1, qr[d0], p1, 0, 0, 0);
#if ATT_DUP_MFMA
    dm0 = __builtin_amdgcn_mfma_f32_32x32x16_bf16(b0, qr[d0], dm0, 0, 0, 0); dm1 = __builtin_amdgcn_mfma_f32_32x32x16_bf16(b1, qr[d0], dm1, 0, 0, 0);
#endif
  }
#if ATT_DUP_MFMA
  asm volatile("" :: "v"(dm0), "v"(dm1));
#endif
}
__device__ __forceinline__ int v_st(int k, int c) { const int kk = k; return ((kk >> 3) * 4 + (c >> 5)) * 512 + ((kk & 7) * 32 + (c & 31)) * 2; }
__device__ __forceinline__ int v_rd_base(int lane) { return ((lane & 3) << 3) | (((lane >> 2) & 3) << 6) | (((lane >> 4) & 1) << 5) | (((lane >> 5) & 1) << 8); }
constexpr int v_rd_off(int d0, int ks, int half) { return d0 * 512 + ks * 4096 + half * 2048; }
template <int OFF> __device__ __forceinline__ s16x4 tr_read(int vb) {
  s16x4 r; asm volatile("ds_read_b64_tr_b16 %0, %1 offset:%2" : "=&v"(r) : "v"(vb), "i"(OFF) : "memory"); return r;
}
template <int D0> __device__ __forceinline__ void pv_one(f32x16& od, int vb, bf16x8 pa0, bf16x8 pa1, bf16x8 pa2, bf16x8 pa3) {
  const s16x4 l0 = tr_read<v_rd_off(D0, 0, 0)>(vb), h0 = tr_read<v_rd_off(D0, 0, 1)>(vb), l1 = tr_read<v_rd_off(D0, 1, 0)>(vb), h1 = tr_read<v_rd_off(D0, 1, 1)>(vb);
  const s16x4 l2 = tr_read<v_rd_off(D0, 2, 0)>(vb), h2 = tr_read<v_rd_off(D0, 2, 1)>(vb), l3 = tr_read<v_rd_off(D0, 3, 0)>(vb), h3 = tr_read<v_rd_off(D0, 3, 1)>(vb);
  asm volatile("s_waitcnt lgkmcnt(0)" ::: "memory"); SBAR();
#define PK(L, H) (bf16x8){L[0], L[1], L[2], L[3], H[0], H[1], H[2], H[3]}
  od = __builtin_amdgcn_mfma_f32_32x32x16_bf16(pa0, PK(l0, h0), od, 0, 0, 0);
  od = __builtin_amdgcn_mfma_f32_32x32x16_bf16(pa1, PK(l1, h1), od, 0, 0, 0);
  od = __builtin_amdgcn_mfma_f32_32x32x16_bf16(pa2, PK(l2, h2), od, 0, 0, 0);
  od = __builtin_amdgcn_mfma_f32_32x32x16_bf16(pa3, PK(l3, h3), od, 0, 0, 0);
#undef PK
}
template <int DV, bool OL> __device__ __forceinline__ void pv_all(f32x16* o, f32x16& ol, bf16x8 onesB, int vb, bf16x8 pa0, bf16x8 pa1, bf16x8 pa2, bf16x8 pa3) {
  pv_one<0>(o[0], vb, pa0, pa1, pa2, pa3); pv_one<1>(o[1], vb, pa0, pa1, pa2, pa3);
  if constexpr (DV == 128) { pv_one<2>(o[2], vb, pa0, pa1, pa2, pa3); pv_one<3>(o[3], vb, pa0, pa1, pa2, pa3); }
  if constexpr (OL) {
    ol = __builtin_amdgcn_mfma_f32_32x32x16_bf16(pa0, onesB, ol, 0, 0, 0); ol = __builtin_amdgcn_mfma_f32_32x32x16_bf16(pa1, onesB, ol, 0, 0, 0);
    ol = __builtin_amdgcn_mfma_f32_32x32x16_bf16(pa2, onesB, ol, 0, 0, 0); ol = __builtin_amdgcn_mfma_f32_32x32x16_bf16(pa3, onesB, ol, 0, 0, 0); }
}

constexpr int NBUF = 4;
constexpr size_t SHM_ATTN_PP = NBUF * (SHM_V + SHM_K) + NW * 64 * 4;
#define PPBAR() asm volatile("s_waitcnt lgkmcnt(0)\n\ts_barrier" ::: "memory")
template <int DQK, int DV, bool QNORM, bool FIXED>
__device__ __forceinline__ void attn_unit(const bf16_t* __restrict__ Qb, int ldq, const bf16_t* __restrict__ Kh, int ldk, const bf16_t* __restrict__ Vh, int ldv,
                                          bf16_t* __restrict__ Ob, int ldo, int seq, float scale, const float* __restrict__ qgain, const int* __restrict__ qpos, char* lds) {
  const int tid = threadIdx.x, wid = __builtin_amdgcn_readfirstlane(tid >> 6), lane = tid & 63, r32 = lane & 31, hi = lane >> 5;
  const float C = 1.0f, thr_raw = THR * 1.4426950408889634f;
  bf16_t* V_lds = (bf16_t*)lds; bf16_t* K_lds = (bf16_t*)(lds + NBUF * SHM_V);
  float* ws = (float*)(lds + NBUF * (SHM_V + SHM_K)) + wid * 64; float* li_l = ws; float* al_l = ws + 32;
  constexpr bool OL = (DV == 64) && FIXED;
  float m_reg = -1e30f, l_reg = 0; f32x16 o[DV / 32]; f32x16 ol = f32x16{}; bf16x8 qr[DQK / 16];
  const short one_s = (r32 == 0) ? (short)0x3F80 : (short)0; const bf16x8 onesB = {one_s, one_s, one_s, one_s, one_s, one_s, one_s, one_s};
#pragma unroll
  for (int d = 0; d < DV / 32; ++d) o[d] = f32x16{};
  const bf16_t* Qw = Qb + (long)(wid * QBLK + r32) * ldq + hi * 8;
#pragma unroll
  for (int d0 = 0; d0 < DQK / 16; ++d0) qr[d0] = *reinterpret_cast<const bf16x8*>(Qw + d0 * 16);
  if constexpr (QNORM) {
    float vq[DQK / 16][8]; float ssq = 0.f;
#pragma unroll
    for (int d0 = 0; d0 < DQK / 16; ++d0)
#pragma unroll
      for (int e = 0; e < 8; ++e) { vq[d0][e] = pg8::bf2f((bf16_t)qr[d0][e]); ssq += vq[d0][e] * vq[d0][e]; }
    ssq += __shfl_xor(ssq, 32);
    const float rs = scale * 1.4426950408889634f / sqrtf(ssq * (1.0f / DQK) + 1e-6f);
#pragma unroll
    for (int d0 = 0; d0 < DQK / 16; ++d0)
#pragma unroll
      for (int e = 0; e < 8; ++e) vq[d0][e] *= rs * qgain[d0 * 16 + hi * 8 + e];
    if constexpr (DQK == 96) {
      const float posf = (float)qpos[wid * QBLK + r32];
#pragma unroll
      for (int e = 0; e < 8; ++e) { const int j = hi * 8 + e; const float inv = exp2f(-(float)j * 0.8304820237218406f);
        const float ang = posf * inv; const double rev = (double)ang * 0.15915494309189535; const float fr = (float)(rev - rint(rev));
        const float cs = __builtin_amdgcn_cosf(fr), sn = __builtin_amdgcn_sinf(fr), a1 = vq[4][e], a2 = vq[5][e];
        vq[4][e] = a1 * cs - a2 * sn; vq[5][e] = a1 * sn + a2 * cs; }
    }
#pragma unroll
    for (int d0 = 0; d0 < DQK / 16; ++d0) { u32x4 w = {cvtpk(vq[d0][0], vq[d0][1]), cvtpk(vq[d0][2], vq[d0][3]), cvtpk(vq[d0][4], vq[d0][5]), cvtpk(vq[d0][6], vq[d0][7])}; qr[d0] = *reinterpret_cast<bf16x8*>(&w); }
  }
  const int sr = tid >> 4, sc = (tid & 15) * 8, vst0 = v_st(sr, sc), vst1 = v_st(32 + sr, sc);
  const bool kact = sc < DQK, vact = sc < DV;
  const int vb0 = (int)(uintptr_t)V_lds + v_rd_base(lane);
  bf16x8 svs0[2], svs1[2], sks0[2], sks1[2];
#define SLOAD(i, k0) do { if (vact) { svs0[i] = *(const bf16x8*)(&Vh[(long)((k0) + sr) * ldv + sc]); svs1[i] = *(const bf16x8*)(&Vh[(long)((k0) + 32 + sr) * ldv + sc]); } \
    if (kact) { sks0[i] = *(const bf16x8*)(&Kh[(long)((k0) + sr) * ldk + sc]); sks1[i] = *(const bf16x8*)(&Kh[(long)((k0) + 32 + sr) * ldk + sc]); } } while (0)
#define SWRITE(off, i) do { if (vact) { *(bf16x8*)((char*)V_lds + (off) + vst0) = svs0[i]; *(bf16x8*)((char*)V_lds + (off) + vst1) = svs1[i]; } \
    if (kact) { const int kc = sc * 2; *(bf16x8*)((char*)K_lds + (off) + KSWZ(sr, kc)) = sks0[i]; *(bf16x8*)((char*)K_lds + (off) + KSWZ(32 + sr, kc)) = sks1[i]; } } while (0)
#define RESC(a) do { if (!FIXED && __any((a) < 1.f)) { if (hi == 0) al_l[r32] = (a); asm volatile("s_waitcnt lgkmcnt(0)" ::: "memory"); \
    _Pragma("unroll") for (int r = 0; r < 16; ++r) { const float f_ = al_l[crow(r, hi)]; if (OL) ol[r] *= f_; _Pragma("unroll") for (int d = 0; d < DV / 32; ++d) o[d][r] *= f_; } } } while (0)
#define BOFF(t) (((t) & (NBUF - 1)) * (int)SHM_V)
  f32x16 p0, p1; float mn, al; bf16x8 pa0, pa1, pa2, pa3; const int NT = seq / KVBLK;
  SLOAD(0, 0); SLOAD(1, KVBLK);
  SWRITE(BOFF(0), 0); SWRITE(BOFF(1), 1);
  SLOAD(0, 2 * KVBLK);
  PPBAR();
  qkt<DQK>(p0, p1, K_lds, qr, r32, hi);
  if (wid >= 4) PPBAR();
#pragma unroll 1
  for (int s = 0; s < NT; ++s) {
      partialSM<FIXED>(p0, p1, m_reg, mn, al, C, thr_raw); RESC(al); finishSM<!OL>(p0, p1, al, l_reg, pa0, pa1, pa2, pa3);
    if (s + 2 < NT) { SWRITE(BOFF(s + 2), 0); } if (s + 3 < NT) { SLOAD(0, (s + 3) * KVBLK); }
    PPBAR(); SBAR();
      __builtin_amdgcn_s_setprio(1); pv_all<DV, OL>(o, ol, onesB, vb0 + BOFF(s), pa0, pa1, pa2, pa3); if (s + 1 < NT) qkt<DQK>(p0, p1, (bf16_t*)((char*)K_lds + BOFF(s + 1)), qr, r32, hi); __builtin_amdgcn_s_setprio(0);
    PPBAR(); SBAR();
  }
  if (wid < 4) PPBAR();
#undef BOFF
  if constexpr (OL) { if (r32 == 0) {
#pragma unroll
      for (int r = 0; r < 16; ++r) li_l[crow(r, hi)] = ol[r]; } }
  else { if (hi == 0) li_l[r32] = l_reg; }
  asm volatile("s_waitcnt lgkmcnt(0)" ::: "memory");
  float rli[16];
#pragma unroll
  for (int r = 0; r < 16; ++r) rli[r] = __builtin_amdgcn_rcpf(li_l[crow(r, hi)]);
  bf16_t* Ow = Ob + (long)(wid * QBLK) * ldo;
#pragma unroll
  for (int r = 0; r < 16; ++r) { const int orow = crow(r, hi);
#pragma unroll
    for (int d0 = 0; d0 < DV / 32; ++d0) Ow[(long)orow * ldo + d0 * 32 + r32] = (bf16_t)(cvtpk(o[d0][r] * rli[r], 0.f) & 0xffffu); }
  __syncthreads();
#undef SLOAD
#undef SWRITE
#undef RESC
}
#undef SBAR

template <int DQK, int DV, bool QNORM>
__device__ __forceinline__ void attn_unit_naive(const bf16_t* Qb, int ldq, const bf16_t* Kh, int ldk, const bf16_t* Vh, int ldv, bf16_t* Ob, int ldo, int seq, float scale, const float* qgain, char* lds) {
  const int tid = threadIdx.x; float* ql = (float*)lds;
  if (tid < 256) {
    float ssq = 0.f;
    for (int d = 0; d < DQK; ++d) { const float v = pg8::bf2f(Qb[(long)tid * ldq + d]); ssq += v * v; }
    const float rs = QNORM ? 1.0f / sqrtf(ssq * (1.0f / DQK) + 1e-6f) : 1.f;
    for (int d = 0; d < DQK; ++d) { float v = pg8::bf2f(Qb[(long)tid * ldq + d]); if (QNORM) v = pg8::bf2f((bf16_t)(cvtpk(v * rs * qgain[d], 0.f) & 0xffffu)); ql[d * 256 + tid] = v; }
    float m = -1e30f, l = 0.f; float o[DV];
#pragma unroll
    for (int d = 0; d < DV; ++d) o[d] = 0.f;
    for (int k = 0; k < seq; ++k) { float s = 0.f;
      for (int d = 0; d < DQK; ++d) s += ql[d * 256 + tid] * pg8::bf2f(Kh[(long)k * ldk + d]);
      s *= scale; const float mn = fmaxf(m, s), al = __expf(m - mn), p = __expf(s - mn); l = l * al + p; m = mn;
#pragma unroll
      for (int d = 0; d < DV; ++d) o[d] = o[d] * al + p * pg8::bf2f(Vh[(long)k * ldv + d]); }
    const float il = 1.0f / l;
#pragma unroll
    for (int d = 0; d < DV; ++d) Ob[(long)tid * ldo + d] = (bf16_t)(cvtpk(o[d] * il, 0.f) & 0xffffu);
  }
  __syncthreads();
}
}

using pg8::bf16_t; using pg8::f32x4; using pg8::u32x4; using pg8::u32x2; using pg8::bf16x8; using pg8::bf2f; using pg8::bflo; using pg8::bfhi; using pg8::cvt_pk_bf16;
#define LAS __attribute__((address_space(3)))
constexpr int NBATCH = 2, SEQ = 8192, T = NBATCH * SEQ, DM = 1024, MEMLEN = 256, TM = NBATCH * MEMLEN;
constexpr int PROJ_LD = 1536, IN_COLS = 1440, DFF = 2816, DFF2 = 5632;
constexpr int NTHR = 512, NWAVES = 8;
constexpr float EPS = 1e-6f;
constexpr size_t MiB = 1u << 20;
constexpr size_t WS_SS = 1 * MiB, WS_WIN = 2 * MiB, WS_WUQ = 5 * MiB, WS_WUKV = 5 * MiB + 512 * 1024, WS_WG = 6 * MiB, WS_WOUT = 7 * MiB, WS_WMQ = 9 * MiB, WS_WMKV = 10 * MiB,
                 WS_WMO = 12 * MiB, WS_WUP = 13 * MiB, WS_WDN = 24 * MiB, WS_MEMN = 30 * MiB, WS_MEMKV = 31 * MiB, WS_XB = 32 * MiB, WS_KN = 32 * MiB, WS_AGG = 56 * MiB,
                 WS_PROJ = 64 * MiB, WS_CQ = 112 * MiB, WS_CKV = 120 * MiB, WS_XC = 124 * MiB, WS_QRAW = 156 * MiB, WS_KVRAW = 180 * MiB, WS_QN = 112 * MiB, WS_MLA = 136 * MiB,
                 WS_AMIX = 156 * MiB, WS_QMEM = 112 * MiB, WS_OMEM = 128 * MiB, WS_GU = 64 * MiB, WS_HID = 152 * MiB, WS_END = 240 * MiB;
constexpr int LDS_BYTES = 151552, LDSCTL_OFF = LDS_BYTES - 1024, MISC_OFF = LDSCTL_OFF + 320;
constexpr size_t WS_BAR = 65536, BAR_ZERO_BYTES = 16384;

struct Args { const void* in[33]; float* out; unsigned char* ws; int ph_lo, ph_hi; };

struct Ctx {
    LAS unsigned char* lds; char* ldsg;
    int tid, lane, wave, bid, G;
};
#define WSP(type, off) ((type*)(args.ws + (off)))

#define XB_TMO      128
#define XB_XCNT(j)  (256  + 64 * (j))
#define XB_XSUB(j)  (1280 + 64 * (j))
#define XB_XGEN(j)  (2304 + 64 * (j))
#define XB_TOP      3328
#define XB_TOPGEN   3392
#define XCD_BAR_WORDS 3456
#define XB_SPIN_CAP (1u << 18)

__device__ __forceinline__ unsigned xb_ld(unsigned* p)              { return __hip_atomic_load(p, __ATOMIC_RELAXED, __HIP_MEMORY_SCOPE_AGENT); }
__device__ __forceinline__ unsigned xb_add(unsigned* p, unsigned v) { return __hip_atomic_fetch_add(p, v, __ATOMIC_RELAXED, __HIP_MEMORY_SCOPE_AGENT); }
__device__ __forceinline__ unsigned xb_xcc_id() { return (unsigned)__builtin_amdgcn_s_getreg((3 << 11) | 20) & 0xFu; }
#define XB_SPIN(cond, bar) do { unsigned _sp = 0; while (cond) { __builtin_amdgcn_s_sleep(1); \
    if ((++_sp & 255u) == 0u) { if (xb_ld(&(bar)[XB_TMO])) break; if (_sp > XB_SPIN_CAP) { atomicAdd(&(bar)[XB_TMO], 1u); break; } } } } while (0)

struct XcdBarrier {
    unsigned* bar; unsigned x;
    volatile LAS unsigned* st;
};

__device__ __forceinline__ XcdBarrier xcd_barrier_post(unsigned* bar, volatile LAS unsigned* st) {
    XcdBarrier b; b.bar = bar; b.x = xb_xcc_id(); b.st = st;
    if (threadIdx.x == 0) (void)xb_add(&bar[XB_XCNT(b.x)], 1u);
    return b;
}
__device__ __forceinline__ void xcd_barrier_complete(unsigned* bar, unsigned x, unsigned& nloc, unsigned& nx) {
    const unsigned G = gridDim.x * gridDim.y * gridDim.z;
    unsigned sum, cnt, mine, sp = 0u;
    for (;;) {
        sum = 0u; cnt = 0u; mine = 0u;
#pragma unroll
        for (unsigned j = 0; j < 16; ++j) { const unsigned c = xb_ld(&bar[XB_XCNT(j)]); sum += c; cnt += (c > 0u) ? 1u : 0u; mine = (j == x) ? c : mine; }
        if (sum == G) break;
        __builtin_amdgcn_s_sleep(1);
        if ((++sp & 255u) == 0u) { if (xb_ld(&bar[XB_TMO])) break; if (sp > XB_SPIN_CAP) { atomicAdd(&bar[XB_TMO], 1u); break; } }
    }
    nloc = mine > 0u ? mine : 1u; nx = cnt > 0u ? cnt : 1u;
}

__device__ __forceinline__ void xcd_barrier(const XcdBarrier& b) {
    asm volatile("s_waitcnt vmcnt(0)" ::: "memory");
    __syncthreads();
    if (threadIdx.x == 0) {
        unsigned* bar = b.bar;
        __builtin_amdgcn_s_waitcnt(0);
        unsigned nloc = b.st[0], nx = b.st[1];
        if (nloc == 0u) { xcd_barrier_complete(bar, b.x, nloc, nx); b.st[0] = nloc; b.st[1] = nx; }
        const unsigned old = xb_add(&bar[XB_XSUB(b.x)], 1u);
        const unsigned gen = old / nloc;
        if (old + 1u == (gen + 1u) * nloc) {
            __builtin_amdgcn_fence(__ATOMIC_RELEASE, "agent");
            asm volatile("s_waitcnt vmcnt(0)" ::: "memory");
            const unsigned og = xb_add(&bar[XB_TOP], 1u);
            const unsigned tg = og / nx;
            if (og + 1u == (tg + 1u) * nx) xb_add(&bar[XB_TOPGEN], 1u);
            else XB_SPIN(xb_ld(&bar[XB_TOPGEN]) == tg, bar);
            __builtin_amdgcn_fence(__ATOMIC_ACQUIRE, "agent");
            xb_add(&bar[XB_XGEN(b.x)], 1u);
            asm volatile("s_waitcnt vmcnt(0)" ::: "memory");
        } else {
            XB_SPIN(xb_ld(&bar[XB_XGEN(b.x)]) == gen, bar);
            __builtin_amdgcn_fence(__ATOMIC_ACQUIRE, "agent");
            asm volatile("s_waitcnt vmcnt(0)" ::: "memory");
        }
    }
    __syncthreads();
}


__device__ __forceinline__ float wave_sum(float v) {
#pragma unroll
    for (int o = 1; o < 64; o <<= 1) v += __shfl_xor(v, o);
    return v;
}
__device__ __forceinline__ u32x4 pack8(const float* v) { u32x4 w; w.x = cvt_pk_bf16(v[0], v[1]); w.y = cvt_pk_bf16(v[2], v[3]); w.z = cvt_pk_bf16(v[4], v[5]); w.w = cvt_pk_bf16(v[6], v[7]); return w; }
__device__ __forceinline__ void unpack8(const u32x4 w, float* v) { v[0] = bflo(w.x); v[1] = bfhi(w.x); v[2] = bflo(w.y); v[3] = bfhi(w.y); v[4] = bflo(w.z); v[5] = bfhi(w.z); v[6] = bflo(w.w); v[7] = bfhi(w.w); }

template <bool FFNMAP = false> __device__ __forceinline__ void p0_transpose_item(const float* W, const float* gain, int K, int N, bf16_t* WT, LAS float* scr, int item, int lane) {
    const int nblk = N / 32, kb = item / nblk, nb = item % nblk, k0 = 64 * kb, n0 = 32 * nb;
    const int r0 = !FFNMAP ? n0 : (n0 < DFF ? (n0 / 128) * 256 + (n0 % 128) : ((n0 - DFF) / 128) * 256 + 128 + ((n0 - DFF) % 128));
    float tv[32];
#pragma unroll
    for (int i = 0; i < 32; ++i) tv[i] = W[(size_t)(k0 + 2 * i + (lane >> 5)) * N + n0 + (lane & 31)];
#pragma unroll
    for (int i = 0; i < 32; ++i) { const int kk = 2 * i + (lane >> 5); float v = tv[i]; if (gain) v *= gain[k0 + kk]; scr[kk * 33 + (lane & 31)] = v; }
    asm volatile("s_waitcnt lgkmcnt(0)" ::: "memory");
    const int cch = lane & 7;
#pragma unroll
    for (int j = 0; j < 4; ++j) { const int n = (lane >> 3) + 8 * j; const LAS float* s = scr + (8 * cch) * 33 + n;
        u32x4 o; o.x = cvt_pk_bf16(s[0 * 33], s[1 * 33]); o.y = cvt_pk_bf16(s[2 * 33], s[3 * 33]); o.z = cvt_pk_bf16(s[4 * 33], s[5 * 33]); o.w = cvt_pk_bf16(s[6 * 33], s[7 * 33]);
        *(u32x4*)(WT + (size_t)(r0 + n) * K + k0 + 8 * cch) = o; }
    asm volatile("s_waitcnt lgkmcnt(0)" ::: "memory");
}
__device__ __forceinline__ void norm_row_1024(const float* xrow, const float* gain, bf16_t* orow, int lane) {
    const f32x4* xr = (const f32x4*)xrow + lane; const f32x4* gr = (const f32x4*)gain + lane;
    f32x4 v[4]; float s = 0.f;
#pragma unroll
    for (int j = 0; j < 4; ++j) { v[j] = xr[64 * j]; s += (v[j][0] * v[j][0] + v[j][1] * v[j][1]) + (v[j][2] * v[j][2] + v[j][3] * v[j][3]); }
    const float rs = 1.0f / sqrtf(wave_sum(s) * (1.0f / 1024.0f) + EPS);
#pragma unroll
    for (int j = 0; j < 4; ++j) { const f32x4 g = gr[64 * j]; u32x2 w; w.x = cvt_pk_bf16(v[j][0] * rs * g[0], v[j][1] * rs * g[1]); w.y = cvt_pk_bf16(v[j][2] * rs * g[2], v[j][3] * rs * g[3]);
        *((u32x2*)orow + lane + 64 * j) = w; }
}
__device__ __forceinline__ void norm_row2_1024(const float* xa, const float* xb2, const float* gain, bf16_t* oa, bf16_t* ob, int lane) {
    const f32x4* pa = (const f32x4*)xa + lane; const f32x4* pb = (const f32x4*)xb2 + lane; const f32x4* gr = (const f32x4*)gain + lane;
    f32x4 va[4], vb[4]; float sa = 0.f, sb = 0.f;
#pragma unroll
    for (int j = 0; j < 4; ++j) { va[j] = pa[64 * j]; vb[j] = pb[64 * j]; }
#pragma unroll
    for (int j = 0; j < 4; ++j) { sa += (va[j][0] * va[j][0] + va[j][1] * va[j][1]) + (va[j][2] * va[j][2] + va[j][3] * va[j][3]); sb += (vb[j][0] * vb[j][0] + vb[j][1] * vb[j][1]) + (vb[j][2] * vb[j][2] + vb[j][3] * vb[j][3]); }
#pragma unroll
    for (int o = 1; o < 64; o <<= 1) { sa += __shfl_xor(sa, o); sb += __shfl_xor(sb, o); }
    const float ra = 1.0f / sqrtf(sa * (1.0f / 1024.0f) + EPS), rb = 1.0f / sqrtf(sb * (1.0f / 1024.0f) + EPS);
#pragma unroll
    for (int j = 0; j < 4; ++j) { const f32x4 g = gr[64 * j]; u32x2 w;
        w.x = cvt_pk_bf16(va[j][0] * ra * g[0], va[j][1] * ra * g[1]); w.y = cvt_pk_bf16(va[j][2] * ra * g[2], va[j][3] * ra * g[3]); *((u32x2*)oa + lane + 64 * j) = w;
        w.x = cvt_pk_bf16(vb[j][0] * rb * g[0], vb[j][1] * rb * g[1]); w.y = cvt_pk_bf16(vb[j][2] * rb * g[2], vb[j][3] * rb * g[3]); *((u32x2*)ob + lane + 64 * j) = w; }
}
__device__ __forceinline__ void phase0(Ctx& c, const Args& args) {
    LAS float* scr = (LAS float*)(c.lds + c.wave * 16384);
    const int gw = c.bid * NWAVES + c.wave, NGW = c.G * NWAVES;
    constexpr int I_IN = 16 * 45, I_UQ = 4 * 24, I_UKV = 2 * 32, I_OUT = 16 * 32, I_MQ = 16 * 16, I_MKV = 16 * 32, I_MO = 8 * 32, I_UP = 16 * 176, I_DN = 44 * 32;
    constexpr int NITEMS = I_IN + I_MKV;
    const int hw = c.bid * 4 + (c.wave & 3), NHW = c.G * 4;
    if (c.wave < 4) for (int it = hw; it < NITEMS; it += NHW) {
        int r = it;
        if (r < I_IN) { p0_transpose_item(((const float*)args.in[4]), nullptr, 1024, IN_COLS, WSP(bf16_t, WS_WIN), scr, r, c.lane); continue; } r -= I_IN;
        p0_transpose_item(((const float*)args.in[24]), nullptr, 1024, 1024, WSP(bf16_t, WS_WMKV), scr, r, c.lane);
    }
    constexpr int PSPLIT = 4864;
    for (int p = (c.wave < 4 ? PSPLIT : 0) + hw; p < (c.wave < 4 ? T / 2 : PSPLIT); p += NHW) { const int m = 2 * p; norm_row2_1024(((const float*)args.in[0]) + (size_t)m * DM, ((const float*)args.in[0]) + (size_t)(m + 1) * DM, ((const float*)args.in[3]), WSP(bf16_t, WS_XB) + (size_t)m * DM, WSP(bf16_t, WS_XB) + (size_t)(m + 1) * DM, c.lane); }
    if (c.wave >= 4) { for (int m = 2 * T; m < T; m += 2 * NHW) norm_row2_1024(((const float*)args.in[0]) + (size_t)m * DM, ((const float*)args.in[0]) + (size_t)(m + 1) * DM, ((const float*)args.in[3]), WSP(bf16_t, WS_XB) + (size_t)m * DM, WSP(bf16_t, WS_XB) + (size_t)(m + 1) * DM, c.lane);
           for (int m = hw; m < TM; m += NHW) norm_row_1024(((const float*)args.in[1]) + (size_t)m * DM, ((const float*)args.in[22]), WSP(bf16_t, WS_MEMN) + (size_t)m * DM, c.lane); }
    const int gt = c.bid * NTHR + c.tid, NGT = c.G * NTHR;
    for (int i = gt; i < (PROJ_LD - IN_COLS) * 1024 / 8; i += NGT) *((u32x4*)(WSP(bf16_t, WS_WIN) + (size_t)IN_COLS * 1024) + i) = (u32x4){0u, 0u, 0u, 0u};
}

__device__ __forceinline__ void phase2(Ctx& c, const Args& args) {
    const int gw = c.bid * NWAVES + c.wave, NGW = c.G * NWAVES, lane = c.lane;
    const bf16_t* __restrict__ proj = WSP(bf16_t, WS_PROJ);
    bf16_t* __restrict__ cqo = WSP(bf16_t, WS_CQ); bf16_t* __restrict__ ckvo = WSP(bf16_t, WS_CKV); bf16_t* __restrict__ xco = WSP(bf16_t, WS_XC);
    const int ch = lane * 8;
    float wf[4][8], wb[4][8], bf_[8], bb_[8];
#pragma unroll
    for (int e = 0; e < 8; ++e) { bf_[e] = ((const float*)args.in[6])[ch + e]; bb_[e] = ((const float*)args.in[6])[512 + ch + e];
#pragma unroll
        for (int k = 0; k < 4; ++k) { wf[k][e] = ((const float*)args.in[5])[(0 * 4 + k) * 512 + ch + e]; wb[k][e] = ((const float*)args.in[5])[(1 * 4 + k) * 512 + ch + e]; } }
    const f32x4 gq = *(const f32x4*)(((const float*)args.in[12]) + lane * 4); const float gkv0 = ((const float*)args.in[14])[lane * 2], gkv1 = ((const float*)args.in[14])[lane * 2 + 1];
    for (int row = gw; row < T; row += NGW) {
        const bf16_t* pr = proj + (size_t)row * PROJ_LD;
        const int t = row & (SEQ - 1);
        u32x4 xr[7];
#pragma unroll
        for (int dt = -3; dt <= 3; ++dt) { const int tt = t + dt; xr[dt + 3] = (tt >= 0 && tt < SEQ) ? *(const u32x4*)(pr + (long)dt * PROJ_LD + ch) : (u32x4){0u, 0u, 0u, 0u}; }
        const u32x2 wq = *(const u32x2*)(pr + 1024 + lane * 4); const unsigned wk = *(const unsigned*)(pr + 1280 + lane * 2);
        {
            float v[4] = {bflo(wq.x), bfhi(wq.x), bflo(wq.y), bfhi(wq.y)}; const float v0 = bflo(wk), v1 = bfhi(wk);
            float sq = (v[0] * v[0] + v[1] * v[1]) + (v[2] * v[2] + v[3] * v[3]), sk = v0 * v0 + v1 * v1;
#pragma unroll
            for (int o = 1; o < 64; o <<= 1) { sq += __shfl_xor(sq, o); sk += __shfl_xor(sk, o); }
            const float rq = 1.0f / sqrtf(sq * (1.0f / 256.0f) + EPS), rk = 1.0f / sqrtf(sk * (1.0f / 128.0f) + EPS);
            u32x2 o; o.x = cvt_pk_bf16(v[0] * rq * gq[0], v[1] * rq * gq[1]); o.y = cvt_pk_bf16(v[2] * rq * gq[2], v[3] * rq * gq[3]);
            *(u32x2*)(cqo + (size_t)row * 256 + lane * 4) = o;
            *(unsigned*)(ckvo + (size_t)row * 128 + lane * 2) = cvt_pk_bf16(v0 * rk * gkv0, v1 * rk * gkv1);
        }
        {
            float xs[7][8];
#pragma unroll
            for (int i = 0; i < 7; ++i) unpack8(xr[i], xs[i]);
            float of[8], ob[8];
#pragma unroll
            for (int e = 0; e < 8; ++e) { of[e] = bf_[e]; ob[e] = bb_[e]; }
#pragma unroll
            for (int k = 0; k < 4; ++k)
#pragma unroll
                for (int e = 0; e < 8; ++e) { of[e] += wf[k][e] * xs[k][e]; ob[e] += wb[k][e] * xs[3 + k][e]; }
            *(u32x4*)(xco + (size_t)row * 512 + ch) = pack8(of);
            *(u32x4*)(xco + ((size_t)T + row) * 512 + ch) = pack8(ob);
        }
    }
    for (int row = gw; row < TM; row += NGW) {
        bf16_t* kp = WSP(bf16_t, WS_MEMKV) + (size_t)row * 1024 + lane * 8; float v[8]; unpack8(*(const u32x4*)kp, v);
        float s = 0.f;
#pragma unroll
        for (int e = 0; e < 8; ++e) s += v[e] * v[e];
        s += __shfl_xor(s, 1); s += __shfl_xor(s, 2); s += __shfl_xor(s, 4); s += __shfl_xor(s, 8);
        const float rs = 1.0f / sqrtf(s * (1.0f / 128.0f) + EPS);
#pragma unroll
        for (int e = 0; e < 8; ++e) v[e] *= rs * ((const float*)args.in[26])[(lane & 15) * 8 + e];
        *(u32x4*)kp = pack8(v);
    }
}

struct KPrep { float gnk[8], grk1[2], grk2[2], invf[2]; };
__device__ __forceinline__ KPrep kprep_init(const Args& args, int sub) {
    KPrep k;
#pragma unroll
    for (int e = 0; e < 8; ++e) k.gnk[e] = ((const float*)args.in[17])[sub * 8 + e];
#pragma unroll
    for (int jj = 0; jj < 2; ++jj) { k.grk1[jj] = ((const float*)args.in[17])[64 + 2 * sub + jj]; k.grk2[jj] = ((const float*)args.in[17])[80 + 2 * sub + jj]; k.invf[jj] = exp2f(-(float)(2 * sub + jj) * 0.8304820237218406f); }
    return k;
}
__device__ __forceinline__ void kprep_rowhead(const Args& args, const KPrep& k, int row, int h, int sub) {
    const bf16_t* __restrict__ proj = WSP(bf16_t, WS_PROJ); const bf16_t* __restrict__ kvraw = WSP(bf16_t, WS_KVRAW); bf16_t* __restrict__ Kn = WSP(bf16_t, WS_KN);
    const bf16_t* kp = kvraw + (size_t)row * 1024 + h * 128; const bf16_t* rp = proj + (size_t)row * PROJ_LD + 1408 + 2 * sub;
    const u32x4 kv = *(const u32x4*)(kp + sub * 8);
    const unsigned k1 = *(const unsigned*)rp, k2 = *(const unsigned*)(rp + 16);
    const float posf = (float)((const int*)args.in[2])[row]; float cs[2], sn[2];
#pragma unroll
    for (int jj = 0; jj < 2; ++jj) { const float ang = posf * k.invf[jj]; const double rev = (double)ang * 0.15915494309189535; const float fr = (float)(rev - rint(rev));
        cs[jj] = __builtin_amdgcn_cosf(fr); sn[jj] = __builtin_amdgcn_sinf(fr); }
    float vk[8]; unpack8(kv, vk);
    float tk1[2] = {bflo(k1), bfhi(k1)}, tk2[2] = {bflo(k2), bfhi(k2)};
    float sk = (tk1[0] * tk1[0] + tk1[1] * tk1[1]) + (tk2[0] * tk2[0] + tk2[1] * tk2[1]);
#pragma unroll
    for (int e = 0; e < 8; ++e) sk += vk[e] * vk[e];
#pragma unroll
    for (int o = 1; o < 8; o <<= 1) sk += __shfl_xor(sk, o);
    const float rk = 1.0f / sqrtf(sk * (1.0f / 96.0f) + EPS);
#pragma unroll
    for (int e = 0; e < 8; ++e) vk[e] *= rk * k.gnk[e];
    float ok1[2], ok2[2];
#pragma unroll
    for (int jj = 0; jj < 2; ++jj) { const float b1 = tk1[jj] * rk * k.grk1[jj], b2 = tk2[jj] * rk * k.grk2[jj]; ok1[jj] = b1 * cs[jj] - b2 * sn[jj]; ok2[jj] = b1 * sn[jj] + b2 * cs[jj]; }
    bf16_t* ok = Kn + ((size_t)((row >> 13) * 8 + h) * SEQ + (row & (SEQ - 1))) * 96;
    *(u32x4*)(ok + sub * 8) = pack8(vk); *(unsigned*)(ok + 64 + 2 * sub) = cvt_pk_bf16(ok1[0], ok1[1]); *(unsigned*)(ok + 80 + 2 * sub) = cvt_pk_bf16(ok2[0], ok2[1]);
}

__device__ __forceinline__ float gelu_tanh(float y) { const float u = 0.7978845608028654f * (y + 0.044715f * y * y * y); const float th = 1.0f - 2.0f / (__expf(2.0f * u) + 1.0f); return 0.5f * y * (1.0f + th); }
__device__ __forceinline__ void phase6(Ctx& c, const Args& args) {
    const unsigned* Gt = (const unsigned*)args.out; const float2* agg = WSP(float2, WS_AGG); const bf16_t* proj = WSP(bf16_t, WS_PROJ);
    LAS float* hl = (LAS float*)c.lds;
    bf16_t* amix = WSP(bf16_t, WS_AMIX); const bf16_t* mla = WSP(bf16_t, WS_MLA);
    const int ch = c.tid;
    for (int chunk = c.bid; chunk < 256; chunk += c.G) {
        const int b = chunk >> 7, cc = chunk & 127;
        float cf = 0.f, cb = 0.f;
#pragma unroll 1
        for (int q0 = 0; q0 < 128; q0 += 32) {
            float2 af[32], ab[32];
#pragma unroll
            for (int k = 0; k < 32; ++k) { af[k] = agg[((size_t)b * 128 + q0 + k) * 512 + ch]; ab[k] = agg[((size_t)256 + b * 128 + 127 - (q0 + k)) * 512 + ch]; }
#pragma unroll
            for (int k = 0; k < 32; ++k) { const int q = q0 + k; if (q < cc) cf = __expf(af[k].x) * cf + af[k].y; if (127 - q > cc) cb = __expf(ab[k].x) * cb + ab[k].y; }
        }
        const size_t row0 = (size_t)chunk * 64;
        { const unsigned* gp = Gt + row0 * 512 + ch; float hcur = cf;
#pragma unroll 1
          for (int i0 = 0; i0 < 64; i0 += 32) { unsigned wv[32];
#pragma unroll
              for (int k = 0; k < 32; ++k) wv[k] = gp[(size_t)(i0 + k) * 512];
#pragma unroll
              for (int k = 0; k < 32; ++k) { hcur = __expf(bflo(wv[k])) * hcur + bfhi(wv[k]); hl[(i0 + k) * 512 + ch] = hcur; } } }
        { const unsigned* gp = Gt + ((size_t)T + row0) * 512 + ch; const bf16_t* yp = proj + row0 * PROJ_LD + 512 + ch; float hcur = cb;
#pragma unroll 1
          for (int i0 = 63; i0 >= 0; i0 -= 32) { unsigned wv[32]; bf16_t yv[32];
#pragma unroll
              for (int k = 0; k < 32; ++k) { wv[k] = gp[(size_t)(i0 - k) * 512]; yv[k] = yp[(size_t)(i0 - k) * PROJ_LD]; }
#pragma unroll
              for (int k = 0; k < 32; ++k) { const int i = i0 - k; hcur = __expf(bflo(wv[k])) * hcur + bfhi(wv[k]); hl[i * 512 + ch] = (hl[i * 512 + ch] + hcur) * gelu_tanh(bf2f(yv[k])); } } }
        __syncthreads();
        { const bf16_t* __restrict__ mlar = mla; bf16_t* __restrict__ amo = amix; float gl[8], gm[8]; u32x4 mv[8];
#pragma unroll
          for (int e = 0; e < 8; ++e) { gl[e] = ((const float*)args.in[18])[c.lane * 8 + e]; gm[e] = ((const float*)args.in[19])[c.lane * 8 + e]; }
#pragma unroll
          for (int rr = 0; rr < 8; ++rr) mv[rr] = *(const u32x4*)(mlar + (row0 + c.wave * 8 + rr) * 512 + c.lane * 8);
#pragma unroll
          for (int rr = 0; rr < 8; ++rr) { const int r = c.wave * 8 + rr; const size_t row = row0 + r;
            float v[8], w[8]; { const LAS f32x4* p = (const LAS f32x4*)(hl + r * 512 + c.lane * 8); const f32x4 a = p[0], bq = p[1]; v[0] = a[0]; v[1] = a[1]; v[2] = a[2]; v[3] = a[3]; v[4] = bq[0]; v[5] = bq[1]; v[6] = bq[2]; v[7] = bq[3]; }
            unpack8(mv[rr], w);
            float s = 0.f, s2 = 0.f;
#pragma unroll
            for (int e = 0; e < 8; ++e) { s += v[e] * v[e]; s2 += w[e] * w[e]; }
#pragma unroll
            for (int o = 1; o < 64; o <<= 1) { s += __shfl_xor(s, o); s2 += __shfl_xor(s2, o); }
            const float rs = 1.0f / sqrtf(s * (1.0f / 512.0f) + EPS), rs2 = 1.0f / sqrtf(s2 * (1.0f / 512.0f) + EPS);
#pragma unroll
            for (int e = 0; e < 8; ++e) { v[e] *= rs * gl[e]; w[e] *= rs2 * gm[e]; }
            *(u32x4*)(amo + row * 1024 + c.lane * 8) = pack8(v);
            *(u32x4*)(amo + row * 1024 + 512 + c.lane * 8) = pack8(w); } }
        __syncthreads();
    }
}

typedef float f32x2 __attribute__((ext_vector_type(2)));
__device__ __forceinline__ void unpack8v(const u32x4 w, f32x2* v) { v[0] = (f32x2){bflo(w.x), bfhi(w.x)}; v[1] = (f32x2){bflo(w.y), bfhi(w.y)}; v[2] = (f32x2){bflo(w.z), bfhi(w.z)}; v[3] = (f32x2){bflo(w.w), bfhi(w.w)}; }
__device__ __forceinline__ void phase12(Ctx& c, const Args& args, int bsel) {
    const bf16_t* __restrict__ gu = WSP(bf16_t, WS_GU); bf16_t* __restrict__ hid = WSP(bf16_t, WS_HID) + (size_t)bsel * SEQ * DFF;
    const float* __restrict__ cw = ((const float*)args.in[30]); const float* __restrict__ cb = ((const float*)args.in[31]);
    if (c.tid >= DFF / 8) return;
    const int j = c.tid * 8;
    f32x2 wg[3][4], wu[3][4], bg[4], bu[4];
#pragma unroll
    for (int e = 0; e < 4; ++e) { bg[e] = *(const f32x2*)(cb + j + 2 * e); bu[e] = *(const f32x2*)(cb + DFF + j + 2 * e);
#pragma unroll
        for (int k = 0; k < 3; ++k) { wg[k][e] = *(const f32x2*)(cw + (size_t)k * DFF2 + j + 2 * e); wu[k][e] = *(const f32x2*)(cw + (size_t)k * DFF2 + DFF + j + 2 * e); } }
    for (int chunk = c.bid; chunk < SEQ / 32; chunk += c.G) {
        const int t0 = chunk * 32;
        u32x4 rg[4], ru[4];
        const u32x4 z4 = (u32x4){0u, 0u, 0u, 0u};
#define P12_LOAD(s, k) do { const int tt_ = t0 - 1 + (s); if (tt_ >= 0 && tt_ < SEQ && (s) < 34) { rg[k] = *(const u32x4*)(gu + (size_t)tt_ * DFF2 + j); ru[k] = *(const u32x4*)(gu + (size_t)tt_ * DFF2 + DFF + j); } else { rg[k] = z4; ru[k] = z4; } } while (0)
#pragma unroll
        for (int k = 0; k < 4; ++k) P12_LOAD(k, k);
        f32x2 wing[3][4], winu[3][4];
#pragma unroll 1
        for (int s0 = 0; s0 < 36; s0 += 12) {
#pragma unroll
            for (int k = 0; k < 12; ++k) { const int s = s0 + k; constexpr int dummy = 0; (void)dummy;
                const int sn = k % 3, sq = (k + 2) % 3, sp = (k + 1) % 3;
                unpack8v(rg[k & 3], wing[sn]); unpack8v(ru[k & 3], winu[sn]);
                P12_LOAD(s + 4, k & 3);
                if (s >= 2 && s < 34) { u32x4 o; unsigned ow[4];
#pragma unroll
                    for (int e = 0; e < 4; ++e) { const f32x2 G = bg[e] + wg[0][e] * wing[sp][e] + wg[1][e] * wing[sq][e] + wg[2][e] * wing[sn][e]; const f32x2 U = bu[e] + wu[0][e] * winu[sp][e] + wu[1][e] * winu[sq][e] + wu[2][e] * winu[sn][e];
                        const f32x2 a = G * (-1.4426950408889634f); f32x2 d; d.x = __builtin_amdgcn_exp2f(a.x); d.y = __builtin_amdgcn_exp2f(a.y); d = d + 1.0f;
                        f32x2 r; r.x = __builtin_amdgcn_rcpf(d.x); r.y = __builtin_amdgcn_rcpf(d.y); const f32x2 h = G * r * U; ow[e] = cvt_pk_bf16(h.x, h.y); }
                    o.x = ow[0]; o.y = ow[1]; o.z = ow[2]; o.w = ow[3];
                    *(u32x4*)(hid + (size_t)(t0 + s - 2) * DFF + j) = o; } }
        }
#undef P12_LOAD
    }
}

template <class Epi, class Sched> __device__ __forceinline__ void run_gemm(Ctx& c, const pg8::Gemm g, const Sched& S, const Epi& E) {
#if FAST_GEMM
    pg8::gemm_phase<Epi, Sched, true, true>(c.lds, g, S, E);
#else
    pg8::gemm_naive<Epi, Sched>(g, S, E);
#endif
}
__device__ __forceinline__ pg8::Sched2 sched1(Ctx& c, const void* A, const void* B, int nM, int nN, int lda, int ldb) {
    pg8::Sched2 s; s.a = pg8::Job{(const char*)A, (const char*)B, nM, nN}; s.b = pg8::Job{nullptr, nullptr, 0, 0}; s.G = c.G; s.c = c.bid; s.lda = lda; s.ldb = ldb; return s;
}
template <int DQK, int DV, bool QNORM, bool FIXED> __device__ __forceinline__ void run_attn(Ctx& c, const bf16_t* Qb, int ldq, const bf16_t* Kh, int ldk, const bf16_t* Vh, int ldv, bf16_t* Ob, int ldo, int seq, float scale, const float* qg, const int* qpos) {
    att::attn_unit<DQK, DV, QNORM, FIXED>(Qb, ldq, Kh, ldk, Vh, ldv, Ob, ldo, seq, scale, qg, qpos, c.ldsg);
}

__device__ __forceinline__ void p3_small_weights(Ctx& c, const Args& args, int wave0, int nwaves) {
    LAS float* scr = (LAS float*)(c.lds + c.wave * 16384); constexpr int I_UQ = 4 * 24, I_UKV = 2 * 32;
    for (int it = wave0; it < I_UQ + I_UKV; it += nwaves) {
        if (it < I_UQ) p0_transpose_item(((const float*)args.in[13]), nullptr, 256, 768, WSP(bf16_t, WS_WUQ), scr, it, c.lane);
        else p0_transpose_item(((const float*)args.in[15]), nullptr, 128, 1024, WSP(bf16_t, WS_WUKV), scr, it - I_UQ, c.lane); }
    const int gt = wave0 * 64 + c.lane, NGT = nwaves * 64;
    for (int i = gt; i < 8 * 256 * 128; i += NGT) {
        const int k = i & 127, n = (i >> 7) & 255, grp = i >> 15, d = grp >> 2, png = grp & 3;
        const int gate = n >> 7, cl = n & 127, blk_n = cl >> 6, dout = cl & 63, blk_k = k >> 6, cin = k & 63;
        float v = 0.f;
        if (blk_n == blk_k) { const float* W = gate ? ((const float*)args.in[9]) : ((const float*)args.in[7]); v = W[((size_t)(d * 8 + png * 2 + blk_n) * 64 + cin) * 64 + dout]; }
        WSP(bf16_t, WS_WG)[i] = (bf16_t)(cvt_pk_bf16(v, 0.f) & 0xffffu);
    }
    for (int i = gt; i < 1024; i += NGT) WSP(float, 0)[i] = -8.0f * log1pf(expf(-((const float*)args.in[11])[i]));
}
__device__ __forceinline__ void ph1(Ctx& c, const Args& args) {
    pg8::Sched2 S; S.a = pg8::Job{(const char*)WSP(bf16_t, WS_XB), (const char*)WSP(bf16_t, WS_WIN), T / 256, PROJ_LD / 256};
    S.b = pg8::Job{(const char*)WSP(bf16_t, WS_MEMN), (const char*)WSP(bf16_t, WS_WMKV), TM / 256, 4}; S.G = c.G; S.c = c.bid; S.lda = 1024; S.ldb = 1024;
    pg8::EpiBf<false> E{WSP(bf16_t, WS_PROJ), PROJ_LD, WSP(bf16_t, WS_MEMKV), 1024, nullptr, nullptr};
    run_gemm(c, pg8::Gemm{1024, 1024, 1024}, S, E);
    constexpr int NU1 = (T / 256) * (PROJ_LD / 256) + (TM / 256) * 4;
    const int idle0 = NU1 - c.G; __syncthreads();
    if (c.G < NU1 && idle0 > 0 && idle0 < c.G) { if (c.bid >= idle0) p3_small_weights(c, args, (c.bid - idle0) * NWAVES + c.wave, (c.G - idle0) * NWAVES); }
    else p3_small_weights(c, args, c.bid * NWAVES + c.wave, c.G * NWAVES);
}
__device__ __forceinline__ void ph3_weights(Ctx& c, const Args& args, int first, int stride) {
    constexpr int I_OUT = 16 * 32, I_MQ = 16 * 16, I_MO = 8 * 32; LAS float* scr = (LAS float*)(c.lds + c.wave * 16384);
    for (int it = first; it < I_OUT + I_MQ + I_MO; it += stride) {
        if (it < I_OUT) p0_transpose_item(((const float*)args.in[20]), nullptr, 1024, 1024, WSP(bf16_t, WS_WOUT), scr, it, c.lane);
        else if (it < I_OUT + I_MQ) p0_transpose_item(((const float*)args.in[23]), ((const float*)args.in[21]), 1024, 512, WSP(bf16_t, WS_WMQ), scr, it - I_OUT, c.lane);
        else p0_transpose_item(((const float*)args.in[27]), nullptr, 512, 1024, WSP(bf16_t, WS_WMO), scr, it - I_OUT - I_MQ, c.lane); }
    __syncthreads();
}
__device__ __forceinline__ void ph3(Ctx& c, const Args& args) {
    { constexpr int NQ = (T / 256) * 3;
      if (c.G > NQ) { if (c.bid >= NQ) ph3_weights(c, args, (c.bid - NQ) * NWAVES + c.wave, (c.G - NQ) * NWAVES); }
      else ph3_weights(c, args, c.bid * NWAVES + c.wave, c.G * NWAVES); }
    { pg8::Sched2 S = sched1(c, WSP(bf16_t, WS_CQ), WSP(bf16_t, WS_WUQ), T / 256, 3, 256, 256); pg8::EpiBf<false> E{WSP(bf16_t, WS_QRAW), 768, nullptr, 0, nullptr, nullptr}; run_gemm(c, pg8::Gemm{256, 256, 256}, S, E); }
    { pg8::Sched2 S = sched1(c, WSP(bf16_t, WS_CKV), WSP(bf16_t, WS_WUKV), T / 256, 4, 128, 128); pg8::EpiBf<false> E{WSP(bf16_t, WS_KVRAW), 1024, nullptr, 0, nullptr, nullptr}; run_gemm(c, pg8::Gemm{128, 128, 128}, S, E);
      asm volatile("s_waitcnt vmcnt(0)" ::: "memory"); __syncthreads();
      const int sub = c.tid & 7; const KPrep kp_ = kprep_init(args, sub); pg8::Unit u;
      for (int i = 0; S.next(i, u); ++i)
#pragma unroll 2
          for (int p = 0; p < 8; ++p) { const int pi = p * 64 + (c.tid >> 3); kprep_rowhead(args, kp_, u.pm * 256 + (pi >> 1), 2 * u.pn + (pi & 1), sub); } }
    { pg8::GateOrder S{(const char*)WSP(bf16_t, WS_XC), (const char*)WSP(bf16_t, WS_WG), (size_t)T * 512 * 2, c.G, c.bid};
      pg8::EpiGates E{WSP(bf16_t, WS_XC), ((const float*)args.in[8]), ((const float*)args.in[10]), WSP(float, 0), (unsigned*)args.out, T}; run_gemm(c, pg8::Gemm{128, 512, 128}, S, E);
      asm volatile("s_waitcnt vmcnt(0)" ::: "memory"); __syncthreads();
      const unsigned* Gt = (const unsigned*)args.out; float2* agg = WSP(float2, WS_AGG); pg8::Unit u;
      for (int i = 0; S.next(i, u); ++i) { const int d = u.job, chunk = u.pm * 4 + (c.tid >> 7), ch = u.pn * 128 + (c.tid & 127);
          const unsigned* gp = Gt + ((size_t)d * T + (size_t)chunk * 64) * 512 + ch;
          float sl = 0.f, bv = 0.f; unsigned wv[64];
#pragma unroll
          for (int k = 0; k < 64; ++k) wv[k] = gp[(size_t)(d ? 63 - k : k) * 512];
#pragma unroll
          for (int k = 0; k < 64; ++k) { const float la = bflo(wv[k]); sl += la; bv = __expf(la) * bv + bfhi(wv[k]); }
          agg[((size_t)d * 256 + chunk) * 512 + ch] = make_float2(sl, bv); } }
}
__device__ __forceinline__ void ph5(Ctx& c, const Args& args) {
    float gq = 0.f, gk = 0.f;
    for (int i = c.lane; i < 96; i += 64) { gq = fmaxf(gq, fabsf(((const float*)args.in[16])[i])); gk = fmaxf(gk, fabsf(((const float*)args.in[17])[i])); }
#pragma unroll
    for (int o = 1; o < 64; o <<= 1) { gq = fmaxf(gq, __shfl_xor(gq, o)); gk = fmaxf(gk, __shfl_xor(gk, o)); }
    const bool bounded = __builtin_amdgcn_readfirstlane((int)(9.797958971f * 1.02f * gq * gk * 1.4426950408889634f <= 60.0f)) != 0;
    for (int L = c.bid; L < 512; L += c.G) { const int bh = (L >> 8) * 8 + (L & 7), qb = (L & 255) >> 3; const int b = bh >> 3, h = bh & 7;
        const bf16_t* Qp = WSP(bf16_t, WS_QRAW) + ((size_t)b * SEQ + qb * 256) * 768 + h * 96; const int* qpos = ((const int*)args.in[2]) + (size_t)b * SEQ + qb * 256; const bf16_t* Kp = WSP(bf16_t, WS_KN) + (size_t)(b * 8 + h) * SEQ * 96;
        const bf16_t* Vp = WSP(bf16_t, WS_KVRAW) + (size_t)b * SEQ * 1024 + h * 128 + 64; bf16_t* Op = WSP(bf16_t, WS_MLA) + ((size_t)b * SEQ + qb * 256) * 512 + h * 64;
        if (bounded) run_attn<96, 64, true, true>(c, Qp, 768, Kp, 96, Vp, 1024, Op, 512, SEQ, 0.10206207261596575f, ((const float*)args.in[16]), qpos);
        else run_attn<96, 64, true, false>(c, Qp, 768, Kp, 96, Vp, 1024, Op, 512, SEQ, 0.10206207261596575f, ((const float*)args.in[16]), qpos); }
}
__device__ __forceinline__ void ph7(Ctx& c, const Args& args) {
    pg8::Sched2 S = sched1(c, WSP(bf16_t, WS_AMIX), WSP(bf16_t, WS_WOUT), T / 256, 4, 1024, 1024); pg8::EpiResid<true, false> E{((const float*)args.in[0]), nullptr, nullptr, WSP(bf16_t, WS_XB), WSP(float, WS_SS)};
    run_gemm(c, pg8::Gemm{1024, 1024, 1024}, S, E);
}
__device__ __forceinline__ void ph8(Ctx& c, const Args& args) {
    constexpr int NU = (T / 256) * 2;
    if (c.bid >= NU && c.G > NU) {
        LAS float* scr = (LAS float*)(c.lds + c.wave * 16384);
        constexpr int I_UP = 16 * 176, I_DN = 44 * 32;
        const int hw = (c.bid - NU) * NWAVES + c.wave, NHW = (c.G - NU) * NWAVES;
        for (int it = hw; it < I_UP + I_DN; it += NHW) {
            if (it < I_UP) p0_transpose_item<true>(((const float*)args.in[29]), ((const float*)args.in[28]), 1024, DFF2, WSP(bf16_t, WS_WUP), scr, it, c.lane);
            else p0_transpose_item(((const float*)args.in[32]), nullptr, DFF, 1024, WSP(bf16_t, WS_WDN), scr, it - I_UP, c.lane);
        }
        return;
    }
    pg8::Sched2 S = sched1(c, WSP(bf16_t, WS_XB), WSP(bf16_t, WS_WMQ), T / 256, 2, 1024, 1024);
    LAS float* rsl = (LAS float*)(c.lds + 131072); bool one_unit;
    { pg8::Unit u0, u1; const bool h0 = S.next(0, u0); one_unit = h0 && !S.next(1, u1); if (one_unit && c.tid < 256) rsl[c.tid] = pg8::rowscale16(WSP(float, WS_SS), u0.pm * 256 + c.tid); __syncthreads(); }
    pg8::EpiBf<true> E{WSP(bf16_t, WS_QMEM), 512, nullptr, 0, WSP(float, WS_SS), one_unit ? rsl : nullptr};
    run_gemm(c, pg8::Gemm{1024, 1024, 1024}, S, E);
    if (c.G <= NU) {
        LAS float* scr = (LAS float*)(c.lds + c.wave * 16384); constexpr int I_UP = 16 * 176, I_DN = 44 * 32;
        __syncthreads();
        for (int it = c.bid * NWAVES + c.wave; it < I_UP + I_DN; it += c.G * NWAVES) {
            if (it < I_UP) p0_transpose_item<true>(((const float*)args.in[29]), ((const float*)args.in[28]), 1024, DFF2, WSP(bf16_t, WS_WUP), scr, it, c.lane);
            else p0_transpose_item(((const float*)args.in[32]), nullptr, DFF, 1024, WSP(bf16_t, WS_WDN), scr, it - I_UP, c.lane);
        }
    }
}
__device__ __forceinline__ void ph9(Ctx& c, const Args& args) {
    float gq = 0.f, gk = 0.f;
    for (int i = c.lane; i < 128; i += 64) { gq = fmaxf(gq, fabsf(((const float*)args.in[25])[i])); gk = fmaxf(gk, fabsf(((const float*)args.in[26])[i])); }
#pragma unroll
    for (int o = 1; o < 64; o <<= 1) { gq = fmaxf(gq, __shfl_xor(gq, o)); gk = fmaxf(gk, __shfl_xor(gk, o)); }
    const bool bounded = __builtin_amdgcn_readfirstlane((int)(11.313708499f * 1.02f * gq * gk * 1.4426950408889634f <= 60.0f)) != 0;
    for (int L = c.bid; L < 256; L += c.G) { const int rb = L >> 2, h = L & 3, b = rb >> 5;
        const bf16_t* Qp = WSP(bf16_t, WS_QMEM) + (size_t)rb * 256 * 512 + h * 128; const bf16_t* Kp = WSP(bf16_t, WS_MEMKV) + (size_t)b * MEMLEN * 1024 + h * 128;
        const bf16_t* Vp = WSP(bf16_t, WS_MEMKV) + (size_t)b * MEMLEN * 1024 + 512 + h * 128; bf16_t* Op = WSP(bf16_t, WS_OMEM) + (size_t)rb * 256 * 512 + h * 128;
        if (bounded) run_attn<128, 128, true, true>(c, Qp, 512, Kp, 1024, Vp, 1024, Op, 512, MEMLEN, 0.08838834764831845f, ((const float*)args.in[25]), nullptr);
        else run_attn<128, 128, true, false>(c, Qp, 512, Kp, 1024, Vp, 1024, Op, 512, MEMLEN, 0.08838834764831845f, ((const float*)args.in[25]), nullptr); }
}
__device__ __forceinline__ void ph10(Ctx& c, const Args& args) {
    pg8::Sched2 S = sched1(c, WSP(bf16_t, WS_OMEM), WSP(bf16_t, WS_WMO), T / 256, 4, 512, 512); pg8::EpiResid<false, false> E{nullptr, WSP(bf16_t, WS_XB), nullptr, WSP(bf16_t, WS_XB), WSP(float, WS_SS)};
    run_gemm(c, pg8::Gemm{512, 512, 512}, S, E);
}
__device__ __forceinline__ void ph11(Ctx& c, const Args& args) {
    pg8::FfnOrder S{(const char*)WSP(bf16_t, WS_XB), (const char*)WSP(bf16_t, WS_WUP), c.G, c.bid};
    LAS float* rsl = (LAS float*)(c.lds + 131072 + 8192 + 4096);
    { pg8::Unit u;
      for (int i = 0; i < 6 && S.next(i, u); ++i) { const int b = u.pm / 33, pmb = u.pm - 33 * b;
          if (c.tid < 256) { const int tl = 254 * pmb - 1 + c.tid; rsl[i * 256 + c.tid] = (tl >= 0 && tl < SEQ) ? pg8::rowscale16(WSP(float, WS_SS), b * SEQ + tl) : 0.f; } }
      __syncthreads(); }
    pg8::EpiFfn E{WSP(float, WS_SS), ((const float*)args.in[30]), ((const float*)args.in[31]), WSP(bf16_t, WS_HID), (LAS float*)(c.lds + 131072), rsl};
    run_gemm(c, pg8::Gemm{1024, 1024, 1024}, S, E);
}
__device__ __forceinline__ void ph15(Ctx& c, const Args& args) {
    pg8::Sched2 S = sched1(c, WSP(bf16_t, WS_HID), WSP(bf16_t, WS_WDN), T / 256, 4, DFF, DFF); pg8::EpiResid<false, true> E{nullptr, WSP(bf16_t, WS_XB), args.out, nullptr, nullptr};
    run_gemm(c, pg8::Gemm{DFF, DFF, DFF}, S, E);
}

constexpr int N_PHASES = 16;
#ifndef PH_MASK
#define PH_MASK 0xFFFF
#endif
#ifndef DUP_MASK
#define DUP_MASK 0
#endif
#ifndef EXTRA_SYNCS
#define EXTRA_SYNCS 0
#endif
__global__ void __launch_bounds__(NTHR) fwd_kernel(Args args) {
    extern __shared__ __attribute__((aligned(16))) unsigned char lds_raw[];
    cg::grid_group grid = cg::this_grid();
    Ctx c;
    c.lds = (LAS unsigned char*)lds_raw; c.ldsg = (char*)lds_raw;
    c.tid = threadIdx.x; c.lane = c.tid & 63; c.wave = __builtin_amdgcn_readfirstlane(c.tid >> 6); c.bid = blockIdx.x; c.G = gridDim.x;
    for (int u = c.tid; u < (LDS_BYTES - LDSCTL_OFF) / 4; u += NTHR) ((LAS unsigned*)(c.lds + LDSCTL_OFF))[u] = 0u;
    __syncthreads();
    XcdBarrier bar = xcd_barrier_post((unsigned*)(args.ws + WS_BAR), (volatile LAS unsigned*)(c.lds + MISC_OFF) + 8);
    const int lo = args.ph_lo, hi = args.ph_hi;
    if (lo < 0) grid.sync();
#define IN(k) (((PH_MASK >> (k)) & 1) && lo <= (k) && (k) < hi)
#define DUPQ(k) (((DUP_MASK >> (k)) & 1) && IN(k))
#define SEAM(k) do { if (IN(k) && IN((k) + 1)) xcd_barrier(bar); } while (0)
#define PH(k, call) do { if (IN(k)) { call; } if (DUPQ(k)) { grid.sync(); call; } } while (0)
#ifndef TS_PHASE
#define TS_PHASE (-1)
#endif
    unsigned long long ts0_ = 0, span_ = 0; const bool stamper_ = (TS_PHASE >= 0) && blockIdx.x == 0 && c.tid == 0;
#define PHS(k, call) do { if (TS_PHASE == (k) && stamper_) ts0_ = __builtin_amdgcn_s_memrealtime(); PH(k, call); SEAM(k); if (TS_PHASE == (k) && stamper_) span_ = __builtin_amdgcn_s_memrealtime() - ts0_; } while (0)
    PHS(0, phase0(c, args));
#pragma unroll 1
    for (int es_ = 0; es_ < EXTRA_SYNCS; ++es_) grid.sync();
    PHS(1, ph1(c, args));
    PHS(2, phase2(c, args));
    PHS(3, ph3(c, args));
    PHS(5, ph5(c, args));
    PHS(6, phase6(c, args));
    PHS(7, ph7(c, args));
    PHS(8, ph8(c, args));
    PHS(9, ph9(c, args));
    PHS(10, ph10(c, args));
    PHS(11, ph11(c, args));
    if (TS_PHASE == 15 && stamper_) ts0_ = __builtin_amdgcn_s_memrealtime();
    PH(15, ph15(c, args));
    if (TS_PHASE == 15 && stamper_) span_ = __builtin_amdgcn_s_memrealtime() - ts0_;
    if (TS_PHASE >= 0 && stamper_) { const unsigned long long te_ = __builtin_amdgcn_s_memrealtime(); while (__builtin_amdgcn_s_memrealtime() - te_ < 10ull * span_) __builtin_amdgcn_s_sleep(8); }
#undef IN
#undef SEAM
}

#ifndef N_LAUNCHES
#define N_LAUNCHES 1
#endif
extern "C" void kernel_launch(void* const* d_in, const int* in_sizes, int n_in, void* d_out, int out_size, void* d_ws, size_t ws_size, hipStream_t stream) {
    static int grid = 0;
    if (grid == 0) {
        if (n_in != 33 || in_sizes[0] != T * DM || out_size != T * DM || ws_size < WS_END) { fprintf(stderr, "kernel_launch: unexpected shapes (n_in %d, in0 %d, out %d, ws %zu)\n", n_in, n_in > 0 ? in_sizes[0] : -1, out_size, ws_size); grid = -1; return; }
        int dev = 0, cus = 0, per_cu = 0;
        if (hipGetDevice(&dev) != hipSuccess || hipDeviceGetAttribute(&cus, hipDeviceAttributeMultiprocessorCount, dev) != hipSuccess) { grid = -1; return; }
        if (hipFuncSetAttribute((const void*)fwd_kernel, hipFuncAttributeMaxDynamicSharedMemorySize, LDS_BYTES) != hipSuccess) { fprintf(stderr, "kernel_launch: hipFuncSetAttribute failed\n"); grid = -1; return; }
        if (hipOccupancyMaxActiveBlocksPerMultiprocessor(&per_cu, (const void*)fwd_kernel, NTHR, LDS_BYTES) != hipSuccess || per_cu < 1) { fprintf(stderr, "kernel_launch: occupancy query says %d\n", per_cu); per_cu = 1; }
        (void)hipGetLastError();
        if (per_cu > 1) per_cu = 1;
        grid = cus * per_cu;
    }
    if (grid < 0) return;
    if (hipMemsetAsync((char*)d_ws + WS_BAR, 0, BAR_ZERO_BYTES, stream) != hipSuccess) { fprintf(stderr, "kernel_launch: hipMemsetAsync failed\n"); return; }
    Args a{};
    for (int i = 0; i < 33; ++i) a.in[i] = d_in[i];
    a.out = (float*)d_out; a.ws = (unsigned char*)d_ws;
#if N_LAUNCHES == 1
    a.ph_lo = 0; a.ph_hi = N_PHASES;
    void* kargs[] = {&a};
    const hipError_t e = hipLaunchCooperativeKernel((const void*)fwd_kernel, dim3(grid), dim3(NTHR), kargs, LDS_BYTES, stream);
    if (e != hipSuccess) fprintf(stderr, "kernel_launch: cooperative launch failed: %s (grid %d)\n", hipGetErrorString(e), grid);
#else
    for (int p = 0; p < N_PHASES; ++p) { a.ph_lo = p; a.ph_hi = p + 1; hipLaunchKernelGGL(fwd_kernel, dim3(grid), dim3(NTHR), LDS_BYTES, stream, a); }
#endif
}
```

```cpp
#include <hip/hip_runtime.h>
#include <hip/hip_cooperative_groups.h>
#include <cstdio>
#include <cstdint>
namespace cg = cooperative_groups;

#ifndef FAST_GEMM
#define FAST_GEMM 1
#endif
#ifndef FAST_ATTN
#define FAST_ATTN 1
#endif

namespace pg8 {
#define PG8_LAS __attribute__((address_space(3)))
typedef unsigned short bf16_t;
typedef short bf16x8 __attribute__((ext_vector_type(8)));
typedef float f32x4 __attribute__((ext_vector_type(4)));
typedef unsigned u32x4 __attribute__((ext_vector_type(4)));
constexpr int BM = 256, BK = 64, HALF = 128, HTB = HALF * BK * 2  , STAGE_BYTES = 8 * HTB, NXCD = 8, WGM = 8;

__host__ __device__ __forceinline__ int lds_byte(int r, int c) { const int st = (r >> 4) * 2 + (c >> 5), rr = r & 15, cc = c & 31, ob = rr * 64 + cc * 2; return st * 1024 + (ob ^ (((ob >> 9) & 1) << 5)); }
__host__ __device__ __forceinline__ void stage_rc(int b, int& R, int& C) { const int st = b / 1024, sb = b % 1024, swz = sb ^ (((sb >> 9) & 1) << 5); R = (st >> 1) * 16 + swz / 64; C = (st & 1) * 32 + (swz % 64) / 2; }
__host__ __device__ __forceinline__ int perm32(int rho) { const int n = rho >> 4, i = rho & 15; return 8 * (i >> 2) + 4 * n + (i & 3); }

typedef unsigned u32x2 __attribute__((ext_vector_type(2)));
struct Unit { int pm, pn, job; const char* A; const char* B; };
struct Gemm { int K, lda, ldb; };

template <class Epi, class Sched, bool ALIGN_EPI = false, bool SP2 = false>
__device__ __forceinline__ void gemm_phase(PG8_LAS unsigned char* lds, const Gemm g, const Sched& S, const Epi& E) {
    const int tid = threadIdx.x, wid = __builtin_amdgcn_readfirstlane(tid >> 6), lane = tid & 63, wr = wid >> 2, wc = wid & 3, fr = lane & 15, fq = lane >> 4;
    int Kopq = g.K; asm volatile("" : "+s"(Kopq));
    const int K = Kopq, nt = K / BK;
    unsigned voffA[2], voffB[2];
#pragma unroll
    for (int i = 0; i < 2; ++i) { int R, C; stage_rc(tid * 16 + i * 8192, R, C); const int Rb = Epi::PERM ? ((R & ~31) + perm32(R & 31)) : R;
        const int Ra = Epi::AMAP ? ((R & 64) + 4 * (R & 15) + ((R >> 4) & 3)) : R;
        voffA[i] = (unsigned)(Ra * g.lda + C) * 2u; voffB[i] = (unsigned)(Rb * g.ldb + C) * 2u; }
    const size_t kstep = (size_t)(BK * 2);
    const size_t hstepA = (size_t)HALF * g.lda * 2, hstepB = (size_t)HALF * g.ldb * 2;
    const unsigned ldsw = (unsigned)wid * 1024u;
    const int aoff = lds_byte(wr * 64 + fr, fq * 8), boff = lds_byte(wc * 32 + fr, fq * 8);
#define PG8_SA(b, h) (((b) * 2 + (h)) * HTB)
#define PG8_SB(b, h) ((4 + (b) * 2 + (h)) * HTB)
#define PG8_STAGE(bufoff, gbase, voff) do { _Pragma("unroll") for (int _i = 0; _i < 2; ++_i) \
        __builtin_amdgcn_global_load_lds((const unsigned*)((const char*)(gbase) + (voff)[_i]), (PG8_LAS unsigned*)(lds + (bufoff) + ldsw + _i * 8192), 16, 0, 0); } while (0)
#define PG8_LDA(dst, b, h) do { _Pragma("unroll") for (int m = 0; m < 4; ++m) _Pragma("unroll") for (int k = 0; k < 2; ++k) dst[m][k] = *(const PG8_LAS bf16x8*)(lds + PG8_SA(b, h) + aoff + m * 2048 + k * 1024); } while (0)
#define PG8_LDB(dst, b, h) do { _Pragma("unroll") for (int n = 0; n < 2; ++n) _Pragma("unroll") for (int k = 0; k < 2; ++k) dst[n][k] = *(const PG8_LAS bf16x8*)(lds + PG8_SB(b, h) + boff + n * 2048 + k * 1024); } while (0)
#define PG8_MMA(ai, bj, At, Bt) do { __builtin_amdgcn_s_setprio(1); _Pragma("unroll") for (int m = 0; m < 4; ++m) _Pragma("unroll") for (int n = 0; n < 2; ++n) _Pragma("unroll") for (int k = 0; k < 2; ++k) \
        acc[ai][bj][m][n] = __builtin_amdgcn_mfma_f32_16x16x32_bf16(Bt[n][k], At[m][k], acc[ai][bj][m][n], 0, 0, 0); __builtin_amdgcn_s_setprio(0); } while (0)
#define PG8_WAIT_V(n) asm volatile("s_waitcnt vmcnt(" #n ")" ::: "memory")
#define PG8_WAIT_L(n) asm volatile("s_waitcnt lgkmcnt(" #n ")" ::: "memory")
#define PG8_BAR __builtin_amdgcn_s_barrier()
#define PG8_SCHED __builtin_amdgcn_sched_barrier(0)
    Unit cur, nxt; int ui = 0;
    if (!S.next(0, cur)) return;
    f32x4 acc[2][2][4][2];
#pragma unroll
    for (int a = 0; a < 2; ++a)
#pragma unroll
        for (int b = 0; b < 2; ++b)
#pragma unroll
            for (int m = 0; m < 4; ++m)
#pragma unroll
                for (int n = 0; n < 2; ++n) acc[a][b][m][n] = (f32x4){0.f, 0.f, 0.f, 0.f};
    bf16x8 At[4][2], B0[2][2], B1[2][2];
    const char* cA = cur.A; const char* cB = cur.B;
    S.a_ready(cur);
    if constexpr (SP2) {
        PG8_STAGE(PG8_SB(0, 0), cB, voffB); PG8_STAGE(PG8_SB(0, 1), cB + hstepB, voffB); PG8_STAGE(PG8_SA(0, 0), cA, voffA); PG8_STAGE(PG8_SA(0, 1), cA + hstepA, voffA);
        if (wr == 1) PG8_BAR;
        PG8_WAIT_V(2); PG8_BAR;
        PG8_STAGE(PG8_SB(1, 0), cB + kstep, voffB); PG8_STAGE(PG8_SA(1, 0), cA + kstep, voffA); PG8_STAGE(PG8_SB(1, 1), cB + hstepB + kstep, voffB);
        PG8_WAIT_V(6); PG8_BAR;
    } else {
        PG8_STAGE(PG8_SB(0, 0), cB, voffB); PG8_STAGE(PG8_SA(0, 0), cA, voffA); PG8_STAGE(PG8_SB(0, 1), cB + hstepB, voffB); PG8_STAGE(PG8_SA(0, 1), cA + hstepA, voffA);
        if (wr == 1) PG8_BAR;
        PG8_WAIT_V(4); PG8_BAR;
        PG8_STAGE(PG8_SB(1, 0), cB + kstep, voffB); PG8_STAGE(PG8_SA(1, 0), cA + kstep, voffA); PG8_STAGE(PG8_SB(1, 1), cB + hstepB + kstep, voffB);
        PG8_WAIT_V(6); PG8_BAR;
    }
    for (;;) {
        const bool has_next = S.next(ui + 1, nxt);
        const char* nA = has_next ? nxt.A : cA; const char* nB = has_next ? nxt.B : cB;
        for (int t = 0; t < nt; t += 2) {
            const bool last = (t == nt - 2);
            const char* a1 = cA + (size_t)(t + 1) * kstep;
            const char* a2 = last ? nA : cA + (size_t)(t + 2) * kstep; const char* b2 = last ? nB : cB + (size_t)(t + 2) * kstep;
            const char* a3 = a2 + kstep; const char* b3 = b2 + kstep;
            if (last && has_next) S.a_ready(nxt);
            if constexpr (SP2) {
            PG8_LDB(B0, 0, 0); PG8_LDB(B1, 0, 1); PG8_SCHED; PG8_LDA(At, 0, 0); PG8_STAGE(PG8_SA(1, 1), a1 + hstepA, voffA);
            PG8_WAIT_V(8); PG8_WAIT_L(0); PG8_BAR; PG8_MMA(0, 0, At, B0); PG8_MMA(0, 1, At, B1); PG8_BAR; PG8_SCHED;
            PG8_LDA(At, 0, 1); PG8_STAGE(PG8_SB(0, 0), b2, voffB); PG8_STAGE(PG8_SB(0, 1), b2 + hstepB, voffB); PG8_STAGE(PG8_SA(0, 0), a2, voffA);
            PG8_WAIT_V(8); PG8_WAIT_L(0); PG8_BAR; PG8_MMA(1, 0, At, B0); PG8_MMA(1, 1, At, B1); PG8_BAR; PG8_SCHED;
            PG8_LDB(B0, 1, 0); PG8_LDB(B1, 1, 1); PG8_SCHED; PG8_LDA(At, 1, 0); PG8_STAGE(PG8_SA(0, 1), a2 + hstepA, voffA);
            PG8_WAIT_V(8); PG8_WAIT_L(0); PG8_BAR; PG8_MMA(0, 0, At, B0); PG8_MMA(0, 1, At, B1); PG8_BAR; PG8_SCHED;
            PG8_LDA(At, 1, 1); PG8_STAGE(PG8_SB(1, 0), b3, voffB); PG8_STAGE(PG8_SB(1, 1), b3 + hstepB, voffB); PG8_STAGE(PG8_SA(1, 0), a3, voffA);
            PG8_WAIT_V(8); PG8_WAIT_L(0); PG8_BAR; PG8_MMA(1, 0, At, B0); PG8_MMA(1, 1, At, B1); PG8_BAR; PG8_SCHED;
            } else {
            PG8_LDB(B0, 0, 0); PG8_SCHED; PG8_LDA(At, 0, 0); PG8_STAGE(PG8_SA(1, 1), a1 + hstepA, voffA);
            PG8_WAIT_L(8); PG8_BAR; PG8_WAIT_L(0); PG8_MMA(0, 0, At, B0); PG8_BAR; PG8_SCHED;
            PG8_LDB(B1, 0, 1); PG8_STAGE(PG8_SB(0, 0), b2, voffB);
            PG8_BAR; PG8_WAIT_L(0); PG8_MMA(0, 1, At, B1); PG8_BAR;
            PG8_LDA(At, 0, 1); PG8_STAGE(PG8_SA(0, 0), a2, voffA);
            PG8_BAR; PG8_WAIT_L(0); PG8_MMA(1, 0, At, B0); PG8_BAR; PG8_SCHED;
            PG8_STAGE(PG8_SB(0, 1), b2 + hstepB, voffB);
            PG8_WAIT_V(6); PG8_BAR; PG8_MMA(1, 1, At, B1); PG8_BAR;
            PG8_LDB(B0, 1, 0); PG8_SCHED; PG8_LDA(At, 1, 0); PG8_STAGE(PG8_SA(0, 1), a2 + hstepA, voffA);
            PG8_WAIT_L(8); PG8_BAR; PG8_WAIT_L(0); PG8_MMA(0, 0, At, B0); PG8_BAR; PG8_SCHED;
            PG8_LDB(B1, 1, 1); PG8_STAGE(PG8_SB(1, 0), b3, voffB);
            PG8_BAR; PG8_WAIT_L(0); PG8_MMA(0, 1, At, B1); PG8_BAR;
            PG8_LDA(At, 1, 1); PG8_STAGE(PG8_SA(1, 0), a3, voffA);
            PG8_BAR; PG8_WAIT_L(0); PG8_MMA(1, 0, At, B0); PG8_BAR; PG8_SCHED;
            PG8_STAGE(PG8_SB(1, 1), b3 + hstepB, voffB);
            PG8_WAIT_V(6); PG8_BAR; PG8_MMA(1, 1, At, B1); PG8_BAR;
            }
        }
        if constexpr (ALIGN_EPI) { if (wr == 0) PG8_BAR; }
        if constexpr (!Epi::AFTER_DRAIN) { E(acc, cur, wr, wc, fr, fq); S.done(cur); }
        if (!has_next) break;
#pragma unroll
        for (int a = 0; a < 2; ++a)
#pragma unroll
            for (int b = 0; b < 2; ++b)
#pragma unroll
                for (int m = 0; m < 4; ++m)
#pragma unroll
                    for (int n = 0; n < 2; ++n) acc[a][b][m][n] = (f32x4){0.f, 0.f, 0.f, 0.f};
        cur = nxt; cA = nA; cB = nB; ++ui;
        if constexpr (ALIGN_EPI) { if (wr == 1) PG8_BAR; }
    }
    PG8_WAIT_V(0);
    if constexpr (!ALIGN_EPI) { if (wr == 0) PG8_BAR; }
    PG8_BAR;
    if constexpr (Epi::AFTER_DRAIN) { E.fused(acc, cur, wr, wc, fr, fq, lds, wid, lane); S.done(cur); }
#undef PG8_SA
#undef PG8_SB
#undef PG8_STAGE
#undef PG8_LDA
#undef PG8_LDB
#undef PG8_MMA
#undef PG8_WAIT_V
#undef PG8_WAIT_L
#undef PG8_BAR
#undef PG8_SCHED
}

__device__ __forceinline__ float bf2f(bf16_t v) { return __uint_as_float((unsigned)v << 16); }
__device__ __forceinline__ float bflo(unsigned w) { return __uint_as_float(w << 16); }
__device__ __forceinline__ float bfhi(unsigned w) { return __uint_as_float(w & 0xffff0000u); }
__device__ __forceinline__ unsigned cvt_pk_bf16(float lo, float hi) { unsigned r; asm volatile("v_cvt_pk_bf16_f32 %0, %1, %2" : "=v"(r) : "v"(lo), "v"(hi)); return r; }

template <class Epi, class Sched>
__device__ __forceinline__ void gemm_naive(const Gemm g, const Sched& S, const Epi& E) {
    const int tid = threadIdx.x, wid = tid >> 6, lane = tid & 63, wr = wid >> 2, wc = wid & 3, fr = lane & 15, fq = lane >> 4;
    Unit u;
    for (int i = 0; S.next(i, u); ++i) {
        f32x4 acc[2][2][4][2];
#pragma unroll
        for (int ai = 0; ai < 2; ++ai)
#pragma unroll
            for (int bj = 0; bj < 2; ++bj)
#pragma unroll
                for (int m = 0; m < 4; ++m)
#pragma unroll
                    for (int n = 0; n < 2; ++n) {
                        const bf16_t* a = (const bf16_t*)u.A + (size_t)(ai * 128 + wr * 64 + m * 16 + fr) * g.lda;
                        const bf16_t* b = (const bf16_t*)u.B + (size_t)(bj * 128 + wc * 32 + n * 16 + 4 * fq) * g.ldb;
                        float s0 = 0.f, s1 = 0.f, s2 = 0.f, s3 = 0.f;
                        for (int k = 0; k < g.K; k += 8) {
                            const bf16x8 av = *(const bf16x8*)(a + k), b0 = *(const bf16x8*)(b + k), b1 = *(const bf16x8*)(b + g.ldb + k), b2 = *(const bf16x8*)(b + 2 * g.ldb + k), b3 = *(const bf16x8*)(b + 3 * g.ldb + k);
#pragma unroll
                            for (int e = 0; e < 8; ++e) { const float x = bf2f((bf16_t)av[e]); s0 += x * bf2f((bf16_t)b0[e]); s1 += x * bf2f((bf16_t)b1[e]); s2 += x * bf2f((bf16_t)b2[e]); s3 += x * bf2f((bf16_t)b3[e]); }
                        }
                        acc[ai][bj][m][n] = (f32x4){s0, s1, s2, s3};
                    }
        E(acc, u, wr, wc, fr, fq);
    }
}

struct Job { const char* A; const char* B; int nM, nN; };
struct Sched2 {
    Job a, b; int G, c, lda, ldb;
    __device__ __forceinline__ bool next(int i, Unit& u) const {
        int L = i * G + c; const int na = a.nM * a.nN, nb = b.nM * b.nN;
        if (L < na) { u.job = 0; u.pm = L % a.nM; u.pn = L / a.nM; u.A = a.A + (size_t)u.pm * 256 * lda * 2; u.B = a.B + (size_t)u.pn * 256 * ldb * 2; return true; }
        L -= na;
        if (L < nb) { u.job = 1; u.pm = L % b.nM; u.pn = L / b.nM; u.A = b.A + (size_t)u.pm * 256 * lda * 2; u.B = b.B + (size_t)u.pn * 256 * ldb * 2; return true; }
        return false;
    }
    __device__ __forceinline__ void a_ready(const Unit&) const {}
    __device__ __forceinline__ void done(const Unit&) const {}
};
struct GateOrder {
    const char* xc; const char* wg; size_t dstride; int G, c;
    __device__ __forceinline__ bool next(int i, Unit& u) const {
        const int L = i * G + c; if (L >= 512) return false;
        const int grp = L >> 6, pm = L & 63, d = grp >> 2, png = grp & 3;
        u.job = d; u.pm = pm; u.pn = png; u.A = xc + (size_t)d * dstride + ((size_t)pm * 256 * 512 + png * 128) * 2; u.B = wg + (size_t)grp * 256 * 128 * 2; return true;
    }
    __device__ __forceinline__ void a_ready(const Unit&) const {}
    __device__ __forceinline__ void done(const Unit&) const {}
};

__device__ __forceinline__ float rowscale16(const float* ss, int row) {
    const f32x4* p = (const f32x4*)(ss + (size_t)row * 16); const f32x4 a = p[0], b = p[1], c = p[2], d = p[3];
    const float s = ((a[0] + a[1]) + (a[2] + a[3])) + ((b[0] + b[1]) + (b[2] + b[3])) + ((c[0] + c[1]) + (c[2] + c[3])) + ((d[0] + d[1]) + (d[2] + d[3]));
    return 1.0f / sqrtf(s * (1.0f / 1024.0f) + 1e-6f);
}
template <bool ROWSCALE> struct EpiBf {
    static constexpr bool PERM = true, AFTER_DRAIN = false, AMAP = false;
    bf16_t* O0; int ld0; bf16_t* O1; int ld1; const float* ss; const PG8_LAS float* rsl;
    __device__ __forceinline__ void operator()(const f32x4 (&acc)[2][2][4][2], const Unit& u, int wr, int wc, int fr, int fq) const {
        bf16_t* O = u.job ? O1 : O0; const int ldc = u.job ? ld1 : ld0;
        const int row0 = u.pm * 256 + wr * 64 + fr, col0 = u.pn * 256 + wc * 32 + 8 * fq;
#pragma unroll
        for (int ai = 0; ai < 2; ++ai)
#pragma unroll
            for (int m = 0; m < 4; ++m) { const int row = row0 + ai * 128 + m * 16; float rs = 1.f; if (ROWSCALE) rs = rsl ? rsl[row - u.pm * 256] : rowscale16(ss, row);
                bf16_t* rowp = O + (size_t)row * ldc + col0;
#pragma unroll
                for (int bj = 0; bj < 2; ++bj) { const f32x4 v0 = acc[ai][bj][m][0] * rs, v1 = acc[ai][bj][m][1] * rs; u32x4 w;
                    w.x = cvt_pk_bf16(v0[0], v0[1]); w.y = cvt_pk_bf16(v0[2], v0[3]); w.z = cvt_pk_bf16(v1[0], v1[1]); w.w = cvt_pk_bf16(v1[2], v1[3]); *(u32x4*)(rowp + bj * 128) = w; } }
    }
};
template <bool BASE_F32, bool OUT_F32> struct EpiResid {
    static constexpr bool PERM = true, AFTER_DRAIN = false, AMAP = false;
    const float* basef; const bf16_t* baseb; float* out; bf16_t* xb; float* ss;
    __device__ __forceinline__ void operator()(const f32x4 (&acc)[2][2][4][2], const Unit& u, int wr, int wc, int fr, int fq) const {
        const int row0 = u.pm * 256 + wr * 64 + fr, col0 = u.pn * 256 + wc * 32 + 8 * fq;
#pragma unroll
        for (int ai = 0; ai < 2; ++ai)
#pragma unroll
            for (int m = 0; m < 4; ++m) { const int row = row0 + ai * 128 + m * 16; const size_t off = (size_t)row * 1024 + col0; float s = 0.f;
#pragma unroll
                for (int bj = 0; bj < 2; ++bj) { const size_t o2 = off + bj * 128; f32x4 b0, b1;
                    if (BASE_F32) { b0 = *(const f32x4*)(basef + o2); b1 = *(const f32x4*)(basef + o2 + 4); }
                    else { const u32x4 w = *(const u32x4*)(baseb + o2); b0 = (f32x4){bflo(w.x), bfhi(w.x), bflo(w.y), bfhi(w.y)}; b1 = (f32x4){bflo(w.z), bfhi(w.z), bflo(w.w), bfhi(w.w)}; }
                    const f32x4 v0 = b0 + acc[ai][bj][m][0], v1 = b1 + acc[ai][bj][m][1];
                    if (OUT_F32) { *(f32x4*)(out + o2) = v0; *(f32x4*)(out + o2 + 4) = v1; }
                    else { s += ((v0[0] * v0[0] + v0[1] * v0[1]) + (v0[2] * v0[2] + v0[3] * v0[3])) + ((v1[0] * v1[0] + v1[1] * v1[1]) + (v1[2] * v1[2] + v1[3] * v1[3]));
                        u32x4 w; w.x = cvt_pk_bf16(v0[0], v0[1]); w.y = cvt_pk_bf16(v0[2], v0[3]); w.z = cvt_pk_bf16(v1[0], v1[1]); w.w = cvt_pk_bf16(v1[2], v1[3]); *(u32x4*)(xb + o2) = w; } }
                if (!OUT_F32) { s += __shfl_xor(s, 16); s += __shfl_xor(s, 32); if (fq == 0) ss[(size_t)row * 16 + u.pn * 4 + wc] = s; } }
    }
};
struct EpiGates {
    static constexpr bool PERM = false, AFTER_DRAIN = false, AMAP = false;
    const bf16_t* xc; const float* b_a; const float* b_i; const float* c8t; unsigned* G; int T;
    __device__ __forceinline__ void operator()(const f32x4 (&acc)[2][2][4][2], const Unit& u, int wr, int wc, int fr, int fq) const {
        const int d = u.job, row0 = u.pm * 256 + wr * 64 + fr, ch0 = u.pn * 128 + wc * 32 + 4 * fq;
#pragma unroll
        for (int n = 0; n < 2; ++n) { const int ch = d * 512 + ch0 + n * 16; const f32x4 ba = *(const f32x4*)(b_a + ch), bi = *(const f32x4*)(b_i + ch), c8 = *(const f32x4*)(c8t + ch);
#pragma unroll
            for (int ai = 0; ai < 2; ++ai)
#pragma unroll
                for (int m = 0; m < 4; ++m) { const int row = row0 + ai * 128 + m * 16;
                    const size_t off = ((size_t)d * T + row) * 512 + ch0 + n * 16; const u32x2 xw = *(const u32x2*)(xc + off);
                    const float xv[4] = {bflo(xw.x), bfhi(xw.x), bflo(xw.y), bfhi(xw.y)}; const f32x4 pa = acc[ai][0][m][n] + ba, pi = acc[ai][1][m][n] + bi; u32x4 o;
#pragma unroll
                    for (int e = 0; e < 4; ++e) { const float r = __builtin_amdgcn_rcpf(1.0f + __expf(-pa[e])), ig = __builtin_amdgcn_rcpf(1.0f + __expf(-pi[e])); const float la = r * c8[e];
                        const float x2 = 2.0f * la; const float om = (x2 > -0.02f) ? -(x2 + 0.5f * x2 * x2 + x2 * x2 * x2 * (1.0f / 6.0f)) : 1.0f - __expf(x2);
                        o[e] = cvt_pk_bf16(la, __builtin_amdgcn_sqrtf(fmaxf(om, 0.f)) * ig * xv[e]); }
                    *(u32x4*)(G + off) = o; asm volatile("" ::: "memory"); } }
    }
};
struct FfnOrder {
    const char* xb; const char* wup; int G, c;
    __device__ __forceinline__ bool next(int i, Unit& u) const {
        const int L = i * G + c, x = L & 7, y = L >> 3; if (y >= 182) return false;
        const int U = x * 182 + y; if (U >= 66 * 22) return false;
        if (U < 16 * 88) { const int pmg = U / 88, r = U - pmg * 88; u.pn = r >> 2; u.pm = pmg * 4 + (r & 3); } else { const int r = U - 16 * 88; u.pn = r >> 1; u.pm = 64 + (r & 1); }
        u.job = i; const int b = u.pm / 33, pmb = u.pm - 33 * b;
        u.A = xb + ((long)(b * 8192 + 254 * pmb - 1) * 1024) * 2; u.B = wup + (size_t)u.pn * 256 * 1024 * 2; return true;
    }
    __device__ __forceinline__ void a_ready(const Unit&) const {}
    __device__ __forceinline__ void done(const Unit&) const {}
};
__device__ __forceinline__ float dpp_shr1(float oldv, float src) { return __int_as_float(__builtin_amdgcn_update_dpp(__float_as_int(oldv), __float_as_int(src), 0x111, 0xf, 0xf, false)); }
__device__ __forceinline__ float dpp_shl1(float oldv, float src) { return __int_as_float(__builtin_amdgcn_update_dpp(__float_as_int(oldv), __float_as_int(src), 0x101, 0xf, 0xf, false)); }
struct EpiFfn {
    static constexpr bool PERM = true, AFTER_DRAIN = false, AMAP = true;
    const float* ss; const float* cw; const float* cb; bf16_t* hid; PG8_LAS float* halo; PG8_LAS float* rsl;
    __device__ __forceinline__ void operator()(f32x4 (&acc)[2][2][4][2], const Unit& u, int wr, int wc, int fr, int fq) const {
        const int b = u.pm / 33, pmb = u.pm - 33 * b, ts = 254 * pmb - 1, c8 = wc * 32 + 8 * fq, j = u.pn * 128 + c8;
        const bool edge = (pmb == 0) || (pmb == 32);
        typedef float f32x2w __attribute__((ext_vector_type(2)));
        PG8_LAS float* wl = halo + 2048;
        f32x2w wld; { const int t2 = (int)threadIdx.x * 2, bjw = t2 >> 9, kw = (t2 >> 7) & 3, cwl = t2 & 127; const float* src = (kw < 3 ? cw + (size_t)kw * 5632 : cb) + bjw * 2816 + u.pn * 128 + cwl; wld = *(const f32x2w*)src; }
#pragma unroll
        for (int ai = 0; ai < 2; ++ai)
#pragma unroll
            for (int m = 0; m < 4; ++m) { const int tl = ts + 128 * ai + 64 * wr + 4 * fr + m; const bool in = !edge || ((tl >= 0) && (tl < 8192)); float rs = 0.f; if (u.job < 6) rs = rsl[u.job * 256 + 128 * ai + 64 * wr + 4 * fr + m]; else if (in) rs = rowscale16(ss, b * 8192 + tl);
#pragma unroll
                for (int bj = 0; bj < 2; ++bj)
#pragma unroll
                    for (int n = 0; n < 2; ++n)
#pragma unroll
                        for (int e = 0; e < 4; ++e) acc[ai][bj][m][n][e] = (edge && !in) ? 0.f : acc[ai][bj][m][n][e] * rs; }
#pragma unroll
        for (int ai = 0; ai < 2; ++ai) { const int grp = 2 * ai + wr;
#pragma unroll
            for (int bj = 0; bj < 2; ++bj) {
                if (fr == 0) { PG8_LAS f32x4* p = (PG8_LAS f32x4*)(halo + (grp * 2 + 0) * 256 + bj * 128 + c8); p[0] = acc[ai][bj][0][0]; p[1] = acc[ai][bj][0][1]; }
                if (fr == 15) { PG8_LAS f32x4* p = (PG8_LAS f32x4*)(halo + (grp * 2 + 1) * 256 + bj * 128 + c8); p[0] = acc[ai][bj][3][0]; p[1] = acc[ai][bj][3][1]; } } }
        *(PG8_LAS f32x2w*)(wl + (int)threadIdx.x * 2) = wld;
        asm volatile("s_waitcnt lgkmcnt(0)\n\ts_barrier" ::: "memory");
        f32x4 wgt[2][3][2], bia[2][2];
#pragma unroll
        for (int bj = 0; bj < 2; ++bj) {
#pragma unroll
            for (int n = 0; n < 2; ++n) { bia[bj][n] = *(const PG8_LAS f32x4*)(wl + (bj * 4 + 3) * 128 + c8 + 4 * n);
#pragma unroll
                for (int k = 0; k < 3; ++k) wgt[bj][k][n] = *(const PG8_LAS f32x4*)(wl + (bj * 4 + k) * 128 + c8 + 4 * n); } }
#pragma unroll
        for (int ai = 0; ai < 2; ++ai) { const int grp = 2 * ai + wr;
            u32x4 ow[4];
#pragma unroll
            for (int n = 0; n < 2; ++n) { f32x4 hp[2], hn[2];
#pragma unroll
                for (int bj = 0; bj < 2; ++bj) { hp[bj] = (grp > 0) ? *(const PG8_LAS f32x4*)(halo + ((grp - 1) * 2 + 1) * 256 + bj * 128 + c8 + 4 * n) : (f32x4){0.f, 0.f, 0.f, 0.f};
                    hn[bj] = (grp < 3) ? *(const PG8_LAS f32x4*)(halo + ((grp + 1) * 2 + 0) * 256 + bj * 128 + c8 + 4 * n) : (f32x4){0.f, 0.f, 0.f, 0.f}; }
                float hv[4][4];
#pragma unroll
                for (int e = 0; e < 4; ++e) { float cv[2][4];
#pragma unroll
                    for (int bj = 0; bj < 2; ++bj) { const float x0 = acc[ai][bj][0][n][e], x1 = acc[ai][bj][1][n][e], x2 = acc[ai][bj][2][n][e], x3 = acc[ai][bj][3][n][e];
                        const float pm0 = dpp_shr1(hp[bj][e], x3), nm3 = dpp_shl1(hn[bj][e], x0);
                        const float w0 = wgt[bj][0][n][e], w1 = wgt[bj][1][n][e], w2 = wgt[bj][2][n][e], bb = bia[bj][n][e];
                        cv[bj][0] = bb + w0 * pm0 + w1 * x0 + w2 * x1; cv[bj][1] = bb + w0 * x0 + w1 * x1 + w2 * x2; cv[bj][2] = bb + w0 * x1 + w1 * x2 + w2 * x3; cv[bj][3] = bb + w0 * x2 + w1 * x3 + w2 * nm3; }
#pragma unroll
                    for (int m = 0; m < 4; ++m) { const float G = cv[0][m]; hv[m][e] = G * __builtin_amdgcn_rcpf(1.0f + __builtin_amdgcn_exp2f(-1.4426950408889634f * G)) * cv[1][m]; } }
#pragma unroll
                for (int m = 0; m < 4; ++m) { ow[m][2 * n] = cvt_pk_bf16(hv[m][0], hv[m][1]); ow[m][2 * n + 1] = cvt_pk_bf16(hv[m][2], hv[m][3]); } }
#pragma unroll
            for (int m = 0; m < 4; ++m) { const int tau = 128 * ai + 64 * wr + 4 * fr + m, tl = ts + tau;
                if (tau >= 1 && tau <= 254 && tl < 8192) *(u32x4*)(hid + ((size_t)b * 8192 + tl) * 2816 + j) = ow[m]; } }
    }
};
}

namespace att {
using pg8::bf16_t;
using bf16x8 = __attribute__((ext_vector_type(8))) short;
using s16x4  = __attribute__((ext_vector_type(4))) short;
using f32x16 = __attribute__((ext_vector_type(16))) float;
using u32x4  = __attribute__((ext_vector_type(4))) unsigned;
constexpr int NW = 8, QBLK = 32, KVBLK = 64;
constexpr size_t SHM_V = KVBLK * 128 * 2, SHM_K = KVBLK * 128 * 2, SHM_ATTN = 3 * SHM_V + 3 * SHM_K + NW * 64 * 4;
constexpr float THR = 8.f;
#define KSWZ(row, colB) ((row) * 256 + ((colB) ^ (((row) & 7) << 4)))
#define SBAR() __builtin_amdgcn_sched_barrier(0)
__device__ __forceinline__ int crow(int r, int hi) { return (r & 3) + 8 * (r >> 2) + 4 * hi; }
__device__ __forceinline__ unsigned cvtpk(float lo, float hi) { unsigned r; asm volatile("v_cvt_pk_bf16_f32 %0, %1, %2" : "=v"(r) : "v"(lo), "v"(hi)); return r; }
#ifndef ATT_DUP_EXP
#define ATT_DUP_EXP 0
#endif
#ifndef ATT_DUP_MFMA
#define ATT_DUP_MFMA 0
#endif
template <bool FIXED> __device__ __forceinline__ void partialSM(f32x16& p0, f32x16& p1, float& m_reg, float& mn, float& alpha, float C, float thr_raw) {
  if constexpr (FIXED) {
#if ATT_DUP_EXP
    { f32x16 dmy;
      _Pragma("unroll") for (int r = 0; r < 16; ++r) dmy[r] = __builtin_amdgcn_exp2f(p0[r] + 1.0f) + __builtin_amdgcn_exp2f(p1[r] + 1.0f);
      asm volatile("" :: "v"(dmy)); }
#endif
    alpha = 1.f;
#pragma unroll
    for (int r = 0; r < 16; ++r) p0[r] = __builtin_amdgcn_exp2f(p0[r]);
    return; }
  float pmax = p0[0];
#pragma unroll
  for (int r = 1; r < 16; ++r) pmax = fmaxf(pmax, p0[r]);
#pragma unroll
  for (int r = 0; r < 16; ++r) pmax = fmaxf(pmax, p1[r]);
  { auto rr = __builtin_amdgcn_permlane32_swap(__float_as_uint(pmax), __float_as_uint(pmax), false, false);
    pmax = fmaxf(__uint_as_float(rr[0]), __uint_as_float(rr[1])); }
  if (__builtin_expect(__all(pmax - m_reg <= thr_raw), 1)) { mn = m_reg; alpha = 1.f; }
  else { mn = fmaxf(m_reg, pmax); alpha = __builtin_amdgcn_exp2f((m_reg - mn) * C); m_reg = mn; }
  const float mnC = -mn * C;
#pragma unroll
  for (int r = 0; r < 16; ++r) p0[r] = fmaf(p0[r], C, mnC);
#pragma unroll
  for (int r = 0; r < 16; ++r) p1[r] = fmaf(p1[r], C, mnC);
#pragma unroll
  for (int r = 0; r < 16; ++r) p0[r] = __builtin_amdgcn_exp2f(p0[r]);
}
template <bool SUM> __device__ __forceinline__ void finishSM(f32x16& p0, f32x16& p1, float alpha, float& l_reg, bf16x8& pa0, bf16x8& pa1, bf16x8& pa2, bf16x8& pa3) {
#pragma unroll
  for (int r = 0; r < 16; ++r) p1[r] = __builtin_amdgcn_exp2f(p1[r]);
  if constexpr (SUM) { float ps = 0;
#pragma unroll
    for (int r = 0; r < 16; ++r) ps += p0[r];
#pragma unroll
    for (int r = 0; r < 16; ++r) ps += p1[r];
    { auto rr = __builtin_amdgcn_permlane32_swap(__float_as_uint(ps), __float_as_uint(ps), false, false);
      ps = __uint_as_float(rr[0]) + __uint_as_float(rr[1]); }
    l_reg = l_reg * alpha + ps; }
#define PK4(P, BASE, OUT) do { u32x4 w = {cvtpk(P[BASE + 0], P[BASE + 1]), cvtpk(P[BASE + 2], P[BASE + 3]), cvtpk(P[BASE + 4], P[BASE + 5]), cvtpk(P[BASE + 6], P[BASE + 7])}; OUT = *reinterpret_cast<bf16x8*>(&w); } while (0)
  PK4(p0, 0, pa0); PK4(p0, 8, pa1); PK4(p1, 0, pa2); PK4(p1, 8, pa3);
#undef PK4
}
template <int DQK> __device__ __forceinline__ void qkt(f32x16& p0, f32x16& p1, const bf16_t* Ks, const bf16x8* qr, int r32, int hi) {
  p0 = f32x16{}; p1 = f32x16{};
#if ATT_DUP_MFMA
  f32x16 dm0 = f32x16{}, dm1 = f32x16{};
#endif
#pragma unroll
  for (int d0 = 0; d0 < DQK / 16; ++d0) { const int cb = (d0 * 16 + hi * 8) * 2;
    const bf16x8 b0 = *reinterpret_cast<const bf16x8*>((const char*)Ks + KSWZ(r32, cb));
    const bf16x8 b1 = *reinterpret_cast<const bf16x8*>((const char*)Ks + KSWZ(32 + r32, cb));
    p0 = __builtin_amdgcn_mfma_f32_32x32x16_bf16(b0, qr[d0], p0, 0, 0, 0);
    p1 = __builtin_amdgcn_mfma_f32_32x32x16_bf16(b1, qr[d0], p1, 0, 0, 0);
#if ATT_DUP_MFMA
    dm0 = __builtin_amdgcn_mfma_f32_32x32x16_bf16(b0, qr[d0], dm0, 0, 0, 0); dm1 = __builtin_amdgcn_mfma_f32_32x32x16_bf16(b1, qr[d0], dm1, 0, 0, 0);
#endif
  }
#if ATT_DUP_MFMA
  asm volatile("" :: "v"(dm0), "v"(dm1));
#endif
}
__device__ __forceinline__ int v_st(int k, int c) { const int kk = k; return ((kk >> 3) * 4 + (c >> 5)) * 512 + ((kk & 7) * 32 + (c & 31)) * 2; }
__device__ __forceinline__ int v_rd_base(int lane) { return ((lane & 3) << 3) | (((lane >> 2) & 3) << 6) | (((lane >> 4) & 1) << 5) | (((lane >> 5) & 1) << 8); }
constexpr int v_rd_off(int d0, int ks, int half) { return d0 * 512 + ks * 4096 + half * 2048; }
template <int OFF> __device__ __forceinline__ s16x4 tr_read(int vb) {
  s16x4 r; asm volatile("ds_read_b64_tr_b16 %0, %1 offset:%2" : "=&v"(r) : "v"(vb), "i"(OFF) : "memory"); return r;
}
template <int D0> __device__ __forceinline__ void pv_one(f32x16& od, int vb, bf16x8 pa0, bf16x8 pa1, bf16x8 pa2, bf16x8 pa3) {
  const s16x4 l0 = tr_read<v_rd_off(D0, 0, 0)>(vb), h0 = tr_read<v_rd_off(D0, 0, 1)>(vb), l1 = tr_read<v_rd_off(D0, 1, 0)>(vb), h1 = tr_read<v_rd_off(D0, 1, 1)>(vb);
  const s16x4 l2 = tr_read<v_rd_off(D0, 2, 0)>(vb), h2 = tr_read<v_rd_off(D0, 2, 1)>(vb), l3 = tr_read<v_rd_off(D0, 3, 0)>(vb), h3 = tr_read<v_rd_off(D0, 3, 1)>(vb);
  asm volatile("s_waitcnt lgkmcnt(0)" ::: "memory"); SBAR();
#define PK(L, H) (bf16x8){L[0], L[1], L[2], L[3], H[0], H[1], H[2], H[3]}
  od = __builtin_amdgcn_mfma_f32_32x32x16_bf16(pa0, PK(l0, h0), od, 0, 0, 0);
  od = __builtin_amdgcn_mfma_f32_32x32x16_bf16(pa1, PK(l1, h1), od, 0, 0, 0);
  od = __builtin_amdgcn_mfma_f32_32x32x16_bf16(pa2, PK(l2, h2), od, 0, 0, 0);
  od = __builtin_amdgcn_mfma_f32_32x32x16_bf16(pa3, PK(l3, h3), od, 0, 0, 0);
#undef PK
}
template <int DV, bool OL> __device__ __forceinline__ void pv_all(f32x16* o, f32x16& ol, bf16x8 onesB, int vb, bf16x8 pa0, bf16x8 pa1, bf16x8 pa2, bf16x8 pa3) {
  pv_one<0>(o[0], vb, pa0, pa1, pa2, pa3); pv_one<1>(o[1], vb, pa0, pa1, pa2, pa3);
  if constexpr (DV == 128) { pv_one<2>(o[2], vb, pa0, pa1, pa2, pa3); pv_one<3>(o[3], vb, pa0, pa1, pa2, pa3); }
  if constexpr (OL) {
    ol = __builtin_amdgcn_mfma_f32_32x32x16_bf16(pa0, onesB, ol, 0, 0, 0); ol = __builtin_amdgcn_mfma_f32_32x32x16_bf16(pa1, onesB, ol, 0, 0, 0);
    ol = __builtin_amdgcn_mfma_f32_32x32x16_bf16(pa2, onesB, ol, 0, 0, 0); ol = __builtin_amdgcn_mfma_f32_32x32x16_bf16(pa3, onesB, ol, 0, 0, 0); }
}

constexpr int NBUF = 4;
constexpr size_t SHM_ATTN_PP = NBUF * (SHM_V + SHM_K) + NW * 64 * 4;
#define PPBAR() asm volatile("s_waitcnt lgkmcnt(0)\n\ts_barrier" ::: "memory")
template <int DQK, int DV, bool QNORM, bool FIXED>
__device__ __forceinline__ void attn_unit(const bf16_t* __restrict__ Qb, int ldq, const bf16_t* __restrict__ Kh, int ldk, const bf16_t* __restrict__ Vh, int ldv,
                                          bf16_t* __restrict__ Ob, int ldo, int seq, float scale, const float* __restrict__ qgain, const int* __restrict__ qpos, char* lds) {
  const int tid = threadIdx.x, wid = __builtin_amdgcn_readfirstlane(tid >> 6), lane = tid & 63, r32 = lane & 31, hi = lane >> 5;
  const float C = 1.0f, thr_raw = THR * 1.4426950408889634f;
  bf16_t* V_lds = (bf16_t*)lds; bf16_t* K_lds = (bf16_t*)(lds + NBUF * SHM_V);
  float* ws = (float*)(lds + NBUF * (SHM_V + SHM_K)) + wid * 64; float* li_l = ws; float* al_l = ws + 32;
  constexpr bool OL = (DV == 64) && FIXED;
  float m_reg = -1e30f, l_reg = 0; f32x16 o[DV / 32]; f32x16 ol = f32x16{}; bf16x8 qr[DQK / 16];
  const short one_s = (r32 == 0) ? (short)0x3F80 : (short)0; const bf16x8 onesB = {one_s, one_s, one_s, one_s, one_s, one_s, one_s, one_s};
#pragma unroll
  for (int d = 0; d < DV / 32; ++d) o[d] = f32x16{};
  const bf16_t* Qw = Qb + (long)(wid * QBLK + r32) * ldq + hi * 8;
#pragma unroll
  for (int d0 = 0; d0 < DQK / 16; ++d0) qr[d0] = *reinterpret_cast<const bf16x8*>(Qw + d0 * 16);
  if constexpr (QNORM) {
    float vq[DQK / 16][8]; float ssq = 0.f;
#pragma unroll
    for (int d0 = 0; d0 < DQK / 16; ++d0)
#pragma unroll
      for (int e = 0; e < 8; ++e) { vq[d0][e] = pg8::bf2f((bf16_t)qr[d0][e]); ssq += vq[d0][e] * vq[d0][e]; }
    ssq += __shfl_xor(ssq, 32);
    const float rs = scale * 1.4426950408889634f / sqrtf(ssq * (1.0f / DQK) + 1e-6f);
#pragma unroll
    for (int d0 = 0; d0 < DQK / 16; ++d0)
#pragma unroll
      for (int e = 0; e < 8; ++e) vq[d0][e] *= rs * qgain[d0 * 16 + hi * 8 + e];
    if constexpr (DQK == 96) {
      const float posf = (float)qpos[wid * QBLK + r32];
#pragma unroll
      for (int e = 0; e < 8; ++e) { const int j = hi * 8 + e; const float inv = exp2f(-(float)j * 0.8304820237218406f);
        const float ang = posf * inv; const double rev = (double)ang * 0.15915494309189535; const float fr = (float)(rev - rint(rev));
        const float cs = __builtin_amdgcn_cosf(fr), sn = __builtin_amdgcn_sinf(fr), a1 = vq[4][e], a2 = vq[5][e];
        vq[4][e] = a1 * cs - a2 * sn; vq[5][e] = a1 * sn + a2 * cs; }
    }
#pragma unroll
    for (int d0 = 0; d0 < DQK / 16; ++d0) { u32x4 w = {cvtpk(vq[d0][0], vq[d0][1]), cvtpk(vq[d0][2], vq[d0][3]), cvtpk(vq[d0][4], vq[d0][5]), cvtpk(vq[d0][6], vq[d0][7])}; qr[d0] = *reinterpret_cast<bf16x8*>(&w); }
  }
  const int sr = tid >> 4, sc = (tid & 15) * 8, vst0 = v_st(sr, sc), vst1 = v_st(32 + sr, sc);
  const bool kact = sc < DQK, vact = sc < DV;
  const int vb0 = (int)(uintptr_t)V_lds + v_rd_base(lane);
  bf16x8 svs0[2], svs1[2], sks0[2], sks1[2];
#define SLOAD(i, k0) do { if (vact) { svs0[i] = *(const bf16x8*)(&Vh[(long)((k0) + sr) * ldv + sc]); svs1[i] = *(const bf16x8*)(&Vh[(long)((k0) + 32 + sr) * ldv + sc]); } \
    if (kact) { sks0[i] = *(const bf16x8*)(&Kh[(long)((k0) + sr) * ldk + sc]); sks1[i] = *(const bf16x8*)(&Kh[(long)((k0) + 32 + sr) * ldk + sc]); } } while (0)
#define SWRITE(off, i) do { if (vact) { *(bf16x8*)((char*)V_lds + (off) + vst0) = svs0[i]; *(bf16x8*)((char*)V_lds + (off) + vst1) = svs1[i]; } \
    if (kact) { const int kc = sc * 2; *(bf16x8*)((char*)K_lds + (off) + KSWZ(sr, kc)) = sks0[i]; *(bf16x8*)((char*)K_lds + (off) + KSWZ(32 + sr, kc)) = sks1[i]; } } while (0)
#define RESC(a) do { if (!FIXED && __any((a) < 1.f)) { if (hi == 0) al_l[r32] = (a); asm volatile("s_waitcnt lgkmcnt(0)" ::: "memory"); \
    _Pragma("unroll") for (int r = 0; r < 16; ++r) { const float f_ = al_l[crow(r, hi)]; if (OL) ol[r] *= f_; _Pragma("unroll") for (int d = 0; d < DV / 32; ++d) o[d][r] *= f_; } } } while (0)
#define BOFF(t) (((t) & (NBUF - 1)) * (int)SHM_V)
  f32x16 p0, p1; float mn, al; bf16x8 pa0, pa1, pa2, pa3; const int NT = seq / KVBLK;
  SLOAD(0, 0); SLOAD(1, KVBLK);
  SWRITE(BOFF(0), 0); SWRITE(BOFF(1), 1);
  SLOAD(0, 2 * KVBLK);
  PPBAR();
  qkt<DQK>(p0, p1, K_lds, qr, r32, hi);
  if (wid >= 4) PPBAR();
#pragma unroll 1
  for (int s = 0; s < NT; ++s) {
      partialSM<FIXED>(p0, p1, m_reg, mn, al, C, thr_raw); RESC(al); finishSM<!OL>(p0, p1, al, l_reg, pa0, pa1, pa2, pa3);
    if (s + 2 < NT) { SWRITE(BOFF(s + 2), 0); } if (s + 3 < NT) { SLOAD(0, (s + 3) * KVBLK); }
    PPBAR(); SBAR();
      __builtin_amdgcn_s_setprio(1); pv_all<DV, OL>(o, ol, onesB, vb0 + BOFF(s), pa0, pa1, pa2, pa3); if (s + 1 < NT) qkt<DQK>(p0, p1, (bf16_t*)((char*)K_lds + BOFF(s + 1)), qr, r32, hi); __builtin_amdgcn_s_setprio(0);
    PPBAR(); SBAR();
  }
  if (wid < 4) PPBAR();
#undef BOFF
  if constexpr (OL) { if (r32 == 0) {
#pragma unroll
      for (int r = 0; r < 16; ++r) li_l[crow(r, hi)] = ol[r]; } }
  else { if (hi == 0) li_l[r32] = l_reg; }
  asm volatile("s_waitcnt lgkmcnt(0)" ::: "memory");
  float rli[16];
#pragma unroll
  for (int r = 0; r < 16; ++r) rli[r] = __builtin_amdgcn_rcpf(li_l[crow(r, hi)]);
  bf16_t* Ow = Ob + (long)(wid * QBLK) * ldo;
#pragma unroll
  for (int r = 0; r < 16; ++r) { const int orow = crow(r, hi);
#pragma unroll
    for (int d0 = 0; d0 < DV / 32; ++d0) Ow[(long)orow * ldo + d0 * 32 + r32] = (bf16_t)(cvtpk(o[d0][r] * rli[r], 0.f) & 0xffffu); }
  __syncthreads();
#undef SLOAD
#undef SWRITE
#undef RESC
}
#undef SBAR

template <int DQK, int DV, bool QNORM>
__device__ __forceinline__ void attn_unit_naive(const bf16_t* Qb, int ldq, const bf16_t* Kh, int ldk, const bf16_t* Vh, int ldv, bf16_t* Ob, int ldo, int seq, float scale, const float* qgain, char* lds) {
  const int tid = threadIdx.x; float* ql = (float*)lds;
  if (tid < 256) {
    float ssq = 0.f;
    for (int d = 0; d < DQK; ++d) { const float v = pg8::bf2f(Qb[(long)tid * ldq + d]); ssq += v * v; }
    const float rs = QNORM ? 1.0f / sqrtf(ssq * (1.0f / DQK) + 1e-6f) : 1.f;
    for (int d = 0; d < DQK; ++d) { float v = pg8::bf2f(Qb[(long)tid * ldq + d]); if (QNORM) v = pg8::bf2f((bf16_t)(cvtpk(v * rs * qgain[d], 0.f) & 0xffffu)); ql[d * 256 + tid] = v; }
    float m = -1e30f, l = 0.f; float o[DV];
#pragma unroll
    for (int d = 0; d < DV; ++d) o[d] = 0.f;
    for (int k = 0; k < seq; ++k) { float s = 0.f;
      for (int d = 0; d < DQK; ++d) s += ql[d * 256 + tid] * pg8::bf2f(Kh[(long)k * ldk + d]);
      s *= scale; const float mn = fmaxf(m, s), al = __expf(m - mn), p = __expf(s - mn); l = l * al + p; m = mn;
#pragma unroll
      for (int d = 0; d < DV; ++d) o[d] = o[d] * al + p * pg8::bf2f(Vh[(long)k * ldv + d]); }
    const float il = 1.0f / l;
#pragma unroll
    for (int d = 0; d < DV; ++d) Ob[(long)tid * ldo + d] = (bf16_t)(cvtpk(o[d] * il, 0.f) & 0xffffu);
  }
  __syncthreads();
}
}

using pg8::bf16_t; using pg8::f32x4; using pg8::u32x4; using pg8::u32x2; using pg8::bf16x8; using pg8::bf2f; using pg8::bflo; using pg8::bfhi; using pg8::cvt_pk_bf16;
#define LAS __attribute__((address_space(3)))
constexpr int NBATCH = 2, SEQ = 8192, T = NBATCH * SEQ, DM = 1024, MEMLEN = 256, TM = NBATCH * MEMLEN;
constexpr int PROJ_LD = 1536, IN_COLS = 1440, DFF = 2816, DFF2 = 5632;
constexpr int NTHR = 512, NWAVES = 8;
constexpr float EPS = 1e-6f;
constexpr size_t MiB = 1u << 20;
constexpr size_t WS_SS = 1 * MiB, WS_WIN = 2 * MiB, WS_WUQ = 5 * MiB, WS_WUKV = 5 * MiB + 512 * 1024, WS_WG = 6 * MiB, WS_WOUT = 7 * MiB, WS_WMQ = 9 * MiB, WS_WMKV = 10 * MiB,
                 WS_WMO = 12 * MiB, WS_WUP = 13 * MiB, WS_WDN = 24 * MiB, WS_MEMN = 30 * MiB, WS_MEMKV = 31 * MiB, WS_XB = 32 * MiB, WS_KN = 32 * MiB, WS_AGG = 56 * MiB, WS_GAGG = 58 * MiB,
                 WS_PROJ = 64 * MiB, WS_CQ = 112 * MiB, WS_CKV = 120 * MiB, WS_XC = 124 * MiB, WS_QRAW = 156 * MiB, WS_KVRAW = 180 * MiB, WS_QN = 112 * MiB, WS_MLA = 136 * MiB,
                 WS_AMIX = 156 * MiB, WS_QMEM = 112 * MiB, WS_OMEM = 128 * MiB, WS_GU = 64 * MiB, WS_HID = 152 * MiB, WS_END = 240 * MiB;
constexpr int LDS_BYTES = 151552, LDSCTL_OFF = LDS_BYTES - 1024, MISC_OFF = LDSCTL_OFF + 320;
constexpr size_t WS_BAR = 65536, BAR_ZERO_BYTES = 16384;

struct Args { const void* in[33]; float* out; unsigned char* ws; int ph_lo, ph_hi; };

struct Ctx {
    LAS unsigned char* lds; char* ldsg;
    int tid, lane, wave, bid, G;
};
#define WSP(type, off) ((type*)(args.ws + (off)))

#define XB_TMO      128
#define XB_XCNT(j)  (256  + 64 * (j))
#define XB_XSUB(j)  (1280 + 64 * (j))
#define XB_XGEN(j)  (2304 + 64 * (j))
#define XB_TOP      3328
#define XB_TOPGEN   3392
#define XCD_BAR_WORDS 3456
#define XB_SPIN_CAP (1u << 18)

__device__ __forceinline__ unsigned xb_ld(unsigned* p)              { return __hip_atomic_load(p, __ATOMIC_RELAXED, __HIP_MEMORY_SCOPE_AGENT); }
__device__ __forceinline__ unsigned xb_add(unsigned* p, unsigned v) { return __hip_atomic_fetch_add(p, v, __ATOMIC_RELAXED, __HIP_MEMORY_SCOPE_AGENT); }
__device__ __forceinline__ unsigned xb_xcc_id() { return (unsigned)__builtin_amdgcn_s_getreg((3 << 11) | 20) & 0xFu; }
#define XB_SPIN(cond, bar) do { unsigned _sp = 0; while (cond) { __builtin_amdgcn_s_sleep(1); \
    if ((++_sp & 255u) == 0u) { if (xb_ld(&(bar)[XB_TMO])) break; if (_sp > XB_SPIN_CAP) { atomicAdd(&(bar)[XB_TMO], 1u); break; } } } } while (0)

struct XcdBarrier {
    unsigned* bar; unsigned x;
    volatile LAS unsigned* st;
};

__device__ __forceinline__ XcdBarrier xcd_barrier_post(unsigned* bar, volatile LAS unsigned* st) {
    XcdBarrier b; b.bar = bar; b.x = xb_xcc_id(); b.st = st;
    if (threadIdx.x == 0) (void)xb_add(&bar[XB_XCNT(b.x)], 1u);
    return b;
}
__device__ __forceinline__ void xcd_barrier_complete(unsigned* bar, unsigned x, unsigned& nloc, unsigned& nx) {
    const unsigned G = gridDim.x * gridDim.y * gridDim.z;
    unsigned sum, cnt, mine, sp = 0u;
    for (;;) {
        sum = 0u; cnt = 0u; mine = 0u;
#pragma unroll
        for (unsigned j = 0; j < 16; ++j) { const unsigned c = xb_ld(&bar[XB_XCNT(j)]); sum += c; cnt += (c > 0u) ? 1u : 0u; mine = (j == x) ? c : mine; }
        if (sum == G) break;
        __builtin_amdgcn_s_sleep(1);
        if ((++sp & 255u) == 0u) { if (xb_ld(&bar[XB_TMO])) break; if (sp > XB_SPIN_CAP) { atomicAdd(&bar[XB_TMO], 1u); break; } }
    }
    nloc = mine > 0u ? mine : 1u; nx = cnt > 0u ? cnt : 1u;
}

__device__ __forceinline__ void xcd_barrier(const XcdBarrier& b) {
    asm volatile("s_waitcnt vmcnt(0)" ::: "memory");
    __syncthreads();
    if (threadIdx.x == 0) {
        unsigned* bar = b.bar;
        __builtin_amdgcn_s_waitcnt(0);
        unsigned nloc = b.st[0], nx = b.st[1];
        if (nloc == 0u) { xcd_barrier_complete(bar, b.x, nloc, nx); b.st[0] = nloc; b.st[1] = nx; }
        const unsigned old = xb_add(&bar[XB_XSUB(b.x)], 1u);
        const unsigned gen = old / nloc;
        if (old + 1u == (gen + 1u) * nloc) {
            __builtin_amdgcn_fence(__ATOMIC_RELEASE, "agent");
            asm volatile("s_waitcnt vmcnt(0)" ::: "memory");
            const unsigned og = xb_add(&bar[XB_TOP], 1u);
            const unsigned tg = og / nx;
            if (og + 1u == (tg + 1u) * nx) xb_add(&bar[XB_TOPGEN], 1u);
            else XB_SPIN(xb_ld(&bar[XB_TOPGEN]) == tg, bar);
            __builtin_amdgcn_fence(__ATOMIC_ACQUIRE, "agent");
            xb_add(&bar[XB_XGEN(b.x)], 1u);
            asm volatile("s_waitcnt vmcnt(0)" ::: "memory");
        } else {
            XB_SPIN(xb_ld(&bar[XB_XGEN(b.x)]) == gen, bar);
            __builtin_amdgcn_fence(__ATOMIC_ACQUIRE, "agent");
            asm volatile("s_waitcnt vmcnt(0)" ::: "memory");
        }
    }
    __syncthreads();
}


__device__ __forceinline__ float wave_sum(float v) {
#pragma unroll
    for (int o = 1; o < 64; o <<= 1) v += __shfl_xor(v, o);
    return v;
}
__device__ __forceinline__ u32x4 pack8(const float* v) { u32x4 w; w.x = cvt_pk_bf16(v[0], v[1]); w.y = cvt_pk_bf16(v[2], v[3]); w.z = cvt_pk_bf16(v[4], v[5]); w.w = cvt_pk_bf16(v[6], v[7]); return w; }
__device__ __forceinline__ void unpack8(const u32x4 w, float* v) { v[0] = bflo(w.x); v[1] = bfhi(w.x); v[2] = bflo(w.y); v[3] = bfhi(w.y); v[4] = bflo(w.z); v[5] = bfhi(w.z); v[6] = bflo(w.w); v[7] = bfhi(w.w); }

template <bool FFNMAP = false> __device__ __forceinline__ void p0_transpose_item(const float* W, const float* gain, int K, int N, bf16_t* WT, LAS float* scr, int item, int lane) {
    const int nblk = N / 32, kb = item / nblk, nb = item % nblk, k0 = 64 * kb, n0 = 32 * nb;
    const int r0 = !FFNMAP ? n0 : (n0 < DFF ? (n0 / 128) * 256 + (n0 % 128) : ((n0 - DFF) / 128) * 256 + 128 + ((n0 - DFF) % 128));
    float tv[32];
#pragma unroll
    for (int i = 0; i < 32; ++i) tv[i] = W[(size_t)(k0 + 2 * i + (lane >> 5)) * N + n0 + (lane & 31)];
#pragma unroll
    for (int i = 0; i < 32; ++i) { const int kk = 2 * i + (lane >> 5); float v = tv[i]; if (gain) v *= gain[k0 + kk]; scr[kk * 33 + (lane & 31)] = v; }
    asm volatile("s_waitcnt lgkmcnt(0)" ::: "memory");
    const int cch = lane & 7;
#pragma unroll
    for (int j = 0; j < 4; ++j) { const int n = (lane >> 3) + 8 * j; const LAS float* s = scr + (8 * cch) * 33 + n;
        u32x4 o; o.x = cvt_pk_bf16(s[0 * 33], s[1 * 33]); o.y = cvt_pk_bf16(s[2 * 33], s[3 * 33]); o.z = cvt_pk_bf16(s[4 * 33], s[5 * 33]); o.w = cvt_pk_bf16(s[6 * 33], s[7 * 33]);
        *(u32x4*)(WT + (size_t)(r0 + n) * K + k0 + 8 * cch) = o; }
    asm volatile("s_waitcnt lgkmcnt(0)" ::: "memory");
}
__device__ __forceinline__ void norm_row_1024(const float* xrow, const float* gain, bf16_t* orow, int lane) {
    const f32x4* xr = (const f32x4*)xrow + lane; const f32x4* gr = (const f32x4*)gain + lane;
    f32x4 v[4]; float s = 0.f;
#pragma unroll
    for (int j = 0; j < 4; ++j) { v[j] = xr[64 * j]; s += (v[j][0] * v[j][0] + v[j][1] * v[j][1]) + (v[j][2] * v[j][2] + v[j][3] * v[j][3]); }
    const float rs = 1.0f / sqrtf(wave_sum(s) * (1.0f / 1024.0f) + EPS);
#pragma unroll
    for (int j = 0; j < 4; ++j) { const f32x4 g = gr[64 * j]; u32x2 w; w.x = cvt_pk_bf16(v[j][0] * rs * g[0], v[j][1] * rs * g[1]); w.y = cvt_pk_bf16(v[j][2] * rs * g[2], v[j][3] * rs * g[3]);
        *((u32x2*)orow + lane + 64 * j) = w; }
}
__device__ __forceinline__ void norm_row2_1024(const float* xa, const float* xb2, const float* gain, bf16_t* oa, bf16_t* ob, int lane) {
    const f32x4* pa = (const f32x4*)xa + lane; const f32x4* pb = (const f32x4*)xb2 + lane; const f32x4* gr = (const f32x4*)gain + lane;
    f32x4 va[4], vb[4]; float sa = 0.f, sb = 0.f;
#pragma unroll
    for (int j = 0; j < 4; ++j) { va[j] = pa[64 * j]; vb[j] = pb[64 * j]; }
#pragma unroll
    for (int j = 0; j < 4; ++j) { sa += (va[j][0] * va[j][0] + va[j][1] * va[j][1]) + (va[j][2] * va[j][2] + va[j][3] * va[j][3]); sb += (vb[j][0] * vb[j][0] + vb[j][1] * vb[j][1]) + (vb[j][2] * vb[j][2] + vb[j][3] * vb[j][3]); }
#pragma unroll
    for (int o = 1; o < 64; o <<= 1) { sa += __shfl_xor(sa, o); sb += __shfl_xor(sb, o); }
    const float ra = 1.0f / sqrtf(sa * (1.0f / 1024.0f) + EPS), rb = 1.0f / sqrtf(sb * (1.0f / 1024.0f) + EPS);
#pragma unroll
    for (int j = 0; j < 4; ++j) { const f32x4 g = gr[64 * j]; u32x2 w;
        w.x = cvt_pk_bf16(va[j][0] * ra * g[0], va[j][1] * ra * g[1]); w.y = cvt_pk_bf16(va[j][2] * ra * g[2], va[j][3] * ra * g[3]); *((u32x2*)oa + lane + 64 * j) = w;
        w.x = cvt_pk_bf16(vb[j][0] * rb * g[0], vb[j][1] * rb * g[1]); w.y = cvt_pk_bf16(vb[j][2] * rb * g[2], vb[j][3] * rb * g[3]); *((u32x2*)ob + lane + 64 * j) = w; }
}
__device__ __forceinline__ void phase0(Ctx& c, const Args& args) {
    LAS float* scr = (LAS float*)(c.lds + c.wave * 16384);
    const int gw = c.bid * NWAVES + c.wave, NGW = c.G * NWAVES;
    constexpr int I_IN = 16 * 45, I_UQ = 4 * 24, I_UKV = 2 * 32, I_OUT = 16 * 32, I_MQ = 16 * 16, I_MKV = 16 * 32, I_MO = 8 * 32, I_UP = 16 * 176, I_DN = 44 * 32;
    constexpr int NITEMS = I_IN + I_UQ + I_UKV + I_MKV;
    const int hw = c.bid * 4 + (c.wave & 3), NHW = c.G * 4;
    if (c.wave < 4) for (int it = hw; it < NITEMS; it += NHW) {
        int r = it;
        if (r < I_IN) { p0_transpose_item(((const float*)args.in[4]), nullptr, 1024, IN_COLS, WSP(bf16_t, WS_WIN), scr, r, c.lane); continue; } r -= I_IN;
        if (r < I_UQ) { p0_transpose_item(((const float*)args.in[13]), nullptr, 256, 768, WSP(bf16_t, WS_WUQ), scr, r, c.lane); continue; } r -= I_UQ;
        if (r < I_UKV) { p0_transpose_item(((const float*)args.in[15]), nullptr, 128, 1024, WSP(bf16_t, WS_WUKV), scr, r, c.lane); continue; } r -= I_UKV;
        p0_transpose_item(((const float*)args.in[24]), nullptr, 1024, 1024, WSP(bf16_t, WS_WMKV), scr, r, c.lane);
    }
    constexpr int PSPLIT = 4864;
    for (int p = (c.wave < 4 ? PSPLIT : 0) + hw; p < (c.wave < 4 ? T / 2 : PSPLIT); p += NHW) { const int m = 2 * p; norm_row2_1024(((const float*)args.in[0]) + (size_t)m * DM, ((const float*)args.in[0]) + (size_t)(m + 1) * DM, ((const float*)args.in[3]), WSP(bf16_t, WS_XB) + (size_t)m * DM, WSP(bf16_t, WS_XB) + (size_t)(m + 1) * DM, c.lane); }
    if (c.wave >= 4) { for (int m = 2 * T; m < T; m += 2 * NHW) norm_row2_1024(((const float*)args.in[0]) + (size_t)m * DM, ((const float*)args.in[0]) + (size_t)(m + 1) * DM, ((const float*)args.in[3]), WSP(bf16_t, WS_XB) + (size_t)m * DM, WSP(bf16_t, WS_XB) + (size_t)(m + 1) * DM, c.lane);
           for (int m = hw; m < TM; m += NHW) norm_row_1024(((const float*)args.in[1]) + (size_t)m * DM, ((const float*)args.in[22]), WSP(bf16_t, WS_MEMN) + (size_t)m * DM, c.lane); }
    const int gt = c.bid * NTHR + c.tid, NGT = c.G * NTHR;
    for (int i = gt; i < (PROJ_LD - IN_COLS) * 1024 / 8; i += NGT) *((u32x4*)(WSP(bf16_t, WS_WIN) + (size_t)IN_COLS * 1024) + i) = (u32x4){0u, 0u, 0u, 0u};
    for (int i = gt; i < 8 * 256 * 128; i += NGT) {
        const int k = i & 127, n = (i >> 7) & 255, grp = i >> 15, d = grp >> 2, png = grp & 3;
        const int gate = n >> 7, cl = n & 127, blk_n = cl >> 6, dout = cl & 63, blk_k = k >> 6, cin = k & 63;
        float v = 0.f;
        if (blk_n == blk_k) { const float* W = gate ? ((const float*)args.in[9]) : ((const float*)args.in[7]); v = W[((size_t)(d * 8 + png * 2 + blk_n) * 64 + cin) * 64 + dout]; }
        WSP(bf16_t, WS_WG)[i] = (bf16_t)(cvt_pk_bf16(v, 0.f) & 0xffffu);
    }
    for (int i = gt; i < 1024; i += NGT) WSP(float, 0)[i] = -8.0f * log1pf(expf(-((const float*)args.in[11])[i]));
}

__device__ __forceinline__ void phase2(Ctx& c, const Args& args) {
    const int gw = c.bid * NWAVES + c.wave, NGW = c.G * NWAVES, lane = c.lane;
    const bf16_t* __restrict__ proj = WSP(bf16_t, WS_PROJ);
    bf16_t* __restrict__ cqo = WSP(bf16_t, WS_CQ); bf16_t* __restrict__ ckvo = WSP(bf16_t, WS_CKV); bf16_t* __restrict__ xco = WSP(bf16_t, WS_XC);
    const int ch = lane * 8;
    float wf[4][8], wb[4][8], bf_[8], bb_[8];
#pragma unroll
    for (int e = 0; e < 8; ++e) { bf_[e] = ((const float*)args.in[6])[ch + e]; bb_[e] = ((const float*)args.in[6])[512 + ch + e];
#pragma unroll
        for (int k = 0; k < 4; ++k) { wf[k][e] = ((const float*)args.in[5])[(0 * 4 + k) * 512 + ch + e]; wb[k][e] = ((const float*)args.in[5])[(1 * 4 + k) * 512 + ch + e]; } }
    const f32x4 gq = *(const f32x4*)(((const float*)args.in[12]) + lane * 4); const float gkv0 = ((const float*)args.in[14])[lane * 2], gkv1 = ((const float*)args.in[14])[lane * 2 + 1];
    for (int row = gw; row < T; row += NGW) {
        const bf16_t* pr = proj + (size_t)row * PROJ_LD;
        const int t = row & (SEQ - 1);
        u32x4 xr[7];
#pragma unroll
        for (int dt = -3; dt <= 3; ++dt) { const int tt = t + dt; xr[dt + 3] = (tt >= 0 && tt < SEQ) ? *(const u32x4*)(pr + (long)dt * PROJ_LD + ch) : (u32x4){0u, 0u, 0u, 0u}; }
        const u32x2 wq = *(const u32x2*)(pr + 1024 + lane * 4); const unsigned wk = *(const unsigned*)(pr + 1280 + lane * 2);
        {
            float v[4] = {bflo(wq.x), bfhi(wq.x), bflo(wq.y), bfhi(wq.y)}; const float v0 = bflo(wk), v1 = bfhi(wk);
            float sq = (v[0] * v[0] + v[1] * v[1]) + (v[2] * v[2] + v[3] * v[3]), sk = v0 * v0 + v1 * v1;
#pragma unroll
            for (int o = 1; o < 64; o <<= 1) { sq += __shfl_xor(sq, o); sk += __shfl_xor(sk, o); }
            const float rq = 1.0f / sqrtf(sq * (1.0f / 256.0f) + EPS), rk = 1.0f / sqrtf(sk * (1.0f / 128.0f) + EPS);
            u32x2 o; o.x = cvt_pk_bf16(v[0] * rq * gq[0], v[1] * rq * gq[1]); o.y = cvt_pk_bf16(v[2] * rq * gq[2], v[3] * rq * gq[3]);
            *(u32x2*)(cqo + (size_t)row * 256 + lane * 4) = o;
            *(unsigned*)(ckvo + (size_t)row * 128 + lane * 2) = cvt_pk_bf16(v0 * rk * gkv0, v1 * rk * gkv1);
        }
        {
            float xs[7][8];
#pragma unroll
            for (int i = 0; i < 7; ++i) unpack8(xr[i], xs[i]);
            float of[8], ob[8];
#pragma unroll
            for (int e = 0; e < 8; ++e) { of[e] = bf_[e]; ob[e] = bb_[e]; }
#pragma unroll
            for (int k = 0; k < 4; ++k)
#pragma unroll
                for (int e = 0; e < 8; ++e) { of[e] += wf[k][e] * xs[k][e]; ob[e] += wb[k][e] * xs[3 + k][e]; }
            *(u32x4*)(xco + (size_t)row * 512 + ch) = pack8(of);
            *(u32x4*)(xco + ((size_t)T + row) * 512 + ch) = pack8(ob);
        }
    }
    for (int row = gw; row < TM; row += NGW) {
        bf16_t* kp = WSP(bf16_t, WS_MEMKV) + (size_t)row * 1024 + lane * 8; float v[8]; unpack8(*(const u32x4*)kp, v);
        float s = 0.f;
#pragma unroll
        for (int e = 0; e < 8; ++e) s += v[e] * v[e];
        s += __shfl_xor(s, 1); s += __shfl_xor(s, 2); s += __shfl_xor(s, 4); s += __shfl_xor(s, 8);
        const float rs = 1.0f / sqrtf(s * (1.0f / 128.0f) + EPS);
#pragma unroll
        for (int e = 0; e < 8; ++e) v[e] *= rs * ((const float*)args.in[26])[(lane & 15) * 8 + e];
        *(u32x4*)kp = pack8(v);
    }
}

struct KPrep { float gnk[8], grk1[2], grk2[2], invf[2]; };
__device__ __forceinline__ KPrep kprep_init(const Args& args, int sub) {
    KPrep k;
#pragma unroll
    for (int e = 0; e < 8; ++e) k.gnk[e] = ((const float*)args.in[17])[sub * 8 + e];
#pragma unroll
    for (int jj = 0; jj < 2; ++jj) { k.grk1[jj] = ((const float*)args.in[17])[64 + 2 * sub + jj]; k.grk2[jj] = ((const float*)args.in[17])[80 + 2 * sub + jj]; k.invf[jj] = exp2f(-(float)(2 * sub + jj) * 0.8304820237218406f); }
    return k;
}
__device__ __forceinline__ void kprep_rowhead(const Args& args, const KPrep& k, int row, int h, int sub) {
    const bf16_t* __restrict__ proj = WSP(bf16_t, WS_PROJ); const bf16_t* __restrict__ kvraw = WSP(bf16_t, WS_KVRAW); bf16_t* __restrict__ Kn = WSP(bf16_t, WS_KN);
    const bf16_t* kp = kvraw + (size_t)row * 1024 + h * 128; const bf16_t* rp = proj + (size_t)row * PROJ_LD + 1408 + 2 * sub;
    const u32x4 kv = *(const u32x4*)(kp + sub * 8);
    const unsigned k1 = *(const unsigned*)rp, k2 = *(const unsigned*)(rp + 16);
    const float posf = (float)((const int*)args.in[2])[row]; float cs[2], sn[2];
#pragma unroll
    for (int jj = 0; jj < 2; ++jj) { const float ang = posf * k.invf[jj]; const double rev = (double)ang * 0.15915494309189535; const float fr = (float)(rev - rint(rev));
        cs[jj] = __builtin_amdgcn_cosf(fr); sn[jj] = __builtin_amdgcn_sinf(fr); }
    float vk[8]; unpack8(kv, vk);
    float tk1[2] = {bflo(k1), bfhi(k1)}, tk2[2] = {bflo(k2), bfhi(k2)};
    float sk = (tk1[0] * tk1[0] + tk1[1] * tk1[1]) + (tk2[0] * tk2[0] + tk2[1] * tk2[1]);
#pragma unroll
    for (int e = 0; e < 8; ++e) sk += vk[e] * vk[e];
#pragma unroll
    for (int o = 1; o < 8; o <<= 1) sk += __shfl_xor(sk, o);
    const float rk = 1.0f / sqrtf(sk * (1.0f / 96.0f) + EPS);
#pragma unroll
    for (int e = 0; e < 8; ++e) vk[e] *= rk * k.gnk[e];
    float ok1[2], ok2[2];
#pragma unroll
    for (int jj = 0; jj < 2; ++jj) { const float b1 = tk1[jj] * rk * k.grk1[jj], b2 = tk2[jj] * rk * k.grk2[jj]; ok1[jj] = b1 * cs[jj] - b2 * sn[jj]; ok2[jj] = b1 * sn[jj] + b2 * cs[jj]; }
    bf16_t* ok = Kn + ((size_t)((row >> 13) * 8 + h) * SEQ + (row & (SEQ - 1))) * 96;
    *(u32x4*)(ok + sub * 8) = pack8(vk); *(unsigned*)(ok + 64 + 2 * sub) = cvt_pk_bf16(ok1[0], ok1[1]); *(unsigned*)(ok + 80 + 2 * sub) = cvt_pk_bf16(ok2[0], ok2[1]);
}

__device__ __forceinline__ float gelu_tanh(float y) { const float u = 0.7978845608028654f * (y + 0.044715f * y * y * y); const float th = 1.0f - 2.0f / (__expf(2.0f * u) + 1.0f); return 0.5f * y * (1.0f + th); }
__device__ __forceinline__ void phase6(Ctx& c, const Args& args) {
    const unsigned* Gt = (const unsigned*)args.out; const float2* agg = WSP(float2, WS_AGG); const bf16_t* proj = WSP(bf16_t, WS_PROJ);
    LAS float* hl = (LAS float*)c.lds;
    bf16_t* amix = WSP(bf16_t, WS_AMIX); const bf16_t* mla = WSP(bf16_t, WS_MLA);
    const int ch = c.tid;
    for (int chunk = c.bid; chunk < 256; chunk += c.G) {
        const int b = chunk >> 7, cc = chunk & 127;
        float cf = 0.f, cb = 0.f;
        {
            const float2* gagg = WSP(float2, WS_GAGG); const int g0 = cc >> 2;
            float2 gf[32], gb[32], af[3], ab[3];
#pragma unroll
            for (int k = 0; k < 32; ++k) { gf[k] = gagg[((size_t)b * 32 + k) * 512 + ch]; gb[k] = gagg[((size_t)64 + b * 32 + 31 - k) * 512 + ch]; }
#pragma unroll
            for (int k = 0; k < 3; ++k) { af[k] = agg[((size_t)b * 128 + g0 * 4 + k) * 512 + ch]; ab[k] = agg[((size_t)256 + b * 128 + g0 * 4 + 3 - k) * 512 + ch]; }
#pragma unroll
            for (int k = 0; k < 32; ++k) { if (k < g0) cf = __expf(gf[k].x) * cf + gf[k].y; if (31 - k > g0) cb = __expf(gb[k].x) * cb + gb[k].y; }
#pragma unroll
            for (int k = 0; k < 3; ++k) { if (g0 * 4 + k < cc) cf = __expf(af[k].x) * cf + af[k].y; if (g0 * 4 + 3 - k > cc) cb = __expf(ab[k].x) * cb + ab[k].y; }
        }
        const size_t row0 = (size_t)chunk * 64;
        { const unsigned* gp = Gt + row0 * 512 + ch; float hcur = cf;
#pragma unroll 1
          for (int i0 = 0; i0 < 64; i0 += 32) { unsigned wv[32];
#pragma unroll
              for (int k = 0; k < 32; ++k) wv[k] = gp[(size_t)(i0 + k) * 512];
#pragma unroll
              for (int k = 0; k < 32; ++k) { hcur = __expf(bflo(wv[k])) * hcur + bfhi(wv[k]); hl[(i0 + k) * 512 + ch] = hcur; } } }
        { const unsigned* gp = Gt + ((size_t)T + row0) * 512 + ch; const bf16_t* yp = proj + row0 * PROJ_LD + 512 + ch; float hcur = cb;
#pragma unroll 1
          for (int i0 = 63; i0 >= 0; i0 -= 32) { unsigned wv[32]; bf16_t yv[32];
#pragma unroll
              for (int k = 0; k < 32; ++k) { wv[k] = gp[(size_t)(i0 - k) * 512]; yv[k] = yp[(size_t)(i0 - k) * PROJ_LD]; }
#pragma unroll
              for (int k = 0; k < 32; ++k) { const int i = i0 - k; hcur = __expf(bflo(wv[k])) * hcur + bfhi(wv[k]); hl[i * 512 + ch] = (hl[i * 512 + ch] + hcur) * gelu_tanh(bf2f(yv[k])); } } }
        __syncthreads();
        { const bf16_t* __restrict__ mlar = mla; bf16_t* __restrict__ amo = amix; float gl[8], gm[8]; u32x4 mv[8];
#pragma unroll
          for (int e = 0; e < 8; ++e) { gl[e] = ((const float*)args.in[18])[c.lane * 8 + e]; gm[e] = ((const float*)args.in[19])[c.lane * 8 + e]; }
#pragma unroll
          for (int rr = 0; rr < 8; ++rr) mv[rr] = *(const u32x4*)(mlar + (row0 + c.wave * 8 + rr) * 512 + c.lane * 8);
#pragma unroll
          for (int rr = 0; rr < 8; ++rr) { const int r = c.wave * 8 + rr; const size_t row = row0 + r;
            float v[8], w[8]; { const LAS f32x4* p = (const LAS f32x4*)(hl + r * 512 + c.lane * 8); const f32x4 a = p[0], bq = p[1]; v[0] = a[0]; v[1] = a[1]; v[2] = a[2]; v[3] = a[3]; v[4] = bq[0]; v[5] = bq[1]; v[6] = bq[2]; v[7] = bq[3]; }
            unpack8(mv[rr], w);
            float s = 0.f, s2 = 0.f;
#pragma unroll
            for (int e = 0; e < 8; ++e) { s += v[e] * v[e]; s2 += w[e] * w[e]; }
#pragma unroll
            for (int o = 1; o < 64; o <<= 1) { s += __shfl_xor(s, o); s2 += __shfl_xor(s2, o); }
            const float rs = 1.0f / sqrtf(s * (1.0f / 512.0f) + EPS), rs2 = 1.0f / sqrtf(s2 * (1.0f / 512.0f) + EPS);
#pragma unroll
            for (int e = 0; e < 8; ++e) { v[e] *= rs * gl[e]; w[e] *= rs2 * gm[e]; }
            *(u32x4*)(amo + row * 1024 + c.lane * 8) = pack8(v);
            *(u32x4*)(amo + row * 1024 + 512 + c.lane * 8) = pack8(w); } }
        __syncthreads();
    }
}

typedef float f32x2 __attribute__((ext_vector_type(2)));
__device__ __forceinline__ void unpack8v(const u32x4 w, f32x2* v) { v[0] = (f32x2){bflo(w.x), bfhi(w.x)}; v[1] = (f32x2){bflo(w.y), bfhi(w.y)}; v[2] = (f32x2){bflo(w.z), bfhi(w.z)}; v[3] = (f32x2){bflo(w.w), bfhi(w.w)}; }
__device__ __forceinline__ void phase12(Ctx& c, const Args& args, int bsel) {
    const bf16_t* __restrict__ gu = WSP(bf16_t, WS_GU); bf16_t* __restrict__ hid = WSP(bf16_t, WS_HID) + (size_t)bsel * SEQ * DFF;
    const float* __restrict__ cw = ((const float*)args.in[30]); const float* __restrict__ cb = ((const float*)args.in[31]);
    if (c.tid >= DFF / 8) return;
    const int j = c.tid * 8;
    f32x2 wg[3][4], wu[3][4], bg[4], bu[4];
#pragma unroll
    for (int e = 0; e < 4; ++e) { bg[e] = *(const f32x2*)(cb + j + 2 * e); bu[e] = *(const f32x2*)(cb + DFF + j + 2 * e);
#pragma unroll
        for (int k = 0; k < 3; ++k) { wg[k][e] = *(const f32x2*)(cw + (size_t)k * DFF2 + j + 2 * e); wu[k][e] = *(const f32x2*)(cw + (size_t)k * DFF2 + DFF + j + 2 * e); } }
    for (int chunk = c.bid; chunk < SEQ / 32; chunk += c.G) {
        const int t0 = chunk * 32;
        u32x4 rg[4], ru[4];
        const u32x4 z4 = (u32x4){0u, 0u, 0u, 0u};
#define P12_LOAD(s, k) do { const int tt_ = t0 - 1 + (s); if (tt_ >= 0 && tt_ < SEQ && (s) < 34) { rg[k] = *(const u32x4*)(gu + (size_t)tt_ * DFF2 + j); ru[k] = *(const u32x4*)(gu + (size_t)tt_ * DFF2 + DFF + j); } else { rg[k] = z4; ru[k] = z4; } } while (0)
#pragma unroll
        for (int k = 0; k < 4; ++k) P12_LOAD(k, k);
        f32x2 wing[3][4], winu[3][4];
#pragma unroll 1
        for (int s0 = 0; s0 < 36; s0 += 12) {
#pragma unroll
            for (int k = 0; k < 12; ++k) { const int s = s0 + k; constexpr int dummy = 0; (void)dummy;
                const int sn = k % 3, sq = (k + 2) % 3, sp = (k + 1) % 3;
                unpack8v(rg[k & 3], wing[sn]); unpack8v(ru[k & 3], winu[sn]);
                P12_LOAD(s + 4, k & 3);
                if (s >= 2 && s < 34) { u32x4 o; unsigned ow[4];
#pragma unroll
                    for (int e = 0; e < 4; ++e) { const f32x2 G = bg[e] + wg[0][e] * wing[sp][e] + wg[1][e] * wing[sq][e] + wg[2][e] * wing[sn][e]; const f32x2 U = bu[e] + wu[0][e] * winu[sp][e] + wu[1][e] * winu[sq][e] + wu[2][e] * winu[sn][e];
                        const f32x2 a = G * (-1.4426950408889634f); f32x2 d; d.x = __builtin_amdgcn_exp2f(a.x); d.y = __builtin_amdgcn_exp2f(a.y); d = d + 1.0f;
                        f32x2 r; r.x = __builtin_amdgcn_rcpf(d.x); r.y = __builtin_amdgcn_rcpf(d.y); const f32x2 h = G * r * U; ow[e] = cvt_pk_bf16(h.x, h.y); }
                    o.x = ow[0]; o.y = ow[1]; o.z = ow[2]; o.w = ow[3];
                    *(u32x4*)(hid + (size_t)(t0 + s - 2) * DFF + j) = o; } }
        }
#undef P12_LOAD
    }
}

template <class Epi, class Sched> __device__ __forceinline__ void run_gemm(Ctx& c, const pg8::Gemm g, const Sched& S, const Epi& E) {
#if FAST_GEMM
    pg8::gemm_phase<Epi, Sched, true, true>(c.lds, g, S, E);
#else
    pg8::gemm_naive<Epi, Sched>(g, S, E);
#endif
}
__device__ __forceinline__ pg8::Sched2 sched1(Ctx& c, const void* A, const void* B, int nM, int nN, int lda, int ldb) {
    pg8::Sched2 s; s.a = pg8::Job{(const char*)A, (const char*)B, nM, nN}; s.b = pg8::Job{nullptr, nullptr, 0, 0}; s.G = c.G; s.c = c.bid; s.lda = lda; s.ldb = ldb; return s;
}
template <int DQK, int DV, bool QNORM, bool FIXED> __device__ __forceinline__ void run_attn(Ctx& c, const bf16_t* Qb, int ldq, const bf16_t* Kh, int ldk, const bf16_t* Vh, int ldv, bf16_t* Ob, int ldo, int seq, float scale, const float* qg, const int* qpos) {
    att::attn_unit<DQK, DV, QNORM, FIXED>(Qb, ldq, Kh, ldk, Vh, ldv, Ob, ldo, seq, scale, qg, qpos, c.ldsg);
}

__device__ __forceinline__ void ph1(Ctx& c, const Args& args) {
    pg8::Sched2 S; S.a = pg8::Job{(const char*)WSP(bf16_t, WS_XB), (const char*)WSP(bf16_t, WS_WIN), T / 256, PROJ_LD / 256};
    S.b = pg8::Job{(const char*)WSP(bf16_t, WS_MEMN), (const char*)WSP(bf16_t, WS_WMKV), TM / 256, 4}; S.G = c.G; S.c = c.bid; S.lda = 1024; S.ldb = 1024;
    pg8::EpiBf<false> E{WSP(bf16_t, WS_PROJ), PROJ_LD, WSP(bf16_t, WS_MEMKV), 1024, nullptr, nullptr};
    run_gemm(c, pg8::Gemm{1024, 1024, 1024}, S, E);
}
__device__ __forceinline__ void ph3_weights(Ctx& c, const Args& args, int first, int stride) {
    constexpr int I_OUT = 16 * 32, I_MQ = 16 * 16, I_MO = 8 * 32; LAS float* scr = (LAS float*)(c.lds + c.wave * 16384);
    for (int it = first; it < I_OUT + I_MQ + I_MO; it += stride) {
        if (it < I_OUT) p0_transpose_item(((const float*)args.in[20]), nullptr, 1024, 1024, WSP(bf16_t, WS_WOUT), scr, it, c.lane);
        else if (it < I_OUT + I_MQ) p0_transpose_item(((const float*)args.in[23]), ((const float*)args.in[21]), 1024, 512, WSP(bf16_t, WS_WMQ), scr, it - I_OUT, c.lane);
        else p0_transpose_item(((const float*)args.in[27]), nullptr, 512, 1024, WSP(bf16_t, WS_WMO), scr, it - I_OUT - I_MQ, c.lane); }
    __syncthreads();
}
__device__ __forceinline__ void ph3(Ctx& c, const Args& args) {
    { constexpr int NQ = (T / 256) * 3;
      if (c.G > NQ) { if (c.bid >= NQ) ph3_weights(c, args, (c.bid - NQ) * NWAVES + c.wave, (c.G - NQ) * NWAVES); }
      else ph3_weights(c, args, c.bid * NWAVES + c.wave, c.G * NWAVES); }
    { pg8::Sched2 S = sched1(c, WSP(bf16_t, WS_CQ), WSP(bf16_t, WS_WUQ), T / 256, 3, 256, 256); pg8::EpiBf<false> E{WSP(bf16_t, WS_QRAW), 768, nullptr, 0, nullptr, nullptr}; run_gemm(c, pg8::Gemm{256, 256, 256}, S, E); }
    { pg8::Sched2 S = sched1(c, WSP(bf16_t, WS_CKV), WSP(bf16_t, WS_WUKV), T / 256, 4, 128, 128); pg8::EpiBf<false> E{WSP(bf16_t, WS_KVRAW), 1024, nullptr, 0, nullptr, nullptr}; run_gemm(c, pg8::Gemm{128, 128, 128}, S, E);
      asm volatile("s_waitcnt vmcnt(0)" ::: "memory"); __syncthreads();
      const int sub = c.tid & 7; const KPrep kp_ = kprep_init(args, sub); pg8::Unit u;
      for (int i = 0; S.next(i, u); ++i)
#pragma unroll 2
          for (int p = 0; p < 8; ++p) { const int pi = p * 64 + (c.tid >> 3); kprep_rowhead(args, kp_, u.pm * 256 + (pi >> 1), 2 * u.pn + (pi & 1), sub); } }
    { pg8::GateOrder S{(const char*)WSP(bf16_t, WS_XC), (const char*)WSP(bf16_t, WS_WG), (size_t)T * 512 * 2, c.G, c.bid};
      pg8::EpiGates E{WSP(bf16_t, WS_XC), ((const float*)args.in[8]), ((const float*)args.in[10]), WSP(float, 0), (unsigned*)args.out, T}; run_gemm(c, pg8::Gemm{128, 512, 128}, S, E);
      asm volatile("s_waitcnt vmcnt(0)" ::: "memory"); __syncthreads();
      const unsigned* Gt = (const unsigned*)args.out; float2* agg = WSP(float2, WS_AGG); pg8::Unit u;
      for (int i = 0; S.next(i, u); ++i) { const int d = u.job, chunk = u.pm * 4 + (c.tid >> 7), ch = u.pn * 128 + (c.tid & 127);
          const unsigned* gp = Gt + ((size_t)d * T + (size_t)chunk * 64) * 512 + ch;
          float sl = 0.f, bv = 0.f; unsigned wv[64];
#pragma unroll
          for (int k = 0; k < 64; ++k) wv[k] = gp[(size_t)(d ? 63 - k : k) * 512];
#pragma unroll
          for (int k = 0; k < 64; ++k) { const float la = bflo(wv[k]); sl += la; bv = __expf(la) * bv + bfhi(wv[k]); }
          agg[((size_t)d * 256 + chunk) * 512 + ch] = make_float2(sl, bv);
          typedef float gl2_t __attribute__((ext_vector_type(2))); LAS gl2_t* gl = (LAS gl2_t*)(c.lds + 131072); const int cq = c.tid >> 7, chl = c.tid & 127;
          gl[cq * 128 + chl] = (gl2_t){sl, bv}; __syncthreads();
          if (cq == 0) { float S = 0.f, B = 0.f;
#pragma unroll
              for (int k = 0; k < 4; ++k) { const gl2_t a = gl[(d ? 3 - k : k) * 128 + chl]; S += a.x; B = __expf(a.x) * B + a.y; }
              WSP(float2, WS_GAGG)[((size_t)d * 64 + u.pm) * 512 + ch] = make_float2(S, B); }
          __syncthreads(); } }
}
__device__ __forceinline__ void ph5(Ctx& c, const Args& args) {
    float gq = 0.f, gk = 0.f;
    for (int i = c.lane; i < 96; i += 64) { gq = fmaxf(gq, fabsf(((const float*)args.in[16])[i])); gk = fmaxf(gk, fabsf(((const float*)args.in[17])[i])); }
#pragma unroll
    for (int o = 1; o < 64; o <<= 1) { gq = fmaxf(gq, __shfl_xor(gq, o)); gk = fmaxf(gk, __shfl_xor(gk, o)); }
    const bool bounded = __builtin_amdgcn_readfirstlane((int)(9.797958971f * 1.02f * gq * gk * 1.4426950408889634f <= 60.0f)) != 0;
    for (int L = c.bid; L < 512; L += c.G) { const int bh = (L >> 8) * 8 + (L & 7), qb = (L & 255) >> 3; const int b = bh >> 3, h = bh & 7;
        const bf16_t* Qp = WSP(bf16_t, WS_QRAW) + ((size_t)b * SEQ + qb * 256) * 768 + h * 96; const int* qpos = ((const int*)args.in[2]) + (size_t)b * SEQ + qb * 256; const bf16_t* Kp = WSP(bf16_t, WS_KN) + (size_t)(b * 8 + h) * SEQ * 96;
        const bf16_t* Vp = WSP(bf16_t, WS_KVRAW) + (size_t)b * SEQ * 1024 + h * 128 + 64; bf16_t* Op = WSP(bf16_t, WS_MLA) + ((size_t)b * SEQ + qb * 256) * 512 + h * 64;
        if (bounded) run_attn<96, 64, true, true>(c, Qp, 768, Kp, 96, Vp, 1024, Op, 512, SEQ, 0.10206207261596575f, ((const float*)args.in[16]), qpos);
        else run_attn<96, 64, true, false>(c, Qp, 768, Kp, 96, Vp, 1024, Op, 512, SEQ, 0.10206207261596575f, ((const float*)args.in[16]), qpos); }
}
__device__ __forceinline__ void ph7(Ctx& c, const Args& args) {
    pg8::Sched2 S = sched1(c, WSP(bf16_t, WS_AMIX), WSP(bf16_t, WS_WOUT), T / 256, 4, 1024, 1024); pg8::EpiResid<true, false> E{((const float*)args.in[0]), nullptr, nullptr, WSP(bf16_t, WS_XB), WSP(float, WS_SS)};
    run_gemm(c, pg8::Gemm{1024, 1024, 1024}, S, E);
}
__device__ __forceinline__ void ph8(Ctx& c, const Args& args) {
    constexpr int NU = (T / 256) * 2;
    if (c.bid >= NU && c.G > NU) {
        LAS float* scr = (LAS float*)(c.lds + c.wave * 16384);
        constexpr int I_UP = 16 * 176, I_DN = 44 * 32;
        const int hw = (c.bid - NU) * NWAVES + c.wave, NHW = (c.G - NU) * NWAVES;
        for (int it = hw; it < I_UP + I_DN; it += NHW) {
            if (it < I_UP) p0_transpose_item<true>(((const float*)args.in[29]), ((const float*)args.in[28]), 1024, DFF2, WSP(bf16_t, WS_WUP), scr, it, c.lane);
            else p0_transpose_item(((const float*)args.in[32]), nullptr, DFF, 1024, WSP(bf16_t, WS_WDN), scr, it - I_UP, c.lane);
        }
        return;
    }
    pg8::Sched2 S = sched1(c, WSP(bf16_t, WS_XB), WSP(bf16_t, WS_WMQ), T / 256, 2, 1024, 1024);
    LAS float* rsl = (LAS float*)(c.lds + 131072); bool one_unit;
    { pg8::Unit u0, u1; const bool h0 = S.next(0, u0); one_unit = h0 && !S.next(1, u1); if (one_unit && c.tid < 256) rsl[c.tid] = pg8::rowscale16(WSP(float, WS_SS), u0.pm * 256 + c.tid); __syncthreads(); }
    pg8::EpiBf<true> E{WSP(bf16_t, WS_QMEM), 512, nullptr, 0, WSP(float, WS_SS), one_unit ? rsl : nullptr};
    run_gemm(c, pg8::Gemm{1024, 1024, 1024}, S, E);
    if (c.G <= NU) {
        LAS float* scr = (LAS float*)(c.lds + c.wave * 16384); constexpr int I_UP = 16 * 176, I_DN = 44 * 32;
        __syncthreads();
        for (int it = c.bid * NWAVES + c.wave; it < I_UP + I_DN; it += c.G * NWAVES) {
            if (it < I_UP) p0_transpose_item<true>(((const float*)args.in[29]), ((const float*)args.in[28]), 1024, DFF2, WSP(bf16_t, WS_WUP), scr, it, c.lane);
            else p0_transpose_item(((const float*)args.in[32]), nullptr, DFF, 1024, WSP(bf16_t, WS_WDN), scr, it - I_UP, c.lane);
        }
    }
}
__device__ __forceinline__ void ph9(Ctx& c, const Args& args) {
    float gq = 0.f, gk = 0.f;
    for (int i = c.lane; i < 128; i += 64) { gq = fmaxf(gq, fabsf(((const float*)args.in[25])[i])); gk = fmaxf(gk, fabsf(((const float*)args.in[26])[i])); }
#pragma unroll
    for (int o = 1; o < 64; o <<= 1) { gq = fmaxf(gq, __shfl_xor(gq, o)); gk = fmaxf(gk, __shfl_xor(gk, o)); }
    const bool bounded = __builtin_amdgcn_readfirstlane((int)(11.313708499f * 1.02f * gq * gk * 1.4426950408889634f <= 60.0f)) != 0;
    for (int L = c.bid; L < 256; L += c.G) { const int rb = L >> 2, h = L & 3, b = rb >> 5;
        const bf16_t* Qp = WSP(bf16_t, WS_QMEM) + (size_t)rb * 256 * 512 + h * 128; const bf16_t* Kp = WSP(bf16_t, WS_MEMKV) + (size_t)b * MEMLEN * 1024 + h * 128;
        const bf16_t* Vp = WSP(bf16_t, WS_MEMKV) + (size_t)b * MEMLEN * 1024 + 512 + h * 128; bf16_t* Op = WSP(bf16_t, WS_OMEM) + (size_t)rb * 256 * 512 + h * 128;
        if (bounded) run_attn<128, 128, true, true>(c, Qp, 512, Kp, 1024, Vp, 1024, Op, 512, MEMLEN, 0.08838834764831845f, ((const float*)args.in[25]), nullptr);
        else run_attn<128, 128, true, false>(c, Qp, 512, Kp, 1024, Vp, 1024, Op, 512, MEMLEN, 0.08838834764831845f, ((const float*)args.in[25]), nullptr); }
}
__device__ __forceinline__ void ph10(Ctx& c, const Args& args) {
    pg8::Sched2 S = sched1(c, WSP(bf16_t, WS_OMEM), WSP(bf16_t, WS_WMO), T / 256, 4, 512, 512); pg8::EpiResid<false, false> E{nullptr, WSP(bf16_t, WS_XB), nullptr, WSP(bf16_t, WS_XB), WSP(float, WS_SS)};
    run_gemm(c, pg8::Gemm{512, 512, 512}, S, E);
}
__device__ __forceinline__ void ph11(Ctx& c, const Args& args) {
    pg8::FfnOrder S{(const char*)WSP(bf16_t, WS_XB), (const char*)WSP(bf16_t, WS_WUP), c.G, c.bid};
    LAS float* rsl = (LAS float*)(c.lds + 131072 + 8192 + 4096);
    { pg8::Unit u;
      for (int i = 0; i < 6 && S.next(i, u); ++i) { const int b = u.pm / 33, pmb = u.pm - 33 * b;
          if (c.tid < 256) { const int tl = 254 * pmb - 1 + c.tid; rsl[i * 256 + c.tid] = (tl >= 0 && tl < SEQ) ? pg8::rowscale16(WSP(float, WS_SS), b * SEQ + tl) : 0.f; } }
      __syncthreads(); }
    pg8::EpiFfn E{WSP(float, WS_SS), ((const float*)args.in[30]), ((const float*)args.in[31]), WSP(bf16_t, WS_HID), (LAS float*)(c.lds + 131072), rsl};
    run_gemm(c, pg8::Gemm{1024, 1024, 1024}, S, E);
}
__device__ __forceinline__ void ph15(Ctx& c, const Args& args) {
    pg8::Sched2 S = sched1(c, WSP(bf16_t, WS_HID), WSP(bf16_t, WS_WDN), T / 256, 4, DFF, DFF); pg8::EpiResid<false, true> E{nullptr, WSP(bf16_t, WS_XB), args.out, nullptr, nullptr};
    run_gemm(c, pg8::Gemm{DFF, DFF, DFF}, S, E);
}

constexpr int N_PHASES = 16;
#ifndef PH_MASK
#define PH_MASK 0xFFFF
#endif
#ifndef DUP_MASK
#define DUP_MASK 0
#endif
#ifndef EXTRA_SYNCS
#define EXTRA_SYNCS 0
#endif
__global__ void __launch_bounds__(NTHR) fwd_kernel(Args args) {
    extern __shared__ __attribute__((aligned(16))) unsigned char lds_raw[];
    cg::grid_group grid = cg::this_grid();
    Ctx c;
    c.lds = (LAS unsigned char*)lds_raw; c.ldsg = (char*)lds_raw;
    c.tid = threadIdx.x; c.lane = c.tid & 63; c.wave = __builtin_amdgcn_readfirstlane(c.tid >> 6); c.bid = blockIdx.x; c.G = gridDim.x;
    for (int u = c.tid; u < (LDS_BYTES - LDSCTL_OFF) / 4; u += NTHR) ((LAS unsigned*)(c.lds + LDSCTL_OFF))[u] = 0u;
    __syncthreads();
    XcdBarrier bar = xcd_barrier_post((unsigned*)(args.ws + WS_BAR), (volatile LAS unsigned*)(c.lds + MISC_OFF) + 8);
    const int lo = args.ph_lo, hi = args.ph_hi;
    if (lo < 0) grid.sync();
#define IN(k) (((PH_MASK >> (k)) & 1) && lo <= (k) && (k) < hi)
#define DUPQ(k) (((DUP_MASK >> (k)) & 1) && IN(k))
#define SEAM(k) do { if (IN(k) && IN((k) + 1)) xcd_barrier(bar); } while (0)
#define PH(k, call) do { if (IN(k)) { call; } if (DUPQ(k)) { grid.sync(); call; } } while (0)
#ifndef TS_PHASE
#define TS_PHASE (-1)
#endif
    unsigned long long ts0_ = 0, span_ = 0; const bool stamper_ = (TS_PHASE >= 0) && blockIdx.x == 0 && c.tid == 0;
#define PHS(k, call) do { if (TS_PHASE == (k) && stamper_) ts0_ = __builtin_amdgcn_s_memrealtime(); PH(k, call); SEAM(k); if (TS_PHASE == (k) && stamper_) span_ = __builtin_amdgcn_s_memrealtime() - ts0_; } while (0)
    PHS(0, phase0(c, args));
#pragma unroll 1
    for (int es_ = 0; es_ < EXTRA_SYNCS; ++es_) grid.sync();
    PHS(1, ph1(c, args));
    PHS(2, phase2(c, args));
    PHS(3, ph3(c, args));
    PHS(5, ph5(c, args));
    PHS(6, phase6(c, args));
    PHS(7, ph7(c, args));
    PHS(8, ph8(c, args));
    PHS(9, ph9(c, args));
    PHS(10, ph10(c, args));
    PHS(11, ph11(c, args));
    if (TS_PHASE == 15 && stamper_) ts0_ = __builtin_amdgcn_s_memrealtime();
    PH(15, ph15(c, args));
    if (TS_PHASE == 15 && stamper_) span_ = __builtin_amdgcn_s_memrealtime() - ts0_;
    if (TS_PHASE >= 0 && stamper_) { const unsigned long long te_ = __builtin_amdgcn_s_memrealtime(); while (__builtin_amdgcn_s_memrealtime() - te_ < 10ull * span_) __builtin_amdgcn_s_sleep(8); }
#undef IN
#undef SEAM
}

#ifndef N_LAUNCHES
#define N_LAUNCHES 1
#endif
extern "C" void kernel_launch(void* const* d_in, const int* in_sizes, int n_in, void* d_out, int out_size, void* d_ws, size_t ws_size, hipStream_t stream) {
    static int grid = 0;
    if (grid == 0) {
        if (n_in != 33 || in_sizes[0] != T * DM || out_size != T * DM || ws_size < WS_END) { fprintf(stderr, "kernel_launch: unexpected shapes (n_in %d, in0 %d, out %d, ws %zu)\n", n_in, n_in > 0 ? in_sizes[0] : -1, out_size, ws_size); grid = -1; return; }
        int dev = 0, cus = 0, per_cu = 0;
        if (hipGetDevice(&dev) != hipSuccess || hipDeviceGetAttribute(&cus, hipDeviceAttributeMultiprocessorCount, dev) != hipSuccess) { grid = -1; return; }
        if (hipFuncSetAttribute((const void*)fwd_kernel, hipFuncAttributeMaxDynamicSharedMemorySize, LDS_BYTES) != hipSuccess) { fprintf(stderr, "kernel_launch: hipFuncSetAttribute failed\n"); grid = -1; return; }
        if (hipOccupancyMaxActiveBlocksPerMultiprocessor(&per_cu, (const void*)fwd_kernel, NTHR, LDS_BYTES) != hipSuccess || per_cu < 1) { fprintf(stderr, "kernel_launch: occupancy query says %d\n", per_cu); per_cu = 1; }
        (void)hipGetLastError();
        if (per_cu > 1) per_cu = 1;
        grid = cus * per_cu;
    }
    if (grid < 0) return;
    if (hipMemsetAsync((char*)d_ws + WS_BAR, 0, BAR_ZERO_BYTES, stream) != hipSuccess) { fprintf(stderr, "kernel_launch: hipMemsetAsync failed\n"); return; }
    Args a{};
    for (int i = 0; i < 33; ++i) a.in[i] = d_in[i];
    a.out = (float*)d_out; a.ws = (unsigned char*)d_ws;
#if N_LAUNCHES == 1
    a.ph_lo = 0; a.ph_hi = N_PHASES;
    void* kargs[] = {&a};
    const hipError_t e = hipLaunchCooperativeKernel((const void*)fwd_kernel, dim3(grid), dim3(NTHR), kargs, LDS_BYTES, stream);
    if (e != hipSuccess) fprintf(stderr, "kernel_launch: cooperative launch failed: %s (grid %d)\n", hipGetErrorString(e), grid);
#else
    for (int p = 0; p < N_PHASES; ++p) { a.ph_lo = p; a.ph_hi = p + 1; hipLaunchKernelGGL(fwd_kernel, dim3(grid), dim3(NTHR), LDS_BYTES, stream, a); }
#endif
}
```
